# Optimizing an MI355X kernel written in HIP

```python
import math
import jax, jax.numpy as jnp
from jax import lax
import numpy as np

D_MODEL = 2048
BATCH = 2
SEQ = 8192
DEPTH = 1

D_FF = 5504
SSD_D_INNER = 2048
SSD_HEAD_DIM = 64
SSD_HEADS = SSD_D_INNER // SSD_HEAD_DIM
SSD_GROUPS = 4
SSD_HEADS_PER_GROUP = SSD_HEADS // SSD_GROUPS
SSD_STATE = 128
SSD_CONV = 4
SSD_CHUNK = 128
SSD_CONV_DIM = SSD_D_INNER + 2 * SSD_GROUPS * SSD_STATE
S5_WIDTH = 1024
S5_GROUP_SIZE = 16
S5_GROUPS = S5_WIDTH // S5_GROUP_SIZE
S5_STATE = 64
OFF_XBC = SSD_D_INNER
OFF_DT = OFF_XBC + SSD_CONV_DIM
OFF_U = OFF_DT + SSD_HEADS
OFF_GATES = OFF_U + S5_WIDTH
IN_COLS = OFF_GATES + 2 * D_MODEL
N_ADA = 9
EPS = 1e-6

kernel_name = "hybrid_ssd_s5_gated_macaron_block"


def rms_norm(x, g):
    xf = x.astype(jnp.float32)
    y = xf * lax.rsqrt(jnp.mean(xf * xf, axis=-1, keepdims=True) + EPS)
    return (y * g.astype(jnp.float32)).astype(x.dtype)


def modulate(x, g, shift, scale):
    return rms_norm(x, g) * (1 + scale) + shift


def swiglu(h, w_in, w_out):
    a, b = jnp.split(h @ w_in, 2, axis=-1)
    return (jax.nn.silu(a) * b) @ w_out


def causal_depthwise_conv(x, w, b):
    k_w = w.shape[0]
    s = x.shape[1]
    xp = jnp.pad(x, ((0, 0), (k_w - 1, 0), (0, 0)))
    out = b
    for k in range(k_w):
        out = out + xp[:, k:k + s] * w[k]
    return out


def ssd_mixer(xbc, z, dt_raw, conv_w, conv_b, dt_bias, a_log, d_skip, norm_w):
    f32 = jnp.float32
    bsz, s, _ = xbc.shape
    nc = s // SSD_CHUNK
    G, R, P, N, L = SSD_GROUPS, SSD_HEADS_PER_GROUP, SSD_HEAD_DIM, SSD_STATE, SSD_CHUNK
    xbc = jax.nn.silu(causal_depthwise_conv(xbc, conv_w, conv_b)).astype(f32)
    xs, bm, cm = jnp.split(xbc, [SSD_D_INNER, SSD_D_INNER + G * N], axis=-1)
    xs = xs.reshape(bsz, nc, L, G, R, P)
    bm = bm.reshape(bsz, nc, L, G, N)
    cm = cm.reshape(bsz, nc, L, G, N)
    dt = jax.nn.softplus(dt_raw.astype(f32) + dt_bias.astype(f32)).reshape(bsz, nc, L, G, R)
    a = -jnp.exp(a_log.astype(f32)).reshape(G, R)
    xdt = xs * dt[..., None]
    da_cs = jnp.cumsum(jnp.moveaxis(dt * a, 2, -1), axis=-1)
    causal = jnp.tril(jnp.ones((L, L), dtype=bool))
    seg = da_cs[..., :, None] - da_cs[..., None, :]
    decay_ls = jnp.exp(jnp.where(causal, seg, -jnp.inf))
    cb = jnp.einsum('bclgn,bcsgn->bcgls', cm, bm)
    y_diag = jnp.einsum('bcgls,bcgrls,bcsgrp->bclgrp', cb, decay_ls, xdt)
    decay_to_end = jnp.exp(da_cs[..., -1:] - da_cs)
    states = jnp.einsum('bclgn,bcgrl,bclgrp->bcgrpn', bm, decay_to_end, xdt)
    chunk_decay = jnp.exp(da_cs[..., -1])

    def step(h, inp):
        st, dec = inp
        return dec[..., None, None] * h + st, h

    h0 = jnp.zeros((bsz, G, R, P, N), f32)
    _, prev = lax.scan(step, h0, (jnp.moveaxis(states, 1, 0), jnp.moveaxis(chunk_decay, 1, 0)))
    prev = jnp.moveaxis(prev, 0, 1)
    y_off = jnp.einsum('bclgn,bcgrpn,bcgrl->bclgrp', cm, prev, jnp.exp(da_cs))
    y = y_diag + y_off + d_skip.astype(f32).reshape(G, R)[:, :, None] * xs
    y = y.reshape(bsz, s, G, R * P)
    yz = y * jax.nn.silu(z.astype(f32)).reshape(bsz, s, G, R * P)
    yz = yz * lax.rsqrt(jnp.mean(yz * yz, axis=-1, keepdims=True) + EPS)
    return (yz.reshape(bsz, s, SSD_D_INNER) * norm_w.astype(f32)).astype(z.dtype)


def s5_mixer(u, lambda_re, lambda_im, b_re, b_im, c_re, c_im, d_skip, log_dt):
    f32 = jnp.float32
    bsz, s, _ = u.shape
    uf = u.astype(f32).reshape(bsz, s, S5_GROUPS, S5_GROUP_SIZE)
    dt = jnp.exp(log_dt.astype(f32))[:, None]
    lr = jnp.minimum(lambda_re.astype(f32), -1e-4)
    li = lambda_im.astype(f32)
    mag = jnp.exp(lr * dt)
    ar = mag * jnp.cos(li * dt)
    ai = mag * jnp.sin(li * dt)
    den = lr * lr + li * li
    nr = ar - 1.0
    kr = (nr * lr + ai * li) / den
    ki = (ai * lr - nr * li) / den
    br = b_re.astype(f32)
    bi = b_im.astype(f32)
    bbar_re = kr[..., None] * br - ki[..., None] * bi
    bbar_im = kr[..., None] * bi + ki[..., None] * br
    bu_re = jnp.einsum('bsgi,gpi->bsgp', uf, bbar_re)
    bu_im = jnp.einsum('bsgi,gpi->bsgp', uf, bbar_im)
    a_re = jnp.broadcast_to(ar, bu_re.shape)
    a_im = jnp.broadcast_to(ai, bu_im.shape)

    def combine(e1, e2):
        a1r, a1i, b1r, b1i = e1
        a2r, a2i, b2r, b2i = e2
        return (a2r * a1r - a2i * a1i,
                a2r * a1i + a2i * a1r,
                a2r * b1r - a2i * b1i + b2r,
                a2r * b1i + a2i * b1r + b2i)

    _, _, s_re, s_im = lax.associative_scan(combine, (a_re, a_im, bu_re, bu_im), axis=1)
    y = (jnp.einsum('bsgp,gip->bsgi', s_re, c_re.astype(f32))
         - jnp.einsum('bsgp,gip->bsgi', s_im, c_im.astype(f32))
         + d_skip.astype(f32) * uf)
    return y.reshape(bsz, s, S5_WIDTH).astype(u.dtype)


def setup_inputs(seed: int = 0) -> dict:
    key = jax.random.key(seed)
    ks = jax.random.split(key, 40)
    f32 = jnp.float32

    def nrm(k, shape, scale):
        return jax.random.normal(k, shape, f32) * scale

    dt_ssd = jnp.exp(jax.random.uniform(ks[11], (DEPTH, SSD_HEADS), f32, math.log(1e-3), math.log(1e-1)))
    lam_im = (jnp.pi * jnp.arange(S5_STATE, dtype=f32))[None, None, :] + nrm(ks[16], (DEPTH, S5_GROUPS, S5_STATE), 0.01)
    return {
        "x": nrm(ks[0], (BATCH, SEQ, D_MODEL), 1.0),
        "c": nrm(ks[1], (BATCH, D_MODEL), 1.0),
        "w_ada": nrm(ks[2], (DEPTH, D_MODEL, N_ADA * D_MODEL), D_MODEL ** -0.5),
        "b_ada": nrm(ks[3], (DEPTH, N_ADA * D_MODEL), 0.01),
        "norm_ffn1": 1.0 + nrm(ks[4], (DEPTH, D_MODEL), 0.02),
        "w_ffn1_in": nrm(ks[5], (DEPTH, D_MODEL, 2 * D_FF), D_MODEL ** -0.5),
        "w_ffn1_out": nrm(ks[6], (DEPTH, D_FF, D_MODEL), D_FF ** -0.5),
        "norm_mix": 1.0 + nrm(ks[7], (DEPTH, D_MODEL), 0.02),
        "w_in": nrm(ks[8], (DEPTH, D_MODEL, IN_COLS), D_MODEL ** -0.5),
        "conv_w": nrm(ks[9], (DEPTH, SSD_CONV, SSD_CONV_DIM), SSD_CONV ** -0.5),
        "conv_b": nrm(ks[10], (DEPTH, SSD_CONV_DIM), 0.01),
        "dt_bias": dt_ssd + jnp.log(-jnp.expm1(-dt_ssd)),
        "a_log": jnp.log(jax.random.uniform(ks[12], (DEPTH, SSD_HEADS), f32, 1.0, 16.0)),
        "d_ssd": 1.0 + nrm(ks[13], (DEPTH, SSD_HEADS), 0.02),
        "ssd_norm_w": 1.0 + nrm(ks[14], (DEPTH, SSD_D_INNER), 0.02),
        "w_a_proj": nrm(ks[15], (DEPTH, SSD_D_INNER, D_MODEL), SSD_D_INNER ** -0.5),
        "s5_lambda_re": -0.5 + nrm(ks[17], (DEPTH, S5_GROUPS, S5_STATE), 0.01),
        "s5_lambda_im": lam_im,
        "s5_b_re": nrm(ks[18], (DEPTH, S5_GROUPS, S5_STATE, S5_GROUP_SIZE), (2 * S5_GROUP_SIZE) ** -0.5),
        "s5_b_im": nrm(ks[19], (DEPTH, S5_GROUPS, S5_STATE, S5_GROUP_SIZE), (2 * S5_GROUP_SIZE) ** -0.5),
        "s5_c_re": nrm(ks[20], (DEPTH, S5_GROUPS, S5_GROUP_SIZE, S5_STATE), (2 * S5_STATE) ** -0.5),
        "s5_c_im": nrm(ks[21], (DEPTH, S5_GROUPS, S5_GROUP_SIZE, S5_STATE), (2 * S5_STATE) ** -0.5),
        "s5_d": nrm(ks[22], (DEPTH, S5_GROUPS, S5_GROUP_SIZE), 1.0),
        "s5_log_dt": jax.random.uniform(ks[23], (DEPTH, S5_GROUPS), f32, math.log(1e-3), math.log(1e-1)),
        "w_b_glu": nrm(ks[24], (DEPTH, S5_WIDTH, 2 * D_MODEL), S5_WIDTH ** -0.5),
        "w_out": nrm(ks[25], (DEPTH, D_MODEL, D_MODEL), D_MODEL ** -0.5),
        "norm_ffn2": 1.0 + nrm(ks[26], (DEPTH, D_MODEL), 0.02),
        "w_ffn2_in": nrm(ks[27], (DEPTH, D_MODEL, 2 * D_FF), D_MODEL ** -0.5),
        "w_ffn2_out": nrm(ks[28], (DEPTH, D_FF, D_MODEL), D_FF ** -0.5),
        "norm_final": 1.0 + nrm(ks[29], (D_MODEL,), 0.02),
    }


def reference(x, c, w_ada, b_ada, norm_ffn1, w_ffn1_in, w_ffn1_out, norm_mix, w_in,
              conv_w, conv_b, dt_bias, a_log, d_ssd, ssd_norm_w, w_a_proj,
              s5_lambda_re, s5_lambda_im, s5_b_re, s5_b_im, s5_c_re, s5_c_im, s5_d, s5_log_dt,
              w_b_glu, w_out, norm_ffn2, w_ffn2_in, w_ffn2_out, norm_final):
    c_act = jax.nn.silu(c)
    for l in range(DEPTH):
        mods = (c_act @ w_ada[l] + b_ada[l])[:, None, :]
        (sh1, sc1, g1, sh2, sc2, g2, sh3, sc3, g3) = jnp.split(mods, N_ADA, axis=-1)

        h = modulate(x, norm_ffn1[l], sh1, sc1)
        x = x + 0.5 * g1 * swiglu(h, w_ffn1_in[l], w_ffn1_out[l])

        h = modulate(x, norm_mix[l], sh2, sc2)
        proj = h @ w_in[l]
        z, xbc, dt_raw, u, gates = jnp.split(proj, [OFF_XBC, OFF_DT, OFF_U, OFF_GATES], axis=-1)
        gate_a, gate_b = jnp.split(gates, 2, axis=-1)

        y_a = ssd_mixer(xbc, z, dt_raw, conv_w[l], conv_b[l], dt_bias[l], a_log[l], d_ssd[l], ssd_norm_w[l])
        p_a = y_a @ w_a_proj[l]

        y_b = s5_mixer(u, s5_lambda_re[l], s5_lambda_im[l], s5_b_re[l], s5_b_im[l],
                       s5_c_re[l], s5_c_im[l], s5_d[l], s5_log_dt[l])
        glu_a, glu_g = jnp.split(jax.nn.gelu(y_b) @ w_b_glu[l], 2, axis=-1)
        p_b = glu_a * jax.nn.sigmoid(glu_g)

        merged = jax.nn.sigmoid(gate_a) * p_a + jax.nn.sigmoid(gate_b) * p_b
        x = x + g2 * (merged @ w_out[l])

        h = modulate(x, norm_ffn2[l], sh3, sc3)
        x = x + 0.5 * g3 * swiglu(h, w_ffn2_in[l], w_ffn2_out[l])
    return rms_norm(x, norm_final)
```

```cpp
#include <hip/hip_runtime.h>
#include <hip/hip_cooperative_groups.h>
#include <cstdio>
#define REP_MASK 0
namespace cg = cooperative_groups;

#define LAS __attribute__((address_space(3)))
typedef unsigned short u16;
typedef short bf16x8 __attribute__((ext_vector_type(8)));
typedef float f32x4 __attribute__((ext_vector_type(4)));
typedef float f32x2 __attribute__((ext_vector_type(2)));
typedef unsigned u32x4 __attribute__((ext_vector_type(4)));
typedef unsigned u32x2 __attribute__((ext_vector_type(2)));

constexpr int M_TOK = 16384, DM = 2048, FF = 5504, SEQ = 8192;
constexpr int NPROJ = 10496;
constexpr int NPROJ_G = 10240, NPROJ_C = 10304;
constexpr int NMOD = 18432;
constexpr int LDS_PHASE_BYTES = 147456;
constexpr int LDS_BYTES = LDS_PHASE_BYTES + 16;
constexpr int NPH = 17;

constexpr size_t WS_W1IN = 0;
constexpr size_t WS_W1OUT = WS_W1IN + (size_t)11008 * 2048 * 2;
constexpr size_t WS_WIN = WS_W1OUT + (size_t)2048 * 5504 * 2;
constexpr size_t WS_WA = WS_WIN + (size_t)NPROJ * 2048 * 2;
constexpr size_t WS_WB = WS_WA + (size_t)2048 * 2048 * 2;
constexpr size_t WS_WO = WS_WB + (size_t)4096 * 1024 * 2;
constexpr size_t WS_H = WS_WO + (size_t)2048 * 2048 * 2;
constexpr size_t WS_HID = WS_H + (size_t)M_TOK * 2048 * 2;
constexpr size_t WS_X = WS_HID + (size_t)M_TOK * FF * 2;
constexpr size_t WS_G = WS_X + (size_t)M_TOK * 3072 * 2;
constexpr size_t WS_MISC = WS_G + (size_t)M_TOK * 4096 * 2;
constexpr size_t WS_Z = WS_HID;
constexpr size_t WS_U = WS_Z + (size_t)M_TOK * 2048 * 2;
constexpr size_t WS_DT = WS_U + (size_t)M_TOK * 1024 * 2;
constexpr size_t WS_CS = WS_DT + (size_t)M_TOK * 32 * 4;
constexpr size_t WS_ST = WS_CS + (size_t)M_TOK * 32 * 4;
constexpr size_t WS_MB = WS_ST;
static_assert(WS_ST + (size_t)M_TOK * 2048 * 2 <= WS_X, "mixer buffers overflow HID");
constexpr size_t WS_BC = WS_WIN;
constexpr size_t WS_CC = WS_BC + (size_t)M_TOK * 512 * 2;
constexpr size_t WS_YA = WS_X;
constexpr size_t WS_YB = WS_YA + (size_t)M_TOK * 2048 * 2;
constexpr size_t WS_PART = WS_MISC;
constexpr size_t WS_MODS = WS_PART + (size_t)32 * 2 * NMOD * 4;
constexpr size_t WS_BBAR = WS_MODS + (size_t)2 * NMOD * 4;
constexpr size_t WS_CM = WS_BBAR + (size_t)64 * 128 * 16 * 2;
constexpr size_t WS_AV = WS_CM + (size_t)64 * 16 * 128 * 2;
constexpr size_t WS_AL = WS_AV + (size_t)4096 * 8;
constexpr size_t WS_SEND = WS_AL + (size_t)4096 * 8;
constexpr size_t WS_SINIT = WS_SEND + (size_t)2 * 32 * 4096 * 8;
constexpr size_t WS_BAR = WS_SINIT + (size_t)2 * 32 * 4096 * 8;
constexpr size_t WS_BCT = WS_BAR + 16384;
constexpr size_t WS_END = WS_BCT + (size_t)512 * 16384 * 2;

struct Params {
    const float* in[30];
    float* out; unsigned char* ws; int ph_lo, ph_hi;
};
enum { I_X = 0, I_C, I_WADA, I_BADA, I_NF1, I_W1IN, I_W1OUT, I_NMIX, I_WIN, I_CONVW, I_CONVB, I_DTB, I_ALOG, I_DSSD, I_SNW, I_WA,
       I_LRE, I_LIM, I_BRE, I_BIM, I_CRE, I_CIM, I_S5D, I_LOGDT, I_WB, I_WO, I_NF2, I_W2IN, I_W2OUT, I_NFIN };

__device__ __forceinline__ unsigned cvt_pk_bf16(float lo, float hi) { unsigned r; asm volatile("v_cvt_pk_bf16_f32 %0, %1, %2" : "=v"(r) : "v"(lo), "v"(hi)); return r; }
__device__ __forceinline__ u16 f2bf(float f) { return (u16)(cvt_pk_bf16(f, 0.f) & 0xffffu); }
__device__ __forceinline__ float bf2f(u16 b) { return __uint_as_float(((unsigned)b) << 16); }
__device__ __forceinline__ float bflo(unsigned w) { return __uint_as_float(w << 16); }
__device__ __forceinline__ float bfhi(unsigned w) { return __uint_as_float(w & 0xffff0000u); }
__device__ __forceinline__ float sigmoidf_(float v) { return __builtin_amdgcn_rcpf(1.f + __expf(-v)); }
__device__ __forceinline__ float siluf_(float v) { return v * sigmoidf_(v); }
__device__ __forceinline__ float gelu_tanh(float v) { const float z = 0.7978845608028654f * (v + 0.044715f * v * v * v); const float t = 1.f - 2.f * __builtin_amdgcn_rcpf(__expf(2.f * z) + 1.f); return 0.5f * v * (1.f + t); }
__device__ __forceinline__ bf16x8 pack8(const float* f) { u32x4 w; w.x = cvt_pk_bf16(f[0], f[1]); w.y = cvt_pk_bf16(f[2], f[3]); w.z = cvt_pk_bf16(f[4], f[5]); w.w = cvt_pk_bf16(f[6], f[7]); return __builtin_bit_cast(bf16x8, w); }
#define MFMA16(a, b, c) __builtin_amdgcn_mfma_f32_16x16x32_bf16((a), (b), (c), 0, 0, 0)

namespace pg8 {
constexpr int BM = 256, BK = 64, HALF = 128, HTB = HALF * BK * 2, STAGE_BYTES = 8 * HTB, NXCD = 8, WGM = 8;
__device__ __forceinline__ int lds_byte(int r, int c) { const int st = (r >> 4) * 2 + (c >> 5), rr = r & 15, cc = c & 31, ob = rr * 64 + cc * 2; return st * 1024 + (ob ^ (((ob >> 9) & 1) << 5)); }
__device__ __forceinline__ void stage_rc(int b, int& R, int& C) { const int st = b / 1024, sb = b % 1024, swz = sb ^ (((sb >> 9) & 1) << 5); R = (st >> 1) * 16 + swz / 64; C = (st & 1) * 32 + (swz % 64) / 2; }
__device__ __forceinline__ int perm32(int rho) { const int n = rho >> 4, i = rho & 15; return 8 * (i >> 2) + 4 * n + (i & 3); }
struct Unit { int pm, pn; };
struct Gemm { const u16* A; const u16* Bt; int M, N, K; };
struct StaticOrder {
    int nM, nN, nwg, G, c; bool pnfast;
    __device__ void init(int M, int N, int G_, int c_, bool pf = false) { nM = M / BM; nN = N / BM; nwg = nM * nN; G = G_; c = c_; pnfast = pf; }
    __device__ bool next(int i, Unit& u) const {
        const long L = (long)i * G + c; if (L >= nwg) return false;
        int wgid = (int)L; { const int q = nwg / NXCD, r = nwg % NXCD, xcd = wgid % NXCD, off = wgid / NXCD; wgid = (xcd < r ? xcd * (q + 1) : r * (q + 1) + (xcd - r) * q) + off; }
        const int nig = WGM * nN, gid = wgid / nig, fm = gid * WGM, gsz = (nM - fm) < WGM ? (nM - fm) : WGM;
        if (pnfast) { u.pm = fm + (wgid % nig) / nN; u.pn = (wgid % nig) % nN; } else { u.pm = fm + ((wgid % nig) % gsz); u.pn = (wgid % nig) / gsz; }
        return true;
    }
};

template <class Epi, bool TA = false, bool TB = false>
__device__ __forceinline__ void gemm_phase(LAS unsigned char* lds, const Gemm g, const StaticOrder& S, const Epi& E) {
    const int tid = threadIdx.x, wid = __builtin_amdgcn_readfirstlane(tid >> 6), lane = tid & 63, wr = wid >> 2, wc = wid & 3, fr = lane & 15, fq = lane >> 4;
    const int K = g.K, nt = K / BK;
    unsigned voffA[2], voffB[2];
#pragma unroll
    for (int i = 0; i < 2; ++i) { int R, C; stage_rc(tid * 16 + i * 8192, R, C); const int Rb = Epi::PERM ? ((R & ~31) + perm32(R & 31)) : R;
        voffA[i] = (unsigned)(R * (TA ? BK : K) + C) * 2u; voffB[i] = (unsigned)(Rb * (TB ? BK : K) + C) * 2u; }
    const size_t kstepA = TA ? (size_t)HTB : (size_t)(BK * 2), kstepB = TB ? (size_t)HTB : (size_t)(BK * 2);
    const size_t hstepA = TA ? (size_t)nt * HTB : (size_t)HALF * K * 2, hstepB = TB ? (size_t)nt * HTB : (size_t)HALF * K * 2;
    const size_t tstep = (size_t)BM * K * 2;
    const unsigned ldsw = (unsigned)wid * 1024u;
    const int aoff = lds_byte(wr * 64 + fr, fq * 8), boff = lds_byte(wc * 32 + fr, fq * 8);
#define PG8_SA(b, h) (((b) * 2 + (h)) * HTB)
#define PG8_SB(b, h) ((4 + (b) * 2 + (h)) * HTB)
#define PG8_STAGE(bufoff, gbase, voff) do { _Pragma("unroll") for (int _i = 0; _i < 2; ++_i) \
        __builtin_amdgcn_global_load_lds((const unsigned*)((const char*)(gbase) + (voff)[_i]), (LAS unsigned*)(lds + (bufoff) + ldsw + _i * 8192), 16, 0, 0); } while (0)
#define PG8_LDA(dst, b, h) do { _Pragma("unroll") for (int m = 0; m < 4; ++m) _Pragma("unroll") for (int k = 0; k < 2; ++k) dst[m][k] = *(const LAS bf16x8*)(lds + PG8_SA(b, h) + aoff + m * 2048 + k * 1024); } while (0)
#define PG8_LDB(dst, b, h) do { _Pragma("unroll") for (int n = 0; n < 2; ++n) _Pragma("unroll") for (int k = 0; k < 2; ++k) dst[n][k] = *(const LAS bf16x8*)(lds + PG8_SB(b, h) + boff + n * 2048 + k * 1024); } while (0)
#define PG8_MMA(ai, bj, At, Bt) do { __builtin_amdgcn_s_setprio(1); _Pragma("unroll") for (int m = 0; m < 4; ++m) _Pragma("unroll") for (int n = 0; n < 2; ++n) _Pragma("unroll") for (int k = 0; k < 2; ++k) \
        acc[ai][bj][m][n] = __builtin_amdgcn_mfma_f32_16x16x32_bf16(Bt[n][k], At[m][k], acc[ai][bj][m][n], 0, 0, 0); __builtin_amdgcn_s_setprio(0); } while (0)
#define PG8_WAIT_V(n) asm volatile("s_waitcnt vmcnt(" #n ")" ::: "memory")
#define PG8_WAIT_L(n) asm volatile("s_waitcnt lgkmcnt(" #n ")" ::: "memory")
#define PG8_BAR __builtin_amdgcn_s_barrier()
#define PG8_SCHED __builtin_amdgcn_sched_barrier(0)
    Unit cur, nxt; int ui = 0;
    if (!S.next(0, cur)) return;
    f32x4 acc[2][2][4][2];
#pragma unroll
    for (int a = 0; a < 2; ++a)
#pragma unroll
        for (int b = 0; b < 2; ++b)
#pragma unroll
            for (int m = 0; m < 4; ++m)
#pragma unroll
                for (int n = 0; n < 2; ++n) acc[a][b][m][n] = (f32x4){0.f, 0.f, 0.f, 0.f};
    bf16x8 At[4][2], B0[2][2], B1[2][2];
    const char* cA = (const char*)g.A + (size_t)cur.pm * tstep; const char* cB = (const char*)g.Bt + (size_t)cur.pn * tstep;
    PG8_STAGE(PG8_SB(0, 0), cB, voffB); PG8_STAGE(PG8_SA(0, 0), cA, voffA); PG8_STAGE(PG8_SB(0, 1), cB + hstepB, voffB); PG8_STAGE(PG8_SA(0, 1), cA + hstepA, voffA);
    if (wr == 1) PG8_BAR;
    PG8_WAIT_V(4); PG8_BAR;
    PG8_STAGE(PG8_SB(1, 0), cB + kstepB, voffB); PG8_STAGE(PG8_SA(1, 0), cA + kstepA, voffA); PG8_STAGE(PG8_SB(1, 1), cB + hstepB + kstepB, voffB);
    PG8_WAIT_V(6); PG8_BAR;
    for (;;) {
        const bool has_next = S.next(ui + 1, nxt);
        const char* nA = has_next ? (const char*)g.A + (size_t)nxt.pm * tstep : cA; const char* nB = has_next ? (const char*)g.Bt + (size_t)nxt.pn * tstep : cB;
        for (int t = 0; t < nt; t += 2) {
            const bool last = (t == nt - 2);
            const char* a1 = cA + (size_t)(t + 1) * kstepA;
            const char* a2 = last ? nA : cA + (size_t)(t + 2) * kstepA; const char* b2 = last ? nB : cB + (size_t)(t + 2) * kstepB;
            const char* a3 = a2 + kstepA; const char* b3 = b2 + kstepB;
            PG8_LDB(B0, 0, 0); PG8_SCHED; PG8_LDA(At, 0, 0); PG8_STAGE(PG8_SA(1, 1), a1 + hstepA, voffA);
            PG8_WAIT_L(8); PG8_BAR; PG8_WAIT_L(0); PG8_MMA(0, 0, At, B0); PG8_BAR; PG8_SCHED;
            PG8_LDB(B1, 0, 1); PG8_STAGE(PG8_SB(0, 0), b2, voffB);
            PG8_BAR; PG8_WAIT_L(0); PG8_MMA(0, 1, At, B1); PG8_BAR;
            PG8_LDA(At, 0, 1); PG8_STAGE(PG8_SA(0, 0), a2, voffA);
            PG8_BAR; PG8_WAIT_L(0); PG8_MMA(1, 0, At, B0); PG8_BAR; PG8_SCHED;
            PG8_STAGE(PG8_SB(0, 1), b2 + hstepB, voffB);
            PG8_WAIT_V(6); PG8_BAR; PG8_MMA(1, 1, At, B1); PG8_BAR;
            PG8_LDB(B0, 1, 0); PG8_SCHED; PG8_LDA(At, 1, 0); PG8_STAGE(PG8_SA(0, 1), a2 + hstepA, voffA);
            PG8_WAIT_L(8); PG8_BAR; PG8_WAIT_L(0); PG8_MMA(0, 0, At, B0); PG8_BAR; PG8_SCHED;
            PG8_LDB(B1, 1, 1); PG8_STAGE(PG8_SB(1, 0), b3, voffB);
            PG8_BAR; PG8_WAIT_L(0); PG8_MMA(0, 1, At, B1); PG8_BAR;
            PG8_LDA(At, 1, 1); PG8_STAGE(PG8_SA(1, 0), a3, voffA);
            PG8_BAR; PG8_WAIT_L(0); PG8_MMA(1, 0, At, B0); PG8_BAR; PG8_SCHED;
            PG8_STAGE(PG8_SB(1, 1), b3 + hstepB, voffB);
            PG8_WAIT_V(6); PG8_BAR; PG8_MMA(1, 1, At, B1); PG8_BAR;
        }
        E(acc, cur, wr, wc, fr, fq);
        if (!has_next) break;
#pragma unroll
        for (int a = 0; a < 2; ++a)
#pragma unroll
            for (int b = 0; b < 2; ++b)
#pragma unroll
                for (int m = 0; m < 4; ++m)
#pragma unroll
                    for (int n = 0; n < 2; ++n) acc[a][b][m][n] = (f32x4){0.f, 0.f, 0.f, 0.f};
        cur = nxt; cA = nA; cB = nB; ++ui;
    }
    PG8_WAIT_V(0);
    if (wr == 0) PG8_BAR;
    PG8_BAR;
#undef PG8_SA
#undef PG8_SB
#undef PG8_STAGE
#undef PG8_LDA
#undef PG8_LDB
#undef PG8_MMA
#undef PG8_WAIT_V
#undef PG8_WAIT_L
#undef PG8_BAR
#undef PG8_SCHED
}
}

struct EpiSwiglu {
    static constexpr bool PERM = true;
    u16* O;
    __device__ __forceinline__ void operator()(const f32x4 (&acc)[2][2][4][2], const pg8::Unit& u, int wr, int wc, int fr, int fq) const {
        const int row0 = u.pm * 256 + wr * 64 + fr, col0 = u.pn * 128 + wc * 32 + 8 * fq;
#pragma unroll
        for (int ai = 0; ai < 2; ++ai)
#pragma unroll
            for (int m = 0; m < 4; ++m) {
                float v[8];
#pragma unroll
                for (int n = 0; n < 2; ++n)
#pragma unroll
                    for (int j = 0; j < 4; ++j) v[n * 4 + j] = siluf_(acc[ai][0][m][n][j]) * acc[ai][1][m][n][j];
                *(bf16x8*)(O + (size_t)(row0 + ai * 128 + m * 16) * FF + col0) = pack8(v);
            }
    }
};
struct EpiResid {
    static constexpr bool PERM = false;
    const float* xin; float* xout; const float* gate; float scale;
    __device__ __forceinline__ void operator()(const f32x4 (&acc)[2][2][4][2], const pg8::Unit& u, int wr, int wc, int fr, int fq) const {
        const int row0 = u.pm * 256 + wr * 64 + fr, col0 = u.pn * 256 + wc * 32 + 4 * fq;
        const float* gp = gate + (u.pm >= 32 ? NMOD : 0) + col0;
        f32x4 gv[2][2];
#pragma unroll
        for (int bj = 0; bj < 2; ++bj)
#pragma unroll
            for (int n = 0; n < 2; ++n) gv[bj][n] = *(const f32x4*)(gp + bj * 128 + n * 16) * scale;
#pragma unroll
        for (int ai = 0; ai < 2; ++ai) {
            f32x4 xi[4][2][2];
#pragma unroll
            for (int m = 0; m < 4; ++m)
#pragma unroll
                for (int bj = 0; bj < 2; ++bj)
#pragma unroll
                    for (int n = 0; n < 2; ++n) xi[m][bj][n] = *(const f32x4*)(xin + (size_t)(row0 + ai * 128 + m * 16) * DM + col0 + bj * 128 + n * 16);
#pragma unroll
            for (int m = 0; m < 4; ++m)
#pragma unroll
                for (int bj = 0; bj < 2; ++bj)
#pragma unroll
                    for (int n = 0; n < 2; ++n) *(f32x4*)(xout + (size_t)(row0 + ai * 128 + m * 16) * DM + col0 + bj * 128 + n * 16) = xi[m][bj][n] + gv[bj][n] * acc[ai][bj][m][n];
        }
    }
};
struct EpiProj {
    static constexpr bool PERM = true;
    u16* Z; u16* XBC; u16* U; u16* G; float* DT; const float* dt_bias;
    __device__ __forceinline__ void operator()(const f32x4 (&acc)[2][2][4][2], const pg8::Unit& u, int wr, int wc, int fr, int fq) const {
        const int row0 = u.pm * 256 + wr * 64 + fr, pn = u.pn;
        if (pn == 40) {
            if (wc == 0) {
#pragma unroll
                for (int ai = 0; ai < 2; ++ai)
#pragma unroll
                    for (int m = 0; m < 4; ++m) {
#pragma unroll
                        for (int n = 0; n < 2; ++n) { f32x4 o;
#pragma unroll
                            for (int j = 0; j < 4; ++j) { const float v = acc[ai][0][m][n][j] + dt_bias[8 * fq + 4 * n + j]; o[j] = v > 20.f ? v : log1pf(__expf(v)); }
                            *(f32x4*)(DT + (size_t)(row0 + ai * 128 + m * 16) * 32 + 8 * fq + 4 * n) = o; }
                    }
            }
            return;
        }
        u16* base; int ld, colt; bool sg = false;
        if (pn < 8) { base = Z; ld = 2048; colt = pn * 256; }
        else if (pn < 20) { base = XBC; ld = 3072; colt = (pn - 8) * 256; }
        else if (pn < 24) { base = U; ld = 1024; colt = (pn - 20) * 256; }
        else { base = G; ld = 4096; colt = (pn - 24) * 256; sg = true; }
        const int col0 = colt + wc * 32 + 8 * fq;
#pragma unroll
        for (int ai = 0; ai < 2; ++ai)
#pragma unroll
            for (int m = 0; m < 4; ++m)
#pragma unroll
                for (int bj = 0; bj < 2; ++bj) {
                    float v[8];
#pragma unroll
                    for (int n = 0; n < 2; ++n)
#pragma unroll
                        for (int j = 0; j < 4; ++j) { const float a = acc[ai][bj][m][n][j]; v[n * 4 + j] = sg ? sigmoidf_(a) : a; }
                    *(bf16x8*)(base + (size_t)(row0 + ai * 128 + m * 16) * ld + col0 + bj * 128) = pack8(v);
                }
    }
};
struct EpiGlu {
    static constexpr bool PERM = true;
    u16* O; const u16* G;
    __device__ __forceinline__ void operator()(const f32x4 (&acc)[2][2][4][2], const pg8::Unit& u, int wr, int wc, int fr, int fq) const {
        const int row0 = u.pm * 256 + wr * 64 + fr, col0 = u.pn * 128 + wc * 32 + 8 * fq;
        u32x4 gw[2][4];
#pragma unroll
        for (int ai = 0; ai < 2; ++ai)
#pragma unroll
            for (int m = 0; m < 4; ++m) gw[ai][m] = *(const u32x4*)(G + (size_t)(row0 + ai * 128 + m * 16) * 4096 + 2048 + col0);
#pragma unroll
        for (int ai = 0; ai < 2; ++ai)
#pragma unroll
            for (int m = 0; m < 4; ++m) {
                const size_t row = (size_t)(row0 + ai * 128 + m * 16);
                const u32x4 g4 = gw[ai][m];
                const float gb[8] = {bflo(g4.x), bfhi(g4.x), bflo(g4.y), bfhi(g4.y), bflo(g4.z), bfhi(g4.z), bflo(g4.w), bfhi(g4.w)};
                float v[8];
#pragma unroll
                for (int n = 0; n < 2; ++n)
#pragma unroll
                    for (int j = 0; j < 4; ++j) v[n * 4 + j] = gb[n * 4 + j] * acc[ai][0][m][n][j] * sigmoidf_(acc[ai][1][m][n][j]);
                *(bf16x8*)(O + row * DM + col0) = pack8(v);
            }
    }
};
struct EpiMerge {
    static constexpr bool PERM = true;
    u16* O; const u16* G; const u16* MB;
    __device__ __forceinline__ void operator()(const f32x4 (&acc)[2][2][4][2], const pg8::Unit& u, int wr, int wc, int fr, int fq) const {
        const int row0 = u.pm * 256 + wr * 64 + fr, col0 = u.pn * 256 + wc * 32 + 8 * fq;
#pragma unroll
        for (int ai = 0; ai < 2; ++ai) {
            u32x4 gw[4][2], mw[4][2];
#pragma unroll
            for (int m = 0; m < 4; ++m)
#pragma unroll
                for (int bj = 0; bj < 2; ++bj) { const size_t row = (size_t)(row0 + ai * 128 + m * 16); const int col = col0 + bj * 128;
                    gw[m][bj] = *(const u32x4*)(G + row * 4096 + col); mw[m][bj] = *(const u32x4*)(MB + row * DM + col); }
            asm volatile("" ::: "memory");
#pragma unroll
            for (int m = 0; m < 4; ++m)
#pragma unroll
                for (int bj = 0; bj < 2; ++bj) {
                    const size_t row = (size_t)(row0 + ai * 128 + m * 16); const int col = col0 + bj * 128;
                    const u32x4 g4 = gw[m][bj], m4 = mw[m][bj];
                    const float ga[8] = {bflo(g4.x), bfhi(g4.x), bflo(g4.y), bfhi(g4.y), bflo(g4.z), bfhi(g4.z), bflo(g4.w), bfhi(g4.w)};
                    const float mb[8] = {bflo(m4.x), bfhi(m4.x), bflo(m4.y), bfhi(m4.y), bflo(m4.z), bfhi(m4.z), bflo(m4.w), bfhi(m4.w)};
                    float v[8];
#pragma unroll
                    for (int n = 0; n < 2; ++n)
#pragma unroll
                        for (int j = 0; j < 4; ++j) v[n * 4 + j] = ga[n * 4 + j] * acc[ai][bj][m][n][j] + mb[n * 4 + j];
                    *(bf16x8*)(O + row * DM + col) = pack8(v);
                }
            asm volatile("" ::: "memory");
        }
    }
};

__device__ __forceinline__ size_t tiled_off(int row, int col, int K) { return ((size_t)(row >> 7) * (K >> 6) + (col >> 6)) * 8192 + (size_t)(row & 127) * 64 + (col & 63); }

__device__ __forceinline__ int map_col(int wsel, int n) {
    if (wsel == 0) return ((n >> 7) & 1) * FF + (n >> 8) * 128 + (n & 127);
    if (wsel == 3) return ((n >> 7) & 1) * 2048 + (n >> 8) * 128 + (n & 127);
    if (wsel == 2) { if (n < 5120) return n; if (n < 6144) return 5152 + (n - 5120); if (n < 10240) return 6176 + (n - 6144); if (n < 10272) return 5120 + (n - 10240); return -1; }
    return n;
}
__device__ __forceinline__ void conv_weight(LAS float* T, const float* __restrict__ src, u16* __restrict__ dst, int K, int ld, int ndst, int wsel, int& tbase, bool tiled = false) {
    const int nnt = ndst / 64, ntiles = (K / 128) * nnt, tid = threadIdx.x, G = gridDim.x;
    const int first = (((int)blockIdx.x - tbase) % G + G) % G;
    for (int t = first; t < ntiles; t += G) {
        const int n0 = (t % nnt) * 64, k0 = (t / nnt) * 128;
        { const int c4 = tid & 15, r = tid >> 4; const int sc = map_col(wsel, n0 + c4 * 4);
#pragma unroll
          for (int ps = 0; ps < 4; ++ps) { const int kr = r + ps * 32;
              f32x4 v = (f32x4){0.f, 0.f, 0.f, 0.f}; if (sc >= 0) v = *(const f32x4*)(src + (size_t)(k0 + kr) * ld + sc);
              LAS float* tp = T + kr * 65 + c4 * 4; tp[0] = v.x; tp[1] = v.y; tp[2] = v.z; tp[3] = v.w; } }
        __syncthreads();
        { const int kg = tid >> 5, nl = tid & 31;
#pragma unroll
          for (int ps = 0; ps < 2; ++ps) { const int n = nl + ps * 32; float f[8];
#pragma unroll
              for (int j = 0; j < 8; ++j) f[j] = T[(kg * 8 + j) * 65 + n];
              *(bf16x8*)(dst + (tiled ? tiled_off(n0 + n, k0 + kg * 8, K) : (size_t)(n0 + n) * K + k0 + kg * 8)) = pack8(f); } }
        __syncthreads();
    }
    tbase += ntiles;
}

template <int MODE, bool TILED = false>
__device__ __forceinline__ void norm_rows(const float* src, const float* __restrict__ gw, const float* __restrict__ sh, const float* __restrict__ sc, u16* dst, float* fdst) {
    const int lane = threadIdx.x & 63, wg = blockIdx.x * 8 + (threadIdx.x >> 6), nw = gridDim.x * 8;
    for (int rp = wg; rp < M_TOK / 2; rp += nw) {
        f32x4 v[2][8]; float ss[2] = {0.f, 0.f};
#pragma unroll
        for (int q = 0; q < 2; ++q)
#pragma unroll
            for (int i = 0; i < 8; ++i) v[q][i] = *(const f32x4*)(src + (size_t)(rp * 2 + q) * DM + i * 256 + lane * 4);
#pragma unroll
        for (int q = 0; q < 2; ++q) {
#pragma unroll
            for (int i = 0; i < 8; ++i) ss[q] += v[q][i].x * v[q][i].x + v[q][i].y * v[q][i].y + v[q][i].z * v[q][i].z + v[q][i].w * v[q][i].w;
#pragma unroll
            for (int off = 32; off >= 1; off >>= 1) ss[q] += __shfl_xor(ss[q], off); }
#pragma unroll
        for (int q = 0; q < 2; ++q) { const int row = rp * 2 + q, bo = (row >> 13) * NMOD; const float rstd = rsqrtf(ss[q] * (1.f / 2048.f) + 1e-6f);
#pragma unroll
            for (int i = 0; i < 8; ++i) { const int col = i * 256 + lane * 4; const f32x4 g4 = *(const f32x4*)(gw + col);
                if (MODE == 0) { const f32x4 s4 = *(const f32x4*)(sc + bo + col), h4 = *(const f32x4*)(sh + bo + col);
                    const f32x4 o = v[q][i] * rstd * g4 * (s4 + 1.f) + h4;
                    u32x2 w; w.x = cvt_pk_bf16(o.x, o.y); w.y = cvt_pk_bf16(o.z, o.w); *(u32x2*)(dst + (TILED ? tiled_off(row, col, DM) : (size_t)row * DM + col)) = w; }
                else { *(f32x4*)(fdst + (size_t)row * DM + col) = v[q][i] * rstd * g4; } } }
    }
}

__device__ __forceinline__ void norm_dt_rows(const float* src, const float* __restrict__ gw, const float* __restrict__ sh, const float* __restrict__ sc, u16* dst,
                                             const u16* __restrict__ wdt  , const float* __restrict__ dt_bias, float* DT) {
    const int lane = threadIdx.x & 63, wg = blockIdx.x * 8 + (threadIdx.x >> 6), nw = gridDim.x * 8, fr = lane & 15, fq = lane >> 4;
    for (int rb = wg; rb < M_TOK / 8; rb += nw) {
        const int row0 = rb * 8, bo = (row0 >> 13) * NMOD;
#pragma unroll 1
        for (int i8 = 0; i8 < 8; ++i8) { const int row = row0 + i8;
            f32x4 v[8]; float ss = 0.f;
#pragma unroll
            for (int i = 0; i < 8; ++i) { v[i] = *(const f32x4*)(src + (size_t)row * DM + i * 256 + lane * 4); ss += v[i].x * v[i].x + v[i].y * v[i].y + v[i].z * v[i].z + v[i].w * v[i].w; }
#pragma unroll
            for (int off = 32; off >= 1; off >>= 1) ss += __shfl_xor(ss, off);
            const float rstd = rsqrtf(ss * (1.f / 2048.f) + 1e-6f);
#pragma unroll
            for (int i = 0; i < 8; ++i) { const int col = i * 256 + lane * 4; const f32x4 g4 = *(const f32x4*)(gw + col), s4 = *(const f32x4*)(sc + bo + col), h4 = *(const f32x4*)(sh + bo + col);
                const f32x4 o = v[i] * rstd * g4 * (s4 + 1.f) + h4;
                u32x2 wv; wv.x = cvt_pk_bf16(o.x, o.y); wv.y = cvt_pk_bf16(o.z, o.w); *(u32x2*)(dst + (size_t)row * DM + col) = wv; } }
        f32x4 a0 = (f32x4){0.f, 0.f, 0.f, 0.f}, a1 = a0;
        const u16* ap = dst + (size_t)(row0 + (fr & 7)) * DM + fq * 8; const u16* bp = wdt + (size_t)fr * 2048 + fq * 8;
        asm volatile("s_waitcnt vmcnt(0)" ::: "memory");
#pragma unroll 8
        for (int ks = 0; ks < 64; ++ks) { const bf16x8 a = *(const bf16x8*)(ap + ks * 32), b0 = *(const bf16x8*)(bp + ks * 32), b1 = *(const bf16x8*)(bp + 16 * 2048 + ks * 32);
            a0 = MFMA16(a, b0, a0); a1 = MFMA16(a, b1, a1); }
        if (fq < 2) {
#pragma unroll
            for (int j = 0; j < 4; ++j) { const float v0 = a0[j] + dt_bias[fr], v1 = a1[j] + dt_bias[16 + fr]; float* dp = DT + (size_t)(row0 + fq * 4 + j) * 32;
                dp[fr] = v0 > 20.f ? v0 : log1pf(__expf(v0)); dp[16 + fr] = v1 > 20.f ? v1 : log1pf(__expf(v1)); } }
    }
}

__device__ __forceinline__ void conv_tile4(const u32x4 (&raw)[11], const int jh, const float* __restrict__ cw, const float* __restrict__ cbp, float (&o)[8][4]) {
    const f32x4 w0 = *(const f32x4*)(cw + jh * 4), w1 = *(const f32x4*)(cw + 3072 + jh * 4), w2 = *(const f32x4*)(cw + 6144 + jh * 4), w3 = *(const f32x4*)(cw + 9216 + jh * 4), bb = *(const f32x4*)(cbp + jh * 4);
    f32x4 xr[11];
#pragma unroll
    for (int k = 0; k < 11; ++k) { const unsigned a = jh ? raw[k].z : raw[k].x, b2 = jh ? raw[k].w : raw[k].y; xr[k] = (f32x4){bflo(a), bfhi(a), bflo(b2), bfhi(b2)}; }
#pragma unroll
    for (int i = 0; i < 8; ++i) { const f32x4 v = bb + w0 * xr[i] + w1 * xr[i + 1] + w2 * xr[i + 2] + w3 * xr[i + 3];
#pragma unroll
        for (int jj = 0; jj < 4; ++jj) o[i][jj] = siluf_(v[jj]); }
}
constexpr int SA_XT = 17408, SA_CS_OFF = 8 * SA_XT, SA_DT_OFF = SA_CS_OFF + 4096, SA_BYTES = SA_DT_OFF + 4096;
__device__ __forceinline__ void ssd_a_item(const Params& p, LAS unsigned char* lds, int item) {
    unsigned char* ws = p.ws;
    const u16* XBC = (const u16*)(ws + WS_X); const float* DT = (const float*)(ws + WS_DT); float* CS = (float*)(ws + WS_CS);
    u16* Bc = (u16*)(ws + WS_BC); u16* Cc = (u16*)(ws + WS_CC); u16* XTG = (u16*)(ws + WS_H); u16* ST = (u16*)(ws + WS_ST);
    u16* BCT = (u16*)(ws + WS_BCT) + (size_t)item * 16384;
    const float* conv_w = p.in[I_CONVW]; const float* conv_b = p.in[I_CONVB];
    const int tid = threadIdx.x, lane = tid & 63, w = __builtin_amdgcn_readfirstlane(tid >> 6), fr = lane & 15, fq = lane >> 4;
    const int b = item >> 8, c = (item >> 2) & 63, g = item & 3, t0 = b * SEQ + c * 128, h = g * 8 + w;
    LAS u16* XT = (LAS u16*)(lds + w * SA_XT);
    LAS float* CSL = (LAS float*)(lds + SA_CS_OFF) + w * 128;
    LAS float* DTL = (LAS float*)(lds + SA_DT_OFF) + w * 128;
    { const float ah = -__expf(p.in[I_ALOG][h]); float carry = 0.f;
#pragma unroll
      for (int half = 0; half < 2; ++half) { const int l = lane + 64 * half; const float dtv = DT[(size_t)(t0 + l) * 32 + h]; float v = dtv * ah;
#pragma unroll
          for (int off = 1; off < 64; off <<= 1) { const float nb = __shfl_up(v, off); if (lane >= off) v += nb; }
          v += carry; carry = __shfl(v, 63);
          CSL[l] = v; DTL[l] = dtv; CS[((size_t)(b * 64 + c) * 32 + h) * 128 + l] = v; } }
    { const int cgx = tid & 31, l0 = (tid >> 5) * 8; const bool isC = cgx >= 16; const int n0 = (cgx & 15) * 8;
      const int col0 = 2048 + (isC ? 512 : 0) + g * 128 + n0;
      u32x4 raw[11];
#pragma unroll
      for (int k = 0; k < 11; ++k) { const int l = l0 - 3 + k; raw[k] = (u32x4){0u, 0u, 0u, 0u}; if (c * 128 + l >= 0) raw[k] = *(const u32x4*)(XBC + (size_t)((long)t0 + l) * 3072 + col0); }
      u16* op = (isC ? Cc : Bc) + (size_t)(t0 + l0) * 512 + g * 128 + n0;
#pragma unroll
      for (int jh = 0; jh < 2; ++jh) { float o[8][4]; conv_tile4(raw, jh, conv_w + col0, conv_b + col0, o);
#pragma unroll
          for (int i = 0; i < 8; ++i) { u32x2 wv; wv.x = cvt_pk_bf16(o[i][0], o[i][1]); wv.y = cvt_pk_bf16(o[i][2], o[i][3]); *(u32x2*)(op + (size_t)i * 512 + jh * 4) = wv; }
          if (!isC) {
#pragma unroll
              for (int j = 0; j < 4; ++j) { const float f[8] = {o[0][j], o[1][j], o[2][j], o[3][j], o[4][j], o[5][j], o[6][j], o[7][j]}; *(bf16x8*)(BCT + (size_t)(n0 + jh * 4 + j) * 128 + l0) = pack8(f); } } } }
    { const int p0 = (lane & 7) * 8, rg = lane >> 3, col0 = h * 64 + p0;
      u16* xtg = XTG + ((size_t)((b * 64 + c) * 32 + h) * 64) * 128;
      const float cs_end = CSL[127];
#pragma unroll 1
      for (int half = 0; half < 2; ++half) {
          const int l0 = half * 64 + rg * 8;
          u32x4 raw[11];
#pragma unroll
          for (int k = 0; k < 11; ++k) { const int l = l0 - 3 + k; raw[k] = (u32x4){0u, 0u, 0u, 0u}; if (c * 128 + l >= 0) raw[k] = *(const u32x4*)(XBC + (size_t)((long)t0 + l) * 3072 + col0); }
          float scl[8];
#pragma unroll
          for (int i = 0; i < 8; ++i) scl[i] = DTL[l0 + i] * __expf(cs_end - CSL[l0 + i]);
#pragma unroll
          for (int jh = 0; jh < 2; ++jh) { float o[8][4]; conv_tile4(raw, jh, conv_w + col0, conv_b + col0, o);
#pragma unroll
              for (int j = 0; j < 4; ++j) { const float f[8] = {o[0][j], o[1][j], o[2][j], o[3][j], o[4][j], o[5][j], o[6][j], o[7][j]};
                  *(bf16x8*)(xtg + (size_t)(p0 + jh * 4 + j) * 128 + l0) = pack8(f);
                  const float f2[8] = {f[0] * scl[0], f[1] * scl[1], f[2] * scl[2], f[3] * scl[3], f[4] * scl[4], f[5] * scl[5], f[6] * scl[6], f[7] * scl[7]};
                  *(LAS bf16x8*)(XT + (p0 + jh * 4 + j) * 136 + l0) = pack8(f2); } }
      } }
    __syncthreads();
    { f32x4 acc[4][8];
#pragma unroll
      for (int mt = 0; mt < 4; ++mt)
#pragma unroll
          for (int nt = 0; nt < 8; ++nt) acc[mt][nt] = (f32x4){0.f, 0.f, 0.f, 0.f};
#pragma unroll 1
      for (int kk = 0; kk < 4; ++kk) { bf16x8 xf[4];
#pragma unroll
          for (int mt = 0; mt < 4; ++mt) xf[mt] = *(const LAS bf16x8*)(XT + (mt * 16 + fr) * 136 + kk * 32 + fq * 8);
#pragma unroll
          for (int nt = 0; nt < 8; ++nt) { const bf16x8 bf = *(const bf16x8*)(BCT + (size_t)(nt * 16 + fr) * 128 + kk * 32 + fq * 8);
#pragma unroll
              for (int mt = 0; mt < 4; ++mt) acc[mt][nt] = MFMA16(bf, xf[mt], acc[mt][nt]); } }
      u16* sp = ST + ((size_t)((b * 64 + c) * 32 + h) * 64) * 128;
#pragma unroll
      for (int mt = 0; mt < 4; ++mt)
#pragma unroll
          for (int nt = 0; nt < 8; ++nt) { u32x2 wv; wv.x = cvt_pk_bf16(acc[mt][nt][0], acc[mt][nt][1]); wv.y = cvt_pk_bf16(acc[mt][nt][2], acc[mt][nt][3]);
              *(u32x2*)(sp + (mt * 16 + fr) * 128 + nt * 16 + fq * 4) = wv; }
    }
    __syncthreads();
}

#define SC_LBAR() do { asm volatile("s_waitcnt lgkmcnt(0)" ::: "memory"); __builtin_amdgcn_s_barrier(); asm volatile("" ::: "memory"); } while (0)
constexpr int SC_CBW = 8448, SC_ZY = 2304, SC_ZY_OFF = 8 * SC_CBW, SC_CS_OFF = SC_ZY_OFF + 8 * SC_ZY, SC_DT_OFF = SC_CS_OFF + 4096, SC_PV_OFF = SC_DT_OFF + 4096, SC_XT_OFF = SC_PV_OFF + 17408, SC_BYTES = SC_XT_OFF + 17408;
static_assert(SC_BYTES <= LDS_PHASE_BYTES, "ssd_c LDS");
__device__ __forceinline__ void ssd_c_item(const Params& p, LAS unsigned char* lds, int item) {
    unsigned char* ws = p.ws;
    const float* DT = (const float*)(ws + WS_DT); const float* CS = (const float*)(ws + WS_CS);
    const u16* Bc = (const u16*)(ws + WS_BC); const u16* Cc = (const u16*)(ws + WS_CC); const u16* XTG = (const u16*)(ws + WS_H); const u16* ST = (const u16*)(ws + WS_ST);
    const u16* Z = (const u16*)(ws + WS_Z); u16* YA = (u16*)(ws + WS_YA);
    const int tid = threadIdx.x, lane = tid & 63, w = __builtin_amdgcn_readfirstlane(tid >> 6), fr = lane & 15, fq = lane >> 4;
    const int b = item >> 8, c = (item >> 2) & 63, g = item & 3, t0 = b * SEQ + c * 128;
    const int mb = (w < 4) ? w : 11 - w;
    LAS float* CBW = (LAS float*)(lds + w * SC_CBW);
    LAS u16* ZY = (LAS u16*)(lds + SC_ZY_OFF + w * SC_ZY);
    LAS float* CSL = (LAS float*)(lds + SC_CS_OFF);
    LAS float* DTL = (LAS float*)(lds + SC_DT_OFF);
    LAS u16* PV = (LAS u16*)(lds + SC_PV_OFF);
    LAS u16* XS = (LAS u16*)(lds + SC_XT_OFF);
#pragma unroll
    for (int i = 0; i < 2; ++i) { const int idx = tid + 512 * i, hd = idx >> 7, l = idx & 127;
        CSL[idx] = CS[((size_t)(b * 64 + c) * 32 + g * 8 + hd) * 128 + l]; DTL[idx] = DT[(size_t)(t0 + l) * 32 + g * 8 + hd]; }
    const int la = 16 * mb + fr;
    bf16x8 afc[4];
#pragma unroll
    for (int kk = 0; kk < 4; ++kk) afc[kk] = *(const bf16x8*)(Cc + (size_t)(t0 + la) * 512 + g * 128 + kk * 32 + fq * 8);
    { LAS u16* BCL = (LAS u16*)(lds + SC_PV_OFF);
#pragma unroll
      for (int i = 0; i < 4; ++i) { const int q = tid + 512 * i, row = q >> 4, cc = q & 15;
          *(LAS u32x4*)(BCL + row * 136 + cc * 8) = *(const u32x4*)(Bc + (size_t)(t0 + row) * 512 + g * 128 + cc * 8); }
      __syncthreads();
#pragma unroll
      for (int st = 0; st < 8; ++st) { f32x4 acc = (f32x4){0.f, 0.f, 0.f, 0.f};
#pragma unroll
          for (int kk = 0; kk < 4; ++kk) { const bf16x8 bf = *(const LAS bf16x8*)(BCL + (st * 16 + fr) * 136 + kk * 32 + fq * 8); acc = MFMA16(afc[kk], bf, acc); }
#pragma unroll
          for (int j = 0; j < 4; ++j) CBW[(fq * 4 + j) * 132 + st * 16 + fr] = acc[j]; } }
    float ssq[4] = {0.f, 0.f, 0.f, 0.f};
    u32x4 rpv[2], rxs[2], rz[2];
    { const size_t hb = ((size_t)((b * 64 + c) * 32 + g * 8) * 64) * 128;
#pragma unroll
      for (int i = 0; i < 2; ++i) { const int q = tid + 512 * i, row = q >> 4, cc = q & 15; rpv[i] = *(const u32x4*)(ST + hb + row * 128 + cc * 8); rxs[i] = *(const u32x4*)(XTG + hb + row * 128 + cc * 8); }
#pragma unroll
      for (int i = 0; i < 2; ++i) { const int q = lane + 64 * i, row = q >> 3, cc = q & 7; rz[i] = *(const u32x4*)(Z + (size_t)(t0 + 16 * mb + row) * DM + g * 512 + cc * 8); } }
#pragma unroll 1
    for (int r = 0; r < 8; ++r) {
        const int h = g * 8 + r;
        const u16* xtg = XTG + ((size_t)((b * 64 + c) * 32 + h) * 64) * 128;
        const u16* pvg = ST + ((size_t)((b * 64 + c) * 32 + h) * 64) * 128;
        SC_LBAR();
#pragma unroll
        for (int i = 0; i < 2; ++i) { const int q = tid + 512 * i, row = q >> 4, cc = q & 15;
            *(LAS u32x4*)(PV + row * 136 + cc * 8) = rpv[i]; *(LAS u32x4*)(XS + row * 136 + cc * 8) = rxs[i]; }
#pragma unroll
        for (int i = 0; i < 2; ++i) { const int q = lane + 64 * i, row = q >> 3, cc = q & 7;
            *(LAS u32x4*)(ZY + row * 72 + cc * 8) = rz[i]; }
        SC_LBAR();
        if (r < 7) {
#pragma unroll
            for (int i = 0; i < 2; ++i) { const int q = tid + 512 * i, row = q >> 4, cc = q & 15;
                rpv[i] = *(const u32x4*)(pvg + 8192 + row * 128 + cc * 8); rxs[i] = *(const u32x4*)(xtg + 8192 + row * 128 + cc * 8); }
#pragma unroll
            for (int i = 0; i < 2; ++i) { const int q = lane + 64 * i, row = q >> 3, cc = q & 7;
                rz[i] = *(const u32x4*)(Z + (size_t)(t0 + 16 * mb + row) * DM + (h + 1) * 64 + cc * 8); }
        }
        const float csl = CSL[r * 128 + la], Dh = p.in[I_DSSD][h];
        f32x4 accd[4], acco[4];
#pragma unroll
        for (int pt = 0; pt < 4; ++pt) { accd[pt] = (f32x4){0.f, 0.f, 0.f, 0.f}; acco[pt] = (f32x4){0.f, 0.f, 0.f, 0.f}; }
#pragma unroll
        for (int kk = 0; kk < 4; ++kk) {
#pragma unroll
            for (int pt = 0; pt < 4; ++pt) { const bf16x8 pf = *(const LAS bf16x8*)(PV + (pt * 16 + fr) * 136 + kk * 32 + fq * 8); acco[pt] = MFMA16(afc[kk], pf, acco[pt]); }
            if (kk * 32 <= 16 * mb + 15) {
                const int s0 = kk * 32 + fq * 8; float mv[8];
#pragma unroll
                for (int i = 0; i < 8; ++i) { const int s = s0 + i; const float e = CBW[fr * 132 + s] * __expf(csl - CSL[r * 128 + s]) * DTL[r * 128 + s]; mv[i] = (s <= la) ? e : 0.f; }
                const bf16x8 afm = pack8(mv);
#pragma unroll
                for (int pt = 0; pt < 4; ++pt) { const bf16x8 xf = *(const LAS bf16x8*)(XS + (pt * 16 + fr) * 136 + kk * 32 + fq * 8); accd[pt] = MFMA16(afm, xf, accd[pt]); }
            }
        }
        float el[4];
#pragma unroll
        for (int j = 0; j < 4; ++j) el[j] = __expf(CSL[r * 128 + 16 * mb + fq * 4 + j]);
#pragma unroll
        for (int pt = 0; pt < 4; ++pt) {
            const u32x2 xr = *(const LAS u32x2*)(XS + (pt * 16 + fr) * 136 + 16 * mb + fq * 4);
            const float xv[4] = {bflo(xr.x), bfhi(xr.x), bflo(xr.y), bfhi(xr.y)};
#pragma unroll
            for (int j = 0; j < 4; ++j) { const float y = accd[pt][j] + el[j] * acco[pt][j] + Dh * xv[j];
                LAS u16* zp = ZY + (fq * 4 + j) * 72 + pt * 16 + fr;
                const float v = y * siluf_(bf2f(*zp)); ssq[j] += v * v; *zp = f2bf(v); }
        }
#pragma unroll
        for (int i = 0; i < 2; ++i) { const int q = lane + 64 * i, row = q >> 3, cc = q & 7;
            *(u32x4*)(YA + (size_t)(t0 + 16 * mb + row) * DM + h * 64 + cc * 8) = *(const LAS u32x4*)(ZY + row * 72 + cc * 8); }
    }
#pragma unroll
    for (int j = 0; j < 4; ++j) { float s = ssq[j]; s += __shfl_xor(s, 1); s += __shfl_xor(s, 2); s += __shfl_xor(s, 4); s += __shfl_xor(s, 8);
        if (fr == 0) CBW[fq * 4 + j] = rsqrtf(s * (1.f / 512.f) + 1e-6f); }
    const float* nw = p.in[I_SNW];
    asm volatile("s_waitcnt vmcnt(0)" ::: "memory");
    { u16* ybase = YA + (size_t)(t0 + 16 * mb) * DM + g * 512 + lane * 8;
      const f32x4 n0 = *(const f32x4*)(nw + g * 512 + lane * 8), n1 = *(const f32x4*)(nw + g * 512 + lane * 8 + 4);
#pragma unroll
      for (int hb = 0; hb < 2; ++hb) { u32x4 v[8];
#pragma unroll
          for (int i = 0; i < 8; ++i) v[i] = *(const u32x4*)(ybase + (size_t)(hb * 8 + i) * DM);
#pragma unroll
          for (int i = 0; i < 8; ++i) { const float rsv = CBW[hb * 8 + i];
              const float f[8] = {bflo(v[i].x) * rsv * n0.x, bfhi(v[i].x) * rsv * n0.y, bflo(v[i].y) * rsv * n0.z, bfhi(v[i].y) * rsv * n0.w, bflo(v[i].z) * rsv * n1.x, bfhi(v[i].z) * rsv * n1.y, bflo(v[i].w) * rsv * n1.z, bfhi(v[i].w) * rsv * n1.w};
              *(bf16x8*)(ybase + (size_t)(hb * 8 + i) * DM) = pack8(f); } } }
    __syncthreads();
}

template <bool OUT>
__device__ __forceinline__ void s5_item(const Params& p, LAS unsigned char* lds, int item) {
    unsigned char* ws = p.ws;
    const u16* U = (const u16*)(ws + WS_U); const u16* BBAR = (const u16*)(ws + WS_BBAR); const u16* CM = (const u16*)(ws + WS_CM);
    const f32x2* AV = (const f32x2*)(ws + WS_AV); f32x2* SEND = (f32x2*)(ws + WS_SEND); const f32x2* SINIT = (const f32x2*)(ws + WS_SINIT); u16* YB = (u16*)(ws + WS_YB);
    const int tid = threadIdx.x, lane = tid & 63, w = __builtin_amdgcn_readfirstlane(tid >> 6), fr = lane & 15, fq = lane >> 4;
    const int b = item >> 11, tc = (item >> 6) & 31, g = item & 63;
    LAS float* L = (LAS float*)(lds + w * 16896);
    LAS u16* OT = (LAS u16*)(lds + 8 * 16896 + w * 1024);
    const f32x2 a = AV[g * 64 + lane]; const float ar = a.x, ai = a.y;
    float sre = 0.f, sim = 0.f;
    if (OUT) { const f32x2 s0 = SINIT[((size_t)(b * 32 + tc) * 64 + g) * 64 + lane]; sre = s0.x; sim = s0.y; }
    const bf16x8 zero8 = (bf16x8){0, 0, 0, 0, 0, 0, 0, 0};
    bf16x8 bfr[8];
#pragma unroll
    for (int nt = 0; nt < 8; ++nt) { bfr[nt] = zero8; if (fq < 2) bfr[nt] = *(const bf16x8*)(BBAR + ((size_t)(g * 128 + nt * 16 + fr)) * 16 + fq * 8); }
    bf16x8 cfr[4], dfr = zero8;
    if (OUT) {
#pragma unroll
        for (int kk = 0; kk < 4; ++kk) cfr[kk] = *(const bf16x8*)(CM + ((size_t)(g * 16 + fr)) * 128 + kk * 32 + fq * 8);
        const unsigned dv = (unsigned)f2bf(p.in[I_S5D][g * 16 + fr]); const int kpos = fr - fq * 8; u32x4 dw = (u32x4){0u, 0u, 0u, 0u};
        if (kpos >= 0 && kpos < 8) { const unsigned word = (kpos & 1) ? (dv << 16) : dv; if ((kpos >> 1) == 0) dw.x = word; else if ((kpos >> 1) == 1) dw.y = word; else if ((kpos >> 1) == 2) dw.z = word; else dw.w = word; }
        dfr = __builtin_bit_cast(bf16x8, dw);
    }
    const size_t ubase = (size_t)(b * SEQ + tc * 256) * 1024 + g * 16 + (fq & 1) * 8;
    bf16x8 afn[2];
#pragma unroll
    for (int mt = 0; mt < 2; ++mt) { afn[mt] = zero8; if (fq < 2) afn[mt] = *(const bf16x8*)(U + ubase + (size_t)(mt * 16 + fr) * 1024); }
#pragma unroll 1
    for (int sb = 0; sb < 8; ++sb) {
        const int tok0 = b * SEQ + tc * 256 + sb * 32;
        bf16x8 af[2] = {afn[0], afn[1]};
        if (sb < 7) {
#pragma unroll
            for (int mt = 0; mt < 2; ++mt) if (fq < 2) afn[mt] = *(const bf16x8*)(U + ubase + (size_t)((sb + 1) * 32 + mt * 16 + fr) * 1024);
        }
#pragma unroll
        for (int mt = 0; mt < 2; ++mt) {
#pragma unroll
            for (int nt = 0; nt < 8; ++nt) { const f32x4 r = MFMA16(af[mt], bfr[nt], ((f32x4){0.f, 0.f, 0.f, 0.f}));
#pragma unroll
                for (int j = 0; j < 4; ++j) L[(mt * 16 + fq * 4 + j) * 132 + nt * 16 + fr] = r[j]; } }
#pragma unroll 8
        for (int t = 0; t < 32; ++t) { const float bre = L[t * 132 + lane], bim = L[t * 132 + 64 + lane];
            const float nre = ar * sre - ai * sim + bre, nim = ar * sim + ai * sre + bim; sre = nre; sim = nim;
            if (OUT) { L[t * 132 + lane] = sre; L[t * 132 + 64 + lane] = sim; } }
        if (OUT) {
#pragma unroll
            for (int mt = 0; mt < 2; ++mt) { f32x4 acc = MFMA16(af[mt], dfr, ((f32x4){0.f, 0.f, 0.f, 0.f}));
#pragma unroll
                for (int kk = 0; kk < 4; ++kk) { float f[8];
#pragma unroll
                    for (int i = 0; i < 8; ++i) f[i] = L[(mt * 16 + fr) * 132 + kk * 32 + fq * 8 + i];
                    acc = MFMA16(pack8(f), cfr[kk], acc); }
#pragma unroll
                for (int j = 0; j < 4; ++j) OT[(mt * 16 + fq * 4 + j) * 16 + fr] = f2bf(gelu_tanh(acc[j])); }
            *(u32x4*)(YB + (size_t)(tok0 + (lane >> 1)) * 1024 + g * 16 + (lane & 1) * 8) = *(const LAS u32x4*)(OT + lane * 8);
        }
    }
    if (!OUT) SEND[((size_t)(b * 32 + tc) * 64 + g) * 64 + lane] = (f32x2){sre, sim};
}

#define XB_TMO      128
#define XB_XCNT(j)  (256  + 64 * (j))
#define XB_XSUB(j)  (1280 + 64 * (j))
#define XB_XGEN(j)  (2304 + 64 * (j))
#define XB_TOP      3328
#define XB_TOPGEN   3392
#define XCD_BAR_WORDS 3456
#define XB_SPIN_CAP (1u << 23)
__device__ __forceinline__ unsigned xb_ld(unsigned* p)              { return __hip_atomic_load(p, __ATOMIC_RELAXED, __HIP_MEMORY_SCOPE_AGENT); }
__device__ __forceinline__ unsigned xb_add(unsigned* p, unsigned v) { return __hip_atomic_fetch_add(p, v, __ATOMIC_RELAXED, __HIP_MEMORY_SCOPE_AGENT); }
__device__ __forceinline__ unsigned xb_xcc_id() { return (unsigned)__builtin_amdgcn_s_getreg((3 << 11) | 20) & 0xFu; }
#define XB_SPIN(cond, bar) do { unsigned _sp = 0; while (cond) { __builtin_amdgcn_s_sleep(1); \
    if ((++_sp & 255u) == 0u) { if (xb_ld(&(bar)[XB_TMO])) break; if (_sp > XB_SPIN_CAP) { atomicAdd(&(bar)[XB_TMO], 1u); break; } } } } while (0)
struct XcdBarrier { unsigned* bar; unsigned x; volatile LAS unsigned* st; };
__device__ __forceinline__ XcdBarrier xcd_barrier_post(unsigned* bar, volatile LAS unsigned* st) {
    XcdBarrier b; b.bar = bar; b.x = xb_xcc_id(); b.st = st;
    if (threadIdx.x == 0) (void)xb_add(&bar[XB_XCNT(b.x)], 1u);
    return b;
}
__device__ __forceinline__ void xcd_barrier_complete(unsigned* bar, unsigned x, unsigned& nloc, unsigned& nx) {
    const unsigned G = gridDim.x * gridDim.y * gridDim.z;
    unsigned sum, cnt, mine, sp = 0u;
    for (;;) {
        sum = 0u; cnt = 0u; mine = 0u;
#pragma unroll
        for (unsigned j = 0; j < 16; ++j) { const unsigned c = xb_ld(&bar[XB_XCNT(j)]); sum += c; cnt += (c > 0u) ? 1u : 0u; mine = (j == x) ? c : mine; }
        if (sum == G) break;
        __builtin_amdgcn_s_sleep(1);
        if ((++sp & 255u) == 0u) { if (xb_ld(&bar[XB_TMO])) break; if (sp > XB_SPIN_CAP) { atomicAdd(&bar[XB_TMO], 1u); break; } }
    }
    nloc = mine > 0u ? mine : 1u; nx = cnt > 0u ? cnt : 1u;
}
__device__ __forceinline__ void xcd_barrier(const XcdBarrier& b) {
    asm volatile("s_waitcnt vmcnt(0)" ::: "memory");
    __syncthreads();
    if (threadIdx.x == 0) {
        unsigned* bar = b.bar;
        __builtin_amdgcn_s_waitcnt(0);
        unsigned nloc = b.st[0], nx = b.st[1];
        if (nloc == 0u) { xcd_barrier_complete(bar, b.x, nloc, nx); b.st[0] = nloc; b.st[1] = nx; }
        const unsigned old = xb_add(&bar[XB_XSUB(b.x)], 1u);
        const unsigned gen = old / nloc;
        if (old + 1u == (gen + 1u) * nloc) {
            __builtin_amdgcn_fence(__ATOMIC_RELEASE, "agent");
            asm volatile("s_waitcnt vmcnt(0)" ::: "memory");
            const unsigned og = xb_add(&bar[XB_TOP], 1u);
            const unsigned tg = og / nx;
            if (og + 1u == (tg + 1u) * nx) xb_add(&bar[XB_TOPGEN], 1u);
            else XB_SPIN(xb_ld(&bar[XB_TOPGEN]) == tg, bar);
            __builtin_amdgcn_fence(__ATOMIC_ACQUIRE, "agent");
            xb_add(&bar[XB_XGEN(b.x)], 1u);
            asm volatile("s_waitcnt vmcnt(0)" ::: "memory");
        } else {
            XB_SPIN(xb_ld(&bar[XB_XGEN(b.x)]) == gen, bar);
            __builtin_amdgcn_fence(__ATOMIC_ACQUIRE, "agent");
            asm volatile("s_waitcnt vmcnt(0)" ::: "memory");
        }
    }
    __syncthreads();
}

__global__ void __launch_bounds__(512, 2) mega(Params p) {
    extern __shared__ __attribute__((aligned(16))) unsigned char shm[];
    LAS unsigned char* lds = (LAS unsigned char*)shm;
    cg::grid_group grid = cg::this_grid();
    unsigned char* ws = p.ws;
    const int tid = threadIdx.x, G = gridDim.x, gtid = blockIdx.x * 512 + tid, nthr = G * 512;
    const int lo = p.ph_lo, hi = p.ph_hi;
    float* mods = (float*)(ws + WS_MODS);
    u16* H = (u16*)(ws + WS_H); u16* HID = (u16*)(ws + WS_HID);
#define IN(k) (lo <= (k) && (k) < hi)
    volatile LAS unsigned* xbst = (volatile LAS unsigned*)(lds + LDS_PHASE_BYTES);
    if (tid < 4) xbst[tid] = 0u;
    __syncthreads();
    XcdBarrier xbar = xcd_barrier_post((unsigned*)(ws + WS_BAR), xbst);
#define SYNC(k) do { if (IN(k) && IN((k) + 1)) { if ((k) == 0) grid.sync(); else xcd_barrier(xbar); } } while (0)
#ifndef REP_MASK
#define REP_MASK 0
#endif
#define REP(k) for (int _rep = 0; _rep < (((REP_MASK >> (k)) & 1) ? 2 : 1); ++_rep)

    if (IN(0)) REP(0) {
        LAS float* scl = (LAS float*)lds;
        for (int i = tid; i < 4096; i += 512) scl[i] = siluf_(p.in[I_C][i]);
        __syncthreads();
        float* part = (float*)(ws + WS_PART); const float* wada = p.in[I_WADA];
        for (int it = gtid; it < 32 * 4608; it += nthr) { const int kc = it / 4608, cgp = it % 4608;
            f32x4 a0 = (f32x4){0.f, 0.f, 0.f, 0.f}, a1 = a0; const float* wp = wada + (size_t)(kc * 64) * NMOD + cgp * 4;
#pragma unroll 8
            for (int k = 0; k < 64; ++k) { const f32x4 wv = *(const f32x4*)(wp + (size_t)k * NMOD); a0 += wv * scl[kc * 64 + k]; a1 += wv * scl[2048 + kc * 64 + k]; }
            *(f32x4*)(part + (size_t)(kc * 2 + 0) * NMOD + cgp * 4) = a0; *(f32x4*)(part + (size_t)(kc * 2 + 1) * NMOD + cgp * 4) = a1; }
        u16* BBAR = (u16*)(ws + WS_BBAR); f32x2* AV = (f32x2*)(ws + WS_AV); f32x2* AL = (f32x2*)(ws + WS_AL);
        for (int i = gtid; i < 4096; i += nthr) { const int g = i >> 6;
            const float dt = expf(p.in[I_LOGDT][g]); const float lr = fminf(p.in[I_LRE][i], -1e-4f), li = p.in[I_LIM][i];
            const float mag = expf(lr * dt); const float ar = mag * cosf(li * dt), ai = mag * sinf(li * dt);
            const float den = lr * lr + li * li, nr = ar - 1.f; const float kr = (nr * lr + ai * li) / den, ki = (ai * lr - nr * li) / den;
            const int pp = i & 63;
#pragma unroll
            for (int ii = 0; ii < 16; ++ii) { const float br = p.in[I_BRE][(size_t)i * 16 + ii], bi = p.in[I_BIM][(size_t)i * 16 + ii];
                BBAR[((size_t)(g * 128 + pp)) * 16 + ii] = f2bf(kr * br - ki * bi); BBAR[((size_t)(g * 128 + 64 + pp)) * 16 + ii] = f2bf(kr * bi + ki * br); }
            AV[i] = (f32x2){ar, ai}; float xr = ar, xi = ai;
#pragma unroll
            for (int s = 0; s < 8; ++s) { const float t = xr * xr - xi * xi; xi = 2.f * xr * xi; xr = t; }
            AL[i] = (f32x2){xr, xi}; }
        u16* CM = (u16*)(ws + WS_CM);
        for (int i = gtid; i < 131072; i += nthr) { const int gi = i >> 7, q = i & 127; CM[i] = f2bf(q < 64 ? p.in[I_CRE][(size_t)gi * 64 + q] : -p.in[I_CIM][(size_t)gi * 64 + q - 64]); }
    }
    SYNC(0);
    if (IN(1)) REP(1) {
        const float* part = (const float*)(ws + WS_PART);
        for (int i = gtid; i < 2 * NMOD; i += nthr) { const int b = i / NMOD, j = i % NMOD; float s = p.in[I_BADA][j];
#pragma unroll 8
            for (int kc = 0; kc < 32; ++kc) s += part[(size_t)(kc * 2 + b) * NMOD + j];
            mods[i] = s; }
        int tb = 0; LAS float* T = (LAS float*)lds;
        conv_weight(T, p.in[I_W1IN], (u16*)(ws + WS_W1IN), 2048, 2 * FF, 2 * FF, 0, tb, true);
        conv_weight(T, p.in[I_W1OUT], (u16*)(ws + WS_W1OUT), FF, 2048, 2048, 1, tb);
        conv_weight(T, p.in[I_WIN], (u16*)(ws + WS_WIN), 2048, 10272, NPROJ_C, 2, tb);
        conv_weight(T, p.in[I_WA], (u16*)(ws + WS_WA), 2048, 2048, 2048, 1, tb);
        conv_weight(T, p.in[I_WB], (u16*)(ws + WS_WB), 1024, 4096, 4096, 3, tb);
        conv_weight(T, p.in[I_WO], (u16*)(ws + WS_WO), 2048, 2048, 2048, 1, tb);
    }
    SYNC(1);
    if (IN(2)) REP(2) norm_rows<0, true>(p.in[I_X], p.in[I_NF1], mods + 0 * DM, mods + 1 * DM, H, nullptr);
    SYNC(2);
    if (IN(3)) REP(3) { pg8::Gemm g{H, (const u16*)(ws + WS_W1IN), M_TOK, 2 * FF, 2048}; pg8::StaticOrder S; S.init(M_TOK, 2 * FF, G, blockIdx.x); EpiSwiglu E{HID}; pg8::gemm_phase<EpiSwiglu, true, true>(lds, g, S, E); }
    SYNC(3);
    if (IN(4)) REP(4) { pg8::Gemm g{HID, (const u16*)(ws + WS_W1OUT), M_TOK, 2048, FF}; pg8::StaticOrder S; S.init(M_TOK, 2048, G, blockIdx.x, true); EpiResid E{p.in[I_X], p.out, mods + 2 * DM, 0.5f}; pg8::gemm_phase(lds, g, S, E); }
    SYNC(4);
    if (IN(5)) REP(5) {
        norm_dt_rows(p.out, p.in[I_NMIX], mods + 3 * DM, mods + 4 * DM, H, (const u16*)(ws + WS_WIN) + (size_t)NPROJ_G * 2048, p.in[I_DTB], (float*)(ws + WS_DT));
        int tb = 0; LAS float* T = (LAS float*)lds;
        conv_weight(T, p.in[I_W2IN], (u16*)(ws + WS_W1IN), 2048, 2 * FF, 2 * FF, 0, tb, true);
        conv_weight(T, p.in[I_W2OUT], (u16*)(ws + WS_W1OUT), FF, 2048, 2048, 1, tb);
    }
    SYNC(5);
    if (IN(6)) REP(6) { pg8::Gemm g{H, (const u16*)(ws + WS_WIN), M_TOK, NPROJ_G, 2048}; pg8::StaticOrder S; S.init(M_TOK, NPROJ_G, G, blockIdx.x);
        EpiProj E{(u16*)(ws + WS_Z), (u16*)(ws + WS_X), (u16*)(ws + WS_U), (u16*)(ws + WS_G), (float*)(ws + WS_DT), p.in[I_DTB]}; pg8::gemm_phase(lds, g, S, E); }
    SYNC(6);
    if (IN(7)) REP(7) {
        __syncthreads();
        REP(17) for (int it = blockIdx.x; it < 512; it += G) ssd_a_item(p, lds, it);
        REP(18) for (int it = blockIdx.x * 8 + (tid >> 6); it < 4096; it += G * 8) s5_item<false>(p, lds, it);
    }
    SYNC(7);
    if (IN(8)) REP(8) {
        u16* ST = (u16*)(ws + WS_ST); const float* CS = (const float*)(ws + WS_CS);
        for (int idx = gtid; idx < 131072; idx += nthr) { const int n4 = idx & 31, pp = (idx >> 5) & 63, h = (idx >> 11) & 31, b = idx >> 16;
            float run[4] = {0.f, 0.f, 0.f, 0.f};
#pragma unroll 1
            for (int cb = 0; cb < 64; cb += 16) {
                u32x2 sv[16]; float cse[16];
#pragma unroll
                for (int i = 0; i < 16; ++i) { const size_t hc = (size_t)((b * 64 + cb + i) * 32 + h); sv[i] = *(const u32x2*)(ST + (hc * 64 + pp) * 128 + n4 * 4); cse[i] = CS[hc * 128 + 127]; }
                asm volatile("" ::: "memory");
#pragma unroll
                for (int i = 0; i < 16; ++i) { const size_t hc = (size_t)((b * 64 + cb + i) * 32 + h); const float dec = __expf(cse[i]);
                    u32x2 o; o.x = cvt_pk_bf16(run[0], run[1]); o.y = cvt_pk_bf16(run[2], run[3]); *(u32x2*)(ST + (hc * 64 + pp) * 128 + n4 * 4) = o;
                    run[0] = dec * run[0] + bflo(sv[i].x); run[1] = dec * run[1] + bfhi(sv[i].x); run[2] = dec * run[2] + bflo(sv[i].y); run[3] = dec * run[3] + bfhi(sv[i].y); }
                asm volatile("" ::: "memory");
            } }
        const f32x2* AL = (const f32x2*)(ws + WS_AL); const f32x2* SEND = (const f32x2*)(ws + WS_SEND); f32x2* SINIT = (f32x2*)(ws + WS_SINIT);
        for (int idx = gtid; idx < 8192; idx += nthr) { const int gp = idx & 4095, b = idx >> 12; const f32x2 a = AL[gp]; float sr = 0.f, si = 0.f;
            f32x2 ev[32];
#pragma unroll
            for (int tc = 0; tc < 32; ++tc) ev[tc] = SEND[(size_t)(b * 32 + tc) * 4096 + gp];
            asm volatile("" ::: "memory");
#pragma unroll
            for (int tc = 0; tc < 32; ++tc) { SINIT[(size_t)(b * 32 + tc) * 4096 + gp] = (f32x2){sr, si};
                const float nr = a.x * sr - a.y * si + ev[tc].x, ni = a.x * si + a.y * sr + ev[tc].y; sr = nr; si = ni; } }
    }
    SYNC(8);
    if (IN(9)) REP(9) {
        __syncthreads();
        REP(19) for (int it = blockIdx.x; it < 512; it += G) ssd_c_item(p, lds, it);
        REP(20) for (int it = blockIdx.x * 8 + (tid >> 6); it < 4096; it += G * 8) s5_item<true>(p, lds, it);
    }
    SYNC(9);
    if (IN(10)) REP(10) { pg8::Gemm g{(const u16*)(ws + WS_YB), (const u16*)(ws + WS_WB), M_TOK, 4096, 1024}; pg8::StaticOrder S; S.init(M_TOK, 4096, G, blockIdx.x); EpiGlu E{(u16*)(ws + WS_MB), (const u16*)(ws + WS_G)}; pg8::gemm_phase(lds, g, S, E); }
    SYNC(10);
    if (IN(11)) REP(11) { pg8::Gemm g{(const u16*)(ws + WS_YA), (const u16*)(ws + WS_WA), M_TOK, 2048, 2048}; pg8::StaticOrder S; S.init(M_TOK, 2048, G, blockIdx.x); EpiMerge E{H, (const u16*)(ws + WS_G), (const u16*)(ws + WS_MB)}; pg8::gemm_phase(lds, g, S, E); }
    SYNC(11);
    if (IN(12)) REP(12) { pg8::Gemm g{H, (const u16*)(ws + WS_WO), M_TOK, 2048, 2048}; pg8::StaticOrder S; S.init(M_TOK, 2048, G, blockIdx.x); EpiResid E{p.out, p.out, mods + 5 * DM, 1.0f}; pg8::gemm_phase(lds, g, S, E); }
    SYNC(12);
    if (IN(13)) REP(13) norm_rows<0>(p.out, p.in[I_NF2], mods + 6 * DM, mods + 7 * DM, H, nullptr);
    SYNC(13);
    if (IN(14)) REP(14) { pg8::Gemm g{H, (const u16*)(ws + WS_W1IN), M_TOK, 2 * FF, 2048}; pg8::StaticOrder S; S.init(M_TOK, 2 * FF, G, blockIdx.x); EpiSwiglu E{HID}; pg8::gemm_phase<EpiSwiglu, false, true>(lds, g, S, E); }
    SYNC(14);
    if (IN(15)) REP(15) { pg8::Gemm g{HID, (const u16*)(ws + WS_W1OUT), M_TOK, 2048, FF}; pg8::StaticOrder S; S.init(M_TOK, 2048, G, blockIdx.x, true); EpiResid E{p.out, p.out, mods + 8 * DM, 0.5f}; pg8::gemm_phase(lds, g, S, E); }
    SYNC(15);
    if (IN(16)) REP(16) norm_rows<1>(p.out, p.in[I_NFIN], nullptr, nullptr, nullptr, p.out);
#undef IN
#undef SYNC
}

#ifndef MK_SPLIT
#define MK_SPLIT 0
#endif
extern "C" void kernel_launch(void* const* d_in, const int* in_sizes, int n_in, void* d_out, int out_size, void* d_ws, size_t ws_size, hipStream_t stream) {
    static int grid = 0;
    if (grid == 0) {
        if (n_in != 30 || ws_size < WS_END) { fprintf(stderr, "kernel_launch: n_in %d ws %zu (need %zu)\n", n_in, ws_size, (size_t)WS_END); grid = -1; return; }
        int dev = 0, cus = 0, per_cu = 0;
        (void)hipGetDevice(&dev); (void)hipDeviceGetAttribute(&cus, hipDeviceAttributeMultiprocessorCount, dev);
        (void)hipFuncSetAttribute((const void*)mega, hipFuncAttributeMaxDynamicSharedMemorySize, LDS_BYTES);
        (void)hipOccupancyMaxActiveBlocksPerMultiprocessor(&per_cu, (const void*)mega, 512, LDS_BYTES);
        if (per_cu < 1) per_cu = 1;
        grid = cus * per_cu; if (grid > 256) grid = 256;
    }
    if (grid < 0) return;
    Params p{};
    for (int i = 0; i < 30; ++i) p.in[i] = (const float*)d_in[i];
    p.out = (float*)d_out; p.ws = (unsigned char*)d_ws;
    (void)hipMemsetAsync((unsigned char*)d_ws + WS_BAR, 0, 16384, stream);
#if MK_SPLIT
    for (int ph = 0; ph < NPH; ++ph) { p.ph_lo = ph; p.ph_hi = ph + 1; void* args[] = {&p};
        (void)hipLaunchCooperativeKernel((void*)mega, dim3(grid), dim3(512), args, LDS_BYTES, stream); }
#else
    p.ph_lo = 0; p.ph_hi = NPH; void* args[] = {&p};
    hipError_t e = hipLaunchCooperativeKernel((void*)mega, dim3(grid), dim3(512), args, LDS_BYTES, stream);
    if (e != hipSuccess) fprintf(stderr, "cooperative launch failed: %s (grid %d)\n", hipGetErrorString(e), grid);
#endif
}
```

```cpp
#include <hip/hip_runtime.h>
#include <hip/hip_cooperative_groups.h>
#include <cstdio>
#define REP_MASK 0
namespace cg = cooperative_groups;

#define LAS __attribute__((address_space(3)))
typedef unsigned short u16;
typedef short bf16x8 __attribute__((ext_vector_type(8)));
typedef float f32x4 __attribute__((ext_vector_type(4)));
typedef float f32x2 __attribute__((ext_vector_type(2)));
typedef unsigned u32x4 __attribute__((ext_vector_type(4)));
typedef unsigned u32x2 __attribute__((ext_vector_type(2)));

constexpr int M_TOK = 16384, DM = 2048, FF = 5504, SEQ = 8192;
constexpr int NPROJ = 10496;
constexpr int NPROJ_G = 10240, NPROJ_C = 10304;
constexpr int NMOD = 18432;
constexpr int LDS_PHASE_BYTES = 147456;
constexpr int LDS_BYTES = LDS_PHASE_BYTES + 16;
constexpr int NPH = 17;

constexpr size_t WS_W1IN = 0;
constexpr size_t WS_W1OUT = WS_W1IN + (size_t)11008 * 2048 * 2;
constexpr size_t WS_WIN = WS_W1OUT + (size_t)2048 * 5504 * 2;
constexpr size_t WS_WA = WS_WIN + (size_t)NPROJ * 2048 * 2;
constexpr size_t WS_WB = WS_WA + (size_t)2048 * 2048 * 2;
constexpr size_t WS_WO = WS_WB + (size_t)4096 * 1024 * 2;
constexpr size_t WS_H = WS_WO + (size_t)2048 * 2048 * 2;
constexpr size_t WS_HID = WS_H + (size_t)M_TOK * 2048 * 2;
constexpr size_t WS_X = WS_HID + (size_t)M_TOK * FF * 2;
constexpr size_t WS_G = WS_X + (size_t)M_TOK * 3072 * 2;
constexpr size_t WS_MISC = WS_G + (size_t)M_TOK * 4096 * 2;
constexpr size_t WS_Z = WS_HID;
constexpr size_t WS_U = WS_Z + (size_t)M_TOK * 2048 * 2;
constexpr size_t WS_DT = WS_U + (size_t)M_TOK * 1024 * 2;
constexpr size_t WS_CS = WS_DT + (size_t)M_TOK * 32 * 4;
constexpr size_t WS_ST = WS_CS + (size_t)M_TOK * 32 * 4;
constexpr size_t WS_MB = WS_ST;
static_assert(WS_ST + (size_t)M_TOK * 2048 * 2 <= WS_X, "mixer buffers overflow HID");
constexpr size_t WS_BC = WS_WIN;
constexpr size_t WS_CC = WS_BC + (size_t)M_TOK * 512 * 2;
constexpr size_t WS_YA = WS_X;
constexpr size_t WS_YB = WS_YA + (size_t)M_TOK * 2048 * 2;
constexpr size_t WS_PART = WS_MISC;
constexpr size_t WS_MODS = WS_PART + (size_t)32 * 2 * NMOD * 4;
constexpr size_t WS_BBAR = WS_MODS + (size_t)2 * NMOD * 4;
constexpr size_t WS_CM = WS_BBAR + (size_t)64 * 128 * 16 * 2;
constexpr size_t WS_AV = WS_CM + (size_t)64 * 16 * 128 * 2;
constexpr size_t WS_AL = WS_AV + (size_t)4096 * 8;
constexpr size_t WS_SEND = WS_AL + (size_t)4096 * 8;
constexpr size_t WS_SINIT = WS_SEND + (size_t)2 * 32 * 4096 * 8;
constexpr size_t WS_BAR = WS_SINIT + (size_t)2 * 32 * 4096 * 8;
constexpr size_t WS_BCT = WS_BAR + 16384;
constexpr size_t WS_END = WS_BCT + (size_t)512 * 16384 * 2;

struct Params {
    const float* in[30];
    float* out; unsigned char* ws; int ph_lo, ph_hi;
};
enum { I_X = 0, I_C, I_WADA, I_BADA, I_NF1, I_W1IN, I_W1OUT, I_NMIX, I_WIN, I_CONVW, I_CONVB, I_DTB, I_ALOG, I_DSSD, I_SNW, I_WA,
       I_LRE, I_LIM, I_BRE, I_BIM, I_CRE, I_CIM, I_S5D, I_LOGDT, I_WB, I_WO, I_NF2, I_W2IN, I_W2OUT, I_NFIN };

__device__ __forceinline__ unsigned cvt_pk_bf16(float lo, float hi) { unsigned r; asm volatile("v_cvt_pk_bf16_f32 %0, %1, %2" : "=v"(r) : "v"(lo), "v"(hi)); return r; }
__device__ __forceinline__ u16 f2bf(float f) { return (u16)(cvt_pk_bf16(f, 0.f) & 0xffffu); }
__device__ __forceinline__ float bf2f(u16 b) { return __uint_as_float(((unsigned)b) << 16); }
__device__ __forceinline__ float bflo(unsigned w) { return __uint_as_float(w << 16); }
__device__ __forceinline__ float bfhi(unsigned w) { return __uint_as_float(w & 0xffff0000u); }
__device__ __forceinline__ float sigmoidf_(float v) { return __builtin_amdgcn_rcpf(1.f + __expf(-v)); }
__device__ __forceinline__ float siluf_(float v) { return v * sigmoidf_(v); }
__device__ __forceinline__ float gelu_tanh(float v) { const float z = 0.7978845608028654f * (v + 0.044715f * v * v * v); const float t = 1.f - 2.f * __builtin_amdgcn_rcpf(__expf(2.f * z) + 1.f); return 0.5f * v * (1.f + t); }
__device__ __forceinline__ bf16x8 pack8(const float* f) { u32x4 w; w.x = cvt_pk_bf16(f[0], f[1]); w.y = cvt_pk_bf16(f[2], f[3]); w.z = cvt_pk_bf16(f[4], f[5]); w.w = cvt_pk_bf16(f[6], f[7]); return __builtin_bit_cast(bf16x8, w); }
#define MFMA16(a, b, c) __builtin_amdgcn_mfma_f32_16x16x32_bf16((a), (b), (c), 0, 0, 0)

namespace pg8 {
constexpr int BM = 256, BK = 64, HALF = 128, HTB = HALF * BK * 2, STAGE_BYTES = 8 * HTB, NXCD = 8, WGM = 8;
__device__ __forceinline__ int lds_byte(int r, int c) { const int st = (r >> 4) * 2 + (c >> 5), rr = r & 15, cc = c & 31, ob = rr * 64 + cc * 2; return st * 1024 + (ob ^ (((ob >> 9) & 1) << 5)); }
__device__ __forceinline__ void stage_rc(int b, int& R, int& C) { const int st = b / 1024, sb = b % 1024, swz = sb ^ (((sb >> 9) & 1) << 5); R = (st >> 1) * 16 + swz / 64; C = (st & 1) * 32 + (swz % 64) / 2; }
__device__ __forceinline__ int perm32(int rho) { const int n = rho >> 4, i = rho & 15; return 8 * (i >> 2) + 4 * n + (i & 3); }
struct Unit { int pm, pn; };
struct Gemm { const u16* A; const u16* Bt; int M, N, K; };
struct StaticOrder {
    int nM, nN, nwg, G, c; bool pnfast;
    __device__ void init(int M, int N, int G_, int c_, bool pf = false) { nM = M / BM; nN = N / BM; nwg = nM * nN; G = G_; c = c_; pnfast = pf; }
    __device__ bool next(int i, Unit& u) const {
        const long L = (long)i * G + c; if (L >= nwg) return false;
        int wgid = (int)L; { const int q = nwg / NXCD, r = nwg % NXCD, xcd = wgid % NXCD, off = wgid / NXCD; wgid = (xcd < r ? xcd * (q + 1) : r * (q + 1) + (xcd - r) * q) + off; }
        const int nig = WGM * nN, gid = wgid / nig, fm = gid * WGM, gsz = (nM - fm) < WGM ? (nM - fm) : WGM;
        if (pnfast) { u.pm = fm + (wgid % nig) / nN; u.pn = (wgid % nig) % nN; } else { u.pm = fm + ((wgid % nig) % gsz); u.pn = (wgid % nig) / gsz; }
        return true;
    }
};

template <class Epi, bool TA = false, bool TB = false>
__device__ __forceinline__ void gemm_phase(LAS unsigned char* lds, const Gemm g, const StaticOrder& S, const Epi& E) {
    const int tid = threadIdx.x, wid = __builtin_amdgcn_readfirstlane(tid >> 6), lane = tid & 63, wr = wid >> 2, wc = wid & 3, fr = lane & 15, fq = lane >> 4;
    const int K = g.K, nt = K / BK;
    unsigned voffA[2], voffB[2];
#pragma unroll
    for (int i = 0; i < 2; ++i) { int R, C; stage_rc(tid * 16 + i * 8192, R, C); const int Rb = Epi::PERM ? ((R & ~31) + perm32(R & 31)) : R;
        voffA[i] = (unsigned)(R * (TA ? BK : K) + C) * 2u; voffB[i] = (unsigned)(Rb * (TB ? BK : K) + C) * 2u; }
    const size_t kstepA = TA ? (size_t)HTB : (size_t)(BK * 2), kstepB = TB ? (size_t)HTB : (size_t)(BK * 2);
    const size_t hstepA = TA ? (size_t)nt * HTB : (size_t)HALF * K * 2, hstepB = TB ? (size_t)nt * HTB : (size_t)HALF * K * 2;
    const size_t tstep = (size_t)BM * K * 2;
    const unsigned ldsw = (unsigned)wid * 1024u;
    const int aoff = lds_byte(wr * 64 + fr, fq * 8), boff = lds_byte(wc * 32 + fr, fq * 8);
#define PG8_SA(b, h) (((b) * 2 + (h)) * HTB)
#define PG8_SB(b, h) ((4 + (b) * 2 + (h)) * HTB)
#define PG8_STAGE(bufoff, gbase, voff) do { _Pragma("unroll") for (int _i = 0; _i < 2; ++_i) \
        __builtin_amdgcn_global_load_lds((const unsigned*)((const char*)(gbase) + (voff)[_i]), (LAS unsigned*)(lds + (bufoff) + ldsw + _i * 8192), 16, 0, 0); } while (0)
#define PG8_LDA(dst, b, h) do { _Pragma("unroll") for (int m = 0; m < 4; ++m) _Pragma("unroll") for (int k = 0; k < 2; ++k) dst[m][k] = *(const LAS bf16x8*)(lds + PG8_SA(b, h) + aoff + m * 2048 + k * 1024); } while (0)
#define PG8_LDB(dst, b, h) do { _Pragma("unroll") for (int n = 0; n < 2; ++n) _Pragma("unroll") for (int k = 0; k < 2; ++k) dst[n][k] = *(const LAS bf16x8*)(lds + PG8_SB(b, h) + boff + n * 2048 + k * 1024); } while (0)
#define PG8_MMA(ai, bj, At, Bt) do { __builtin_amdgcn_s_setprio(1); _Pragma("unroll") for (int m = 0; m < 4; ++m) _Pragma("unroll") for (int n = 0; n < 2; ++n) _Pragma("unroll") for (int k = 0; k < 2; ++k) \
        acc[ai][bj][m][n] = __builtin_amdgcn_mfma_f32_16x16x32_bf16(Bt[n][k], At[m][k], acc[ai][bj][m][n], 0, 0, 0); __builtin_amdgcn_s_setprio(0); } while (0)
#define PG8_WAIT_V(n) asm volatile("s_waitcnt vmcnt(" #n ")" ::: "memory")
#define PG8_WAIT_L(n) asm volatile("s_waitcnt lgkmcnt(" #n ")" ::: "memory")
#define PG8_BAR __builtin_amdgcn_s_barrier()
#define PG8_SCHED __builtin_amdgcn_sched_barrier(0)
    Unit cur, nxt; int ui = 0;
    if (!S.next(0, cur)) return;
    f32x4 acc[2][2][4][2];
#pragma unroll
    for (int a = 0; a < 2; ++a)
#pragma unroll
        for (int b = 0; b < 2; ++b)
#pragma unroll
            for (int m = 0; m < 4; ++m)
#pragma unroll
                for (int n = 0; n < 2; ++n) acc[a][b][m][n] = (f32x4){0.f, 0.f, 0.f, 0.f};
    bf16x8 At[4][2], B0[2][2], B1[2][2];
    const char* cA = (const char*)g.A + (size_t)cur.pm * tstep; const char* cB = (const char*)g.Bt + (size_t)cur.pn * tstep;
    PG8_STAGE(PG8_SB(0, 0), cB, voffB); PG8_STAGE(PG8_SA(0, 0), cA, voffA); PG8_STAGE(PG8_SB(0, 1), cB + hstepB, voffB); PG8_STAGE(PG8_SA(0, 1), cA + hstepA, voffA);
    if (wr == 1) PG8_BAR;
    PG8_WAIT_V(4); PG8_BAR;
    PG8_STAGE(PG8_SB(1, 0), cB + kstepB, voffB); PG8_STAGE(PG8_SA(1, 0), cA + kstepA, voffA); PG8_STAGE(PG8_SB(1, 1), cB + hstepB + kstepB, voffB);
    PG8_WAIT_V(6); PG8_BAR;
    for (;;) {
        const bool has_next = S.next(ui + 1, nxt);
        const char* nA = has_next ? (const char*)g.A + (size_t)nxt.pm * tstep : cA; const char* nB = has_next ? (const char*)g.Bt + (size_t)nxt.pn * tstep : cB;
        for (int t = 0; t < nt; t += 2) {
            const bool last = (t == nt - 2);
            const char* a1 = cA + (size_t)(t + 1) * kstepA;
            const char* a2 = last ? nA : cA + (size_t)(t + 2) * kstepA; const char* b2 = last ? nB : cB + (size_t)(t + 2) * kstepB;
            const char* a3 = a2 + kstepA; const char* b3 = b2 + kstepB;
            PG8_LDB(B0, 0, 0); PG8_SCHED; PG8_LDA(At, 0, 0); PG8_STAGE(PG8_SA(1, 1), a1 + hstepA, voffA);
            PG8_WAIT_L(8); PG8_BAR; PG8_WAIT_L(0); PG8_MMA(0, 0, At, B0); PG8_BAR; PG8_SCHED;
            PG8_LDB(B1, 0, 1); PG8_STAGE(PG8_SB(0, 0), b2, voffB);
            PG8_BAR; PG8_WAIT_L(0); PG8_MMA(0, 1, At, B1); PG8_BAR;
            PG8_LDA(At, 0, 1); PG8_STAGE(PG8_SA(0, 0), a2, voffA);
            PG8_BAR; PG8_WAIT_L(0); PG8_MMA(1, 0, At, B0); PG8_BAR; PG8_SCHED;
            PG8_STAGE(PG8_SB(0, 1), b2 + hstepB, voffB);
            PG8_WAIT_V(6); PG8_BAR; PG8_MMA(1, 1, At, B1); PG8_BAR;
            PG8_LDB(B0, 1, 0); PG8_SCHED; PG8_LDA(At, 1, 0); PG8_STAGE(PG8_SA(0, 1), a2 + hstepA, voffA);
            PG8_WAIT_L(8); PG8_BAR; PG8_WAIT_L(0); PG8_MMA(0, 0, At, B0); PG8_BAR; PG8_SCHED;
            PG8_LDB(B1, 1, 1); PG8_STAGE(PG8_SB(1, 0), b3, voffB);
            PG8_BAR; PG8_WAIT_L(0); PG8_MMA(0, 1, At, B1); PG8_BAR;
            PG8_LDA(At, 1, 1); PG8_STAGE(PG8_SA(1, 0), a3, voffA);
            PG8_BAR; PG8_WAIT_L(0); PG8_MMA(1, 0, At, B0); PG8_BAR; PG8_SCHED;
            PG8_STAGE(PG8_SB(1, 1), b3 + hstepB, voffB);
            PG8_WAIT_V(6); PG8_BAR; PG8_MMA(1, 1, At, B1); PG8_BAR;
        }
        E(acc, cur, wr, wc, fr, fq);
        if (!has_next) break;
#pragma unroll
        for (int a = 0; a < 2; ++a)
#pragma unroll
            for (int b = 0; b < 2; ++b)
#pragma unroll
                for (int m = 0; m < 4; ++m)
#pragma unroll
                    for (int n = 0; n < 2; ++n) acc[a][b][m][n] = (f32x4){0.f, 0.f, 0.f, 0.f};
        cur = nxt; cA = nA; cB = nB; ++ui;
    }
    PG8_WAIT_V(0);
    if (wr == 0) PG8_BAR;
    PG8_BAR;
#undef PG8_SA
#undef PG8_SB
#undef PG8_STAGE
#undef PG8_LDA
#undef PG8_LDB
#undef PG8_MMA
#undef PG8_WAIT_V
#undef PG8_WAIT_L
#undef PG8_BAR
#undef PG8_SCHED
}
}

struct EpiSwiglu {
    static constexpr bool PERM = true;
    u16* O;
    __device__ __forceinline__ void operator()(const f32x4 (&acc)[2][2][4][2], const pg8::Unit& u, int wr, int wc, int fr, int fq) const {
        const int row0 = u.pm * 256 + wr * 64 + fr, col0 = u.pn * 128 + wc * 32 + 8 * fq;
#pragma unroll
        for (int ai = 0; ai < 2; ++ai)
#pragma unroll
            for (int m = 0; m < 4; ++m) {
                float v[8];
#pragma unroll
                for (int n = 0; n < 2; ++n)
#pragma unroll
                    for (int j = 0; j < 4; ++j) v[n * 4 + j] = siluf_(acc[ai][0][m][n][j]) * acc[ai][1][m][n][j];
                *(bf16x8*)(O + (size_t)(row0 + ai * 128 + m * 16) * FF + col0) = pack8(v);
            }
    }
};
struct EpiResid {
    static constexpr bool PERM = false;
    const float* xin; float* xout; const float* gate; float scale;
    __device__ __forceinline__ void operator()(const f32x4 (&acc)[2][2][4][2], const pg8::Unit& u, int wr, int wc, int fr, int fq) const {
        const int row0 = u.pm * 256 + wr * 64 + fr, col0 = u.pn * 256 + wc * 32 + 4 * fq;
        const float* gp = gate + (u.pm >= 32 ? NMOD : 0) + col0;
        f32x4 gv[2][2];
#pragma unroll
        for (int bj = 0; bj < 2; ++bj)
#pragma unroll
            for (int n = 0; n < 2; ++n) gv[bj][n] = *(const f32x4*)(gp + bj * 128 + n * 16) * scale;
#pragma unroll
        for (int ai = 0; ai < 2; ++ai) {
            f32x4 xi[4][2][2];
#pragma unroll
            for (int m = 0; m < 4; ++m)
#pragma unroll
                for (int bj = 0; bj < 2; ++bj)
#pragma unroll
                    for (int n = 0; n < 2; ++n) xi[m][bj][n] = *(const f32x4*)(xin + (size_t)(row0 + ai * 128 + m * 16) * DM + col0 + bj * 128 + n * 16);
#pragma unroll
            for (int m = 0; m < 4; ++m)
#pragma unroll
                for (int bj = 0; bj < 2; ++bj)
#pragma unroll
                    for (int n = 0; n < 2; ++n) *(f32x4*)(xout + (size_t)(row0 + ai * 128 + m * 16) * DM + col0 + bj * 128 + n * 16) = xi[m][bj][n] + gv[bj][n] * acc[ai][bj][m][n];
        }
    }
};
struct EpiProj {
    static constexpr bool PERM = true;
    u16* Z; u16* XBC; u16* U; u16* G; float* DT; const float* dt_bias;
    __device__ __forceinline__ void operator()(const f32x4 (&acc)[2][2][4][2], const pg8::Unit& u, int wr, int wc, int fr, int fq) const {
        const int row0 = u.pm * 256 + wr * 64 + fr, pn = u.pn;
        if (pn == 40) {
            if (wc == 0) {
#pragma unroll
                for (int ai = 0; ai < 2; ++ai)
#pragma unroll
                    for (int m = 0; m < 4; ++m) {
#pragma unroll
                        for (int n = 0; n < 2; ++n) { f32x4 o;
#pragma unroll
                            for (int j = 0; j < 4; ++j) { const float v = acc[ai][0][m][n][j] + dt_bias[8 * fq + 4 * n + j]; o[j] = v > 20.f ? v : log1pf(__expf(v)); }
                            *(f32x4*)(DT + (size_t)(row0 + ai * 128 + m * 16) * 32 + 8 * fq + 4 * n) = o; }
                    }
            }
            return;
        }
        u16* base; int ld, colt; bool sg = false;
        if (pn < 8) { base = Z; ld = 2048; colt = pn * 256; }
        else if (pn < 20) { base = XBC; ld = 3072; colt = (pn - 8) * 256; }
        else if (pn < 24) { base = U; ld = 1024; colt = (pn - 20) * 256; }
        else { base = G; ld = 4096; colt = (pn - 24) * 256; sg = true; }
        const int col0 = colt + wc * 32 + 8 * fq;
#pragma unroll
        for (int ai = 0; ai < 2; ++ai)
#pragma unroll
            for (int m = 0; m < 4; ++m)
#pragma unroll
                for (int bj = 0; bj < 2; ++bj) {
                    float v[8];
#pragma unroll
                    for (int n = 0; n < 2; ++n)
#pragma unroll
                        for (int j = 0; j < 4; ++j) { const float a = acc[ai][bj][m][n][j]; v[n * 4 + j] = sg ? sigmoidf_(a) : a; }
                    *(bf16x8*)(base + (size_t)(row0 + ai * 128 + m * 16) * ld + col0 + bj * 128) = pack8(v);
                }
    }
};
struct EpiGlu {
    static constexpr bool PERM = true;
    u16* O; const u16* G;
    __device__ __forceinline__ void operator()(const f32x4 (&acc)[2][2][4][2], const pg8::Unit& u, int wr, int wc, int fr, int fq) const {
        const int row0 = u.pm * 256 + wr * 64 + fr, col0 = u.pn * 128 + wc * 32 + 8 * fq;
        u32x4 gw[2][4];
#pragma unroll
        for (int ai = 0; ai < 2; ++ai)
#pragma unroll
            for (int m = 0; m < 4; ++m) gw[ai][m] = *(const u32x4*)(G + (size_t)(row0 + ai * 128 + m * 16) * 4096 + 2048 + col0);
#pragma unroll
        for (int ai = 0; ai < 2; ++ai)
#pragma unroll
            for (int m = 0; m < 4; ++m) {
                const size_t row = (size_t)(row0 + ai * 128 + m * 16);
                const u32x4 g4 = gw[ai][m];
                const float gb[8] = {bflo(g4.x), bfhi(g4.x), bflo(g4.y), bfhi(g4.y), bflo(g4.z), bfhi(g4.z), bflo(g4.w), bfhi(g4.w)};
                float v[8];
#pragma unroll
                for (int n = 0; n < 2; ++n)
#pragma unroll
                    for (int j = 0; j < 4; ++j) v[n * 4 + j] = gb[n * 4 + j] * acc[ai][0][m][n][j] * sigmoidf_(acc[ai][1][m][n][j]);
                *(bf16x8*)(O + row * DM + col0) = pack8(v);
            }
    }
};
struct EpiMerge {
    static constexpr bool PERM = true;
    u16* O; const u16* G; const u16* MB;
    __device__ __forceinline__ void operator()(const f32x4 (&acc)[2][2][4][2], const pg8::Unit& u, int wr, int wc, int fr, int fq) const {
        const int row0 = u.pm * 256 + wr * 64 + fr, col0 = u.pn * 256 + wc * 32 + 8 * fq;
#pragma unroll
        for (int ai = 0; ai < 2; ++ai) {
            u32x4 gw[4][2], mw[4][2];
#pragma unroll
            for (int m = 0; m < 4; ++m)
#pragma unroll
                for (int bj = 0; bj < 2; ++bj) { const size_t row = (size_t)(row0 + ai * 128 + m * 16); const int col = col0 + bj * 128;
                    gw[m][bj] = *(const u32x4*)(G + row * 4096 + col); mw[m][bj] = *(const u32x4*)(MB + row * DM + col); }
#pragma unroll
            for (int m = 0; m < 4; ++m)
#pragma unroll
                for (int bj = 0; bj < 2; ++bj) {
                    const size_t row = (size_t)(row0 + ai * 128 + m * 16); const int col = col0 + bj * 128;
                    const u32x4 g4 = gw[m][bj], m4 = mw[m][bj];
                    const float ga[8] = {bflo(g4.x), bfhi(g4.x), bflo(g4.y), bfhi(g4.y), bflo(g4.z), bfhi(g4.z), bflo(g4.w), bfhi(g4.w)};
                    const float mb[8] = {bflo(m4.x), bfhi(m4.x), bflo(m4.y), bfhi(m4.y), bflo(m4.z), bfhi(m4.z), bflo(m4.w), bfhi(m4.w)};
                    float v[8];
#pragma unroll
                    for (int n = 0; n < 2; ++n)
#pragma unroll
                        for (int j = 0; j < 4; ++j) v[n * 4 + j] = ga[n * 4 + j] * acc[ai][bj][m][n][j] + mb[n * 4 + j];
                    *(bf16x8*)(O + row * DM + col) = pack8(v);
                }
        }
    }
};

__device__ __forceinline__ size_t tiled_off(int row, int col, int K) { return ((size_t)(row >> 7) * (K >> 6) + (col >> 6)) * 8192 + (size_t)(row & 127) * 64 + (col & 63); }

__device__ __forceinline__ int map_col(int wsel, int n) {
    if (wsel == 0) return ((n >> 7) & 1) * FF + (n >> 8) * 128 + (n & 127);
    if (wsel == 3) return ((n >> 7) & 1) * 2048 + (n >> 8) * 128 + (n & 127);
    if (wsel == 2) { if (n < 5120) return n; if (n < 6144) return 5152 + (n - 5120); if (n < 10240) return 6176 + (n - 6144); if (n < 10272) return 5120 + (n - 10240); return -1; }
    return n;
}
__device__ __forceinline__ void conv_weight(LAS float* T, const float* __restrict__ src, u16* __restrict__ dst, int K, int ld, int ndst, int wsel, int& tbase, bool tiled = false) {
    const int nnt = ndst / 64, ntiles = (K / 128) * nnt, tid = threadIdx.x, G = gridDim.x;
    const int first = (((int)blockIdx.x - tbase) % G + G) % G;
    for (int t = first; t < ntiles; t += G) {
        const int n0 = (t % nnt) * 64, k0 = (t / nnt) * 128;
        { const int c4 = tid & 15, r = tid >> 4; const int sc = map_col(wsel, n0 + c4 * 4);
#pragma unroll
          for (int ps = 0; ps < 4; ++ps) { const int kr = r + ps * 32;
              f32x4 v = (f32x4){0.f, 0.f, 0.f, 0.f}; if (sc >= 0) v = *(const f32x4*)(src + (size_t)(k0 + kr) * ld + sc);
              LAS float* tp = T + kr * 65 + c4 * 4; tp[0] = v.x; tp[1] = v.y; tp[2] = v.z; tp[3] = v.w; } }
        __syncthreads();
        { const int kg = tid >> 5, nl = tid & 31;
#pragma unroll
          for (int ps = 0; ps < 2; ++ps) { const int n = nl + ps * 32; float f[8];
#pragma unroll
              for (int j = 0; j < 8; ++j) f[j] = T[(kg * 8 + j) * 65 + n];
              *(bf16x8*)(dst + (tiled ? tiled_off(n0 + n, k0 + kg * 8, K) : (size_t)(n0 + n) * K + k0 + kg * 8)) = pack8(f); } }
        __syncthreads();
    }
    tbase += ntiles;
}

template <int MODE, bool TILED = false>
__device__ __forceinline__ void norm_rows(const float* src, const float* __restrict__ gw, const float* __restrict__ sh, const float* __restrict__ sc, u16* dst, float* fdst) {
    const int lane = threadIdx.x & 63, wg = blockIdx.x * 8 + (threadIdx.x >> 6), nw = gridDim.x * 8;
    for (int rp = wg; rp < M_TOK / 2; rp += nw) {
        f32x4 v[2][8]; float ss[2] = {0.f, 0.f};
#pragma unroll
        for (int q = 0; q < 2; ++q)
#pragma unroll
            for (int i = 0; i < 8; ++i) v[q][i] = *(const f32x4*)(src + (size_t)(rp * 2 + q) * DM + i * 256 + lane * 4);
#pragma unroll
        for (int q = 0; q < 2; ++q) {
#pragma unroll
            for (int i = 0; i < 8; ++i) ss[q] += v[q][i].x * v[q][i].x + v[q][i].y * v[q][i].y + v[q][i].z * v[q][i].z + v[q][i].w * v[q][i].w;
#pragma unroll
            for (int off = 32; off >= 1; off >>= 1) ss[q] += __shfl_xor(ss[q], off); }
#pragma unroll
        for (int q = 0; q < 2; ++q) { const int row = rp * 2 + q, bo = (row >> 13) * NMOD; const float rstd = rsqrtf(ss[q] * (1.f / 2048.f) + 1e-6f);
#pragma unroll
            for (int i = 0; i < 8; ++i) { const int col = i * 256 + lane * 4; const f32x4 g4 = *(const f32x4*)(gw + col);
                if (MODE == 0) { const f32x4 s4 = *(const f32x4*)(sc + bo + col), h4 = *(const f32x4*)(sh + bo + col);
                    const f32x4 o = v[q][i] * rstd * g4 * (s4 + 1.f) + h4;
                    u32x2 w; w.x = cvt_pk_bf16(o.x, o.y); w.y = cvt_pk_bf16(o.z, o.w); *(u32x2*)(dst + (TILED ? tiled_off(row, col, DM) : (size_t)row * DM + col)) = w; }
                else { *(f32x4*)(fdst + (size_t)row * DM + col) = v[q][i] * rstd * g4; } } }
    }
}

__device__ __forceinline__ void norm_dt_rows(const float* src, const float* __restrict__ gw, const float* __restrict__ sh, const float* __restrict__ sc, u16* dst,
                                             const u16* __restrict__ wdt  , const float* __restrict__ dt_bias, float* DT) {
    const int lane = threadIdx.x & 63, wg = blockIdx.x * 8 + (threadIdx.x >> 6), nw = gridDim.x * 8, fr = lane & 15, fq = lane >> 4;
    for (int rb = wg; rb < M_TOK / 8; rb += nw) {
        const int row0 = rb * 8, bo = (row0 >> 13) * NMOD;
#pragma unroll 1
        for (int i8 = 0; i8 < 8; ++i8) { const int row = row0 + i8;
            f32x4 v[8]; float ss = 0.f;
#pragma unroll
            for (int i = 0; i < 8; ++i) { v[i] = *(const f32x4*)(src + (size_t)row * DM + i * 256 + lane * 4); ss += v[i].x * v[i].x + v[i].y * v[i].y + v[i].z * v[i].z + v[i].w * v[i].w; }
#pragma unroll
            for (int off = 32; off >= 1; off >>= 1) ss += __shfl_xor(ss, off);
            const float rstd = rsqrtf(ss * (1.f / 2048.f) + 1e-6f);
#pragma unroll
            for (int i = 0; i < 8; ++i) { const int col = i * 256 + lane * 4; const f32x4 g4 = *(const f32x4*)(gw + col), s4 = *(const f32x4*)(sc + bo + col), h4 = *(const f32x4*)(sh + bo + col);
                const f32x4 o = v[i] * rstd * g4 * (s4 + 1.f) + h4;
                u32x2 wv; wv.x = cvt_pk_bf16(o.x, o.y); wv.y = cvt_pk_bf16(o.z, o.w); *(u32x2*)(dst + (size_t)row * DM + col) = wv; } }
        f32x4 a0 = (f32x4){0.f, 0.f, 0.f, 0.f}, a1 = a0;
        const u16* ap = dst + (size_t)(row0 + (fr & 7)) * DM + fq * 8; const u16* bp = wdt + (size_t)fr * 2048 + fq * 8;
        asm volatile("s_waitcnt vmcnt(0)" ::: "memory");
#pragma unroll 8
        for (int ks = 0; ks < 64; ++ks) { const bf16x8 a = *(const bf16x8*)(ap + ks * 32), b0 = *(const bf16x8*)(bp + ks * 32), b1 = *(const bf16x8*)(bp + 16 * 2048 + ks * 32);
            a0 = MFMA16(a, b0, a0); a1 = MFMA16(a, b1, a1); }
        if (fq < 2) {
#pragma unroll
            for (int j = 0; j < 4; ++j) { const float v0 = a0[j] + dt_bias[fr], v1 = a1[j] + dt_bias[16 + fr]; float* dp = DT + (size_t)(row0 + fq * 4 + j) * 32;
                dp[fr] = v0 > 20.f ? v0 : log1pf(__expf(v0)); dp[16 + fr] = v1 > 20.f ? v1 : log1pf(__expf(v1)); } }
    }
}

__device__ __forceinline__ void conv_tile4(const u32x4 (&raw)[11], const int jh, const float* __restrict__ cw, const float* __restrict__ cbp, float (&o)[8][4]) {
    const f32x4 w0 = *(const f32x4*)(cw + jh * 4), w1 = *(const f32x4*)(cw + 3072 + jh * 4), w2 = *(const f32x4*)(cw + 6144 + jh * 4), w3 = *(const f32x4*)(cw + 9216 + jh * 4), bb = *(const f32x4*)(cbp + jh * 4);
    f32x4 xr[11];
#pragma unroll
    for (int k = 0; k < 11; ++k) { const unsigned a = jh ? raw[k].z : raw[k].x, b2 = jh ? raw[k].w : raw[k].y; xr[k] = (f32x4){bflo(a), bfhi(a), bflo(b2), bfhi(b2)}; }
#pragma unroll
    for (int i = 0; i < 8; ++i) { const f32x4 v = bb + w0 * xr[i] + w1 * xr[i + 1] + w2 * xr[i + 2] + w3 * xr[i + 3];
#pragma unroll
        for (int jj = 0; jj < 4; ++jj) o[i][jj] = siluf_(v[jj]); }
}
constexpr int SA_XT = 17408, SA_CS_OFF = 8 * SA_XT, SA_DT_OFF = SA_CS_OFF + 4096, SA_BYTES = SA_DT_OFF + 4096;
__device__ __forceinline__ void ssd_a_item(const Params& p, LAS unsigned char* lds, int item) {
    unsigned char* ws = p.ws;
    const u16* XBC = (const u16*)(ws + WS_X); const float* DT = (const float*)(ws + WS_DT); float* CS = (float*)(ws + WS_CS);
    u16* Bc = (u16*)(ws + WS_BC); u16* Cc = (u16*)(ws + WS_CC); u16* XTG = (u16*)(ws + WS_H); u16* ST = (u16*)(ws + WS_ST);
    u16* BCT = (u16*)(ws + WS_BCT) + (size_t)item * 16384;
    const float* conv_w = p.in[I_CONVW]; const float* conv_b = p.in[I_CONVB];
    const int tid = threadIdx.x, lane = tid & 63, w = __builtin_amdgcn_readfirstlane(tid >> 6), fr = lane & 15, fq = lane >> 4;
    const int b = item >> 8, c = (item >> 2) & 63, g = item & 3, t0 = b * SEQ + c * 128, h = g * 8 + w;
    LAS u16* XT = (LAS u16*)(lds + w * SA_XT);
    LAS float* CSL = (LAS float*)(lds + SA_CS_OFF) + w * 128;
    LAS float* DTL = (LAS float*)(lds + SA_DT_OFF) + w * 128;
    { const float ah = -__expf(p.in[I_ALOG][h]); float carry = 0.f;
#pragma unroll
      for (int half = 0; half < 2; ++half) { const int l = lane + 64 * half; const float dtv = DT[(size_t)(t0 + l) * 32 + h]; float v = dtv * ah;
#pragma unroll
          for (int off = 1; off < 64; off <<= 1) { const float nb = __shfl_up(v, off); if (lane >= off) v += nb; }
          v += carry; carry = __shfl(v, 63);
          CSL[l] = v; DTL[l] = dtv; CS[((size_t)(b * 64 + c) * 32 + h) * 128 + l] = v; } }
    { const int cgx = tid & 31, l0 = (tid >> 5) * 8; const bool isC = cgx >= 16; const int n0 = (cgx & 15) * 8;
      const int col0 = 2048 + (isC ? 512 : 0) + g * 128 + n0;
      u32x4 raw[11];
#pragma unroll
      for (int k = 0; k < 11; ++k) { const int l = l0 - 3 + k; raw[k] = (u32x4){0u, 0u, 0u, 0u}; if (c * 128 + l >= 0) raw[k] = *(const u32x4*)(XBC + (size_t)((long)t0 + l) * 3072 + col0); }
      u16* op = (isC ? Cc : Bc) + (size_t)(t0 + l0) * 512 + g * 128 + n0;
#pragma unroll
      for (int jh = 0; jh < 2; ++jh) { float o[8][4]; conv_tile4(raw, jh, conv_w + col0, conv_b + col0, o);
#pragma unroll
          for (int i = 0; i < 8; ++i) { u32x2 wv; wv.x = cvt_pk_bf16(o[i][0], o[i][1]); wv.y = cvt_pk_bf16(o[i][2], o[i][3]); *(u32x2*)(op + (size_t)i * 512 + jh * 4) = wv; }
          if (!isC) {
#pragma unroll
              for (int j = 0; j < 4; ++j) { const float f[8] = {o[0][j], o[1][j], o[2][j], o[3][j], o[4][j], o[5][j], o[6][j], o[7][j]}; *(bf16x8*)(BCT + (size_t)(n0 + jh * 4 + j) * 128 + l0) = pack8(f); } } } }
    { const int p0 = (lane & 7) * 8, rg = lane >> 3, col0 = h * 64 + p0;
      u16* xtg = XTG + ((size_t)((b * 64 + c) * 32 + h) * 64) * 128;
      const float cs_end = CSL[127];
#pragma unroll 1
      for (int half = 0; half < 2; ++half) {
          const int l0 = half * 64 + rg * 8;
          u32x4 raw[11];
#pragma unroll
          for (int k = 0; k < 11; ++k) { const int l = l0 - 3 + k; raw[k] = (u32x4){0u, 0u, 0u, 0u}; if (c * 128 + l >= 0) raw[k] = *(const u32x4*)(XBC + (size_t)((long)t0 + l) * 3072 + col0); }
          float scl[8];
#pragma unroll
          for (int i = 0; i < 8; ++i) scl[i] = DTL[l0 + i] * __expf(cs_end - CSL[l0 + i]);
#pragma unroll
          for (int jh = 0; jh < 2; ++jh) { float o[8][4]; conv_tile4(raw, jh, conv_w + col0, conv_b + col0, o);
#pragma unroll
              for (int j = 0; j < 4; ++j) { const float f[8] = {o[0][j], o[1][j], o[2][j], o[3][j], o[4][j], o[5][j], o[6][j], o[7][j]};
                  *(bf16x8*)(xtg + (size_t)(p0 + jh * 4 + j) * 128 + l0) = pack8(f);
                  const float f2[8] = {f[0] * scl[0], f[1] * scl[1], f[2] * scl[2], f[3] * scl[3], f[4] * scl[4], f[5] * scl[5], f[6] * scl[6], f[7] * scl[7]};
                  *(LAS bf16x8*)(XT + (p0 + jh * 4 + j) * 136 + l0) = pack8(f2); } }
      } }
    __syncthreads();
    { f32x4 acc[4][8];
#pragma unroll
      for (int mt = 0; mt < 4; ++mt)
#pragma unroll
          for (int nt = 0; nt < 8; ++nt) acc[mt][nt] = (f32x4){0.f, 0.f, 0.f, 0.f};
#pragma unroll 1
      for (int kk = 0; kk < 4; ++kk) { bf16x8 xf[4];
#pragma unroll
          for (int mt = 0; mt < 4; ++mt) xf[mt] = *(const LAS bf16x8*)(XT + (mt * 16 + fr) * 136 + kk * 32 + fq * 8);
#pragma unroll
          for (int nt = 0; nt < 8; ++nt) { const bf16x8 bf = *(const bf16x8*)(BCT + (size_t)(nt * 16 + fr) * 128 + kk * 32 + fq * 8);
#pragma unroll
              for (int mt = 0; mt < 4; ++mt) acc[mt][nt] = MFMA16(bf, xf[mt], acc[mt][nt]); } }
      u16* sp = ST + ((size_t)((b * 64 + c) * 32 + h) * 64) * 128;
#pragma unroll
      for (int mt = 0; mt < 4; ++mt)
#pragma unroll
          for (int nt = 0; nt < 8; ++nt) { u32x2 wv; wv.x = cvt_pk_bf16(acc[mt][nt][0], acc[mt][nt][1]); wv.y = cvt_pk_bf16(acc[mt][nt][2], acc[mt][nt][3]);
              *(u32x2*)(sp + (mt * 16 + fr) * 128 + nt * 16 + fq * 4) = wv; }
    }
    __syncthreads();
}

#define SC_LBAR() do { asm volatile("s_waitcnt lgkmcnt(0)" ::: "memory"); __builtin_amdgcn_s_barrier(); asm volatile("" ::: "memory"); } while (0)
constexpr int SC_CBW = 8448, SC_ZY = 2304, SC_ZY_OFF = 8 * SC_CBW, SC_CS_OFF = SC_ZY_OFF + 8 * SC_ZY, SC_DT_OFF = SC_CS_OFF + 4096, SC_PV_OFF = SC_DT_OFF + 4096, SC_XT_OFF = SC_PV_OFF + 17408, SC_BYTES = SC_XT_OFF + 17408;
static_assert(SC_BYTES <= LDS_PHASE_BYTES, "ssd_c LDS");
__device__ __forceinline__ void ssd_c_item(const Params& p, LAS unsigned char* lds, int item) {
    unsigned char* ws = p.ws;
    const float* DT = (const float*)(ws + WS_DT); const float* CS = (const float*)(ws + WS_CS);
    const u16* Bc = (const u16*)(ws + WS_BC); const u16* Cc = (const u16*)(ws + WS_CC); const u16* XTG = (const u16*)(ws + WS_H); const u16* ST = (const u16*)(ws + WS_ST);
    const u16* Z = (const u16*)(ws + WS_Z); u16* YA = (u16*)(ws + WS_YA);
    const int tid = threadIdx.x, lane = tid & 63, w = __builtin_amdgcn_readfirstlane(tid >> 6), fr = lane & 15, fq = lane >> 4;
    const int b = item >> 8, c = (item >> 2) & 63, g = item & 3, t0 = b * SEQ + c * 128;
    const int mb = (w < 4) ? w : 11 - w;
    LAS float* CBW = (LAS float*)(lds + w * SC_CBW);
    LAS u16* ZY = (LAS u16*)(lds + SC_ZY_OFF + w * SC_ZY);
    LAS float* CSL = (LAS float*)(lds + SC_CS_OFF);
    LAS float* DTL = (LAS float*)(lds + SC_DT_OFF);
    LAS u16* PV = (LAS u16*)(lds + SC_PV_OFF);
    LAS u16* XS = (LAS u16*)(lds + SC_XT_OFF);
#pragma unroll
    for (int i = 0; i < 2; ++i) { const int idx = tid + 512 * i, hd = idx >> 7, l = idx & 127;
        CSL[idx] = CS[((size_t)(b * 64 + c) * 32 + g * 8 + hd) * 128 + l]; DTL[idx] = DT[(size_t)(t0 + l) * 32 + g * 8 + hd]; }
    const int la = 16 * mb + fr;
    bf16x8 afc[4];
#pragma unroll
    for (int kk = 0; kk < 4; ++kk) afc[kk] = *(const bf16x8*)(Cc + (size_t)(t0 + la) * 512 + g * 128 + kk * 32 + fq * 8);
    { LAS u16* BCL = (LAS u16*)(lds + SC_PV_OFF);
#pragma unroll
      for (int i = 0; i < 4; ++i) { const int q = tid + 512 * i, row = q >> 4, cc = q & 15;
          *(LAS u32x4*)(BCL + row * 136 + cc * 8) = *(const u32x4*)(Bc + (size_t)(t0 + row) * 512 + g * 128 + cc * 8); }
      __syncthreads();
#pragma unroll
      for (int st = 0; st < 8; ++st) { f32x4 acc = (f32x4){0.f, 0.f, 0.f, 0.f};
#pragma unroll
          for (int kk = 0; kk < 4; ++kk) { const bf16x8 bf = *(const LAS bf16x8*)(BCL + (st * 16 + fr) * 136 + kk * 32 + fq * 8); acc = MFMA16(afc[kk], bf, acc); }
#pragma unroll
          for (int j = 0; j < 4; ++j) CBW[(fq * 4 + j) * 132 + st * 16 + fr] = acc[j]; } }
    float ssq[4] = {0.f, 0.f, 0.f, 0.f};
    u32x4 rpv[2], rxs[2], rz[2];
    { const size_t hb = ((size_t)((b * 64 + c) * 32 + g * 8) * 64) * 128;
#pragma unroll
      for (int i = 0; i < 2; ++i) { const int q = tid + 512 * i, row = q >> 4, cc = q & 15; rpv[i] = *(const u32x4*)(ST + hb + row * 128 + cc * 8); rxs[i] = *(const u32x4*)(XTG + hb + row * 128 + cc * 8); }
#pragma unroll
      for (int i = 0; i < 2; ++i) { const int q = lane + 64 * i, row = q >> 3, cc = q & 7; rz[i] = *(const u32x4*)(Z + (size_t)(t0 + 16 * mb + row) * DM + g * 512 + cc * 8); } }
#pragma unroll 1
    for (int r = 0; r < 8; ++r) {
        const int h = g * 8 + r;
        const u16* xtg = XTG + ((size_t)((b * 64 + c) * 32 + h) * 64) * 128;
        const u16* pvg = ST + ((size_t)((b * 64 + c) * 32 + h) * 64) * 128;
        SC_LBAR();
#pragma unroll
        for (int i = 0; i < 2; ++i) { const int q = tid + 512 * i, row = q >> 4, cc = q & 15;
            *(LAS u32x4*)(PV + row * 136 + cc * 8) = rpv[i]; *(LAS u32x4*)(XS + row * 136 + cc * 8) = rxs[i]; }
#pragma unroll
        for (int i = 0; i < 2; ++i) { const int q = lane + 64 * i, row = q >> 3, cc = q & 7;
            *(LAS u32x4*)(ZY + row * 72 + cc * 8) = rz[i]; }
        SC_LBAR();
        if (r < 7) {
#pragma unroll
            for (int i = 0; i < 2; ++i) { const int q = tid + 512 * i, row = q >> 4, cc = q & 15;
                rpv[i] = *(const u32x4*)(pvg + 8192 + row * 128 + cc * 8); rxs[i] = *(const u32x4*)(xtg + 8192 + row * 128 + cc * 8); }
#pragma unroll
            for (int i = 0; i < 2; ++i) { const int q = lane + 64 * i, row = q >> 3, cc = q & 7;
                rz[i] = *(const u32x4*)(Z + (size_t)(t0 + 16 * mb + row) * DM + (h + 1) * 64 + cc * 8); }
        }
        const float csl = CSL[r * 128 + la], Dh = p.in[I_DSSD][h];
        f32x4 accd[4], acco[4];
#pragma unroll
        for (int pt = 0; pt < 4; ++pt) { accd[pt] = (f32x4){0.f, 0.f, 0.f, 0.f}; acco[pt] = (f32x4){0.f, 0.f, 0.f, 0.f}; }
#pragma unroll
        for (int kk = 0; kk < 4; ++kk) {
#pragma unroll
            for (int pt = 0; pt < 4; ++pt) { const bf16x8 pf = *(const LAS bf16x8*)(PV + (pt * 16 + fr) * 136 + kk * 32 + fq * 8); acco[pt] = MFMA16(afc[kk], pf, acco[pt]); }
            if (kk * 32 <= 16 * mb + 15) {
                const int s0 = kk * 32 + fq * 8; float mv[8];
#pragma unroll
                for (int i = 0; i < 8; ++i) { const int s = s0 + i; const float e = CBW[fr * 132 + s] * __expf(csl - CSL[r * 128 + s]) * DTL[r * 128 + s]; mv[i] = (s <= la) ? e : 0.f; }
                const bf16x8 afm = pack8(mv);
#pragma unroll
                for (int pt = 0; pt < 4; ++pt) { const bf16x8 xf = *(const LAS bf16x8*)(XS + (pt * 16 + fr) * 136 + kk * 32 + fq * 8); accd[pt] = MFMA16(afm, xf, accd[pt]); }
            }
        }
        float el[4];
#pragma unroll
        for (int j = 0; j < 4; ++j) el[j] = __expf(CSL[r * 128 + 16 * mb + fq * 4 + j]);
#pragma unroll
        for (int pt = 0; pt < 4; ++pt) {
            const u32x2 xr = *(const LAS u32x2*)(XS + (pt * 16 + fr) * 136 + 16 * mb + fq * 4);
            const float xv[4] = {bflo(xr.x), bfhi(xr.x), bflo(xr.y), bfhi(xr.y)};
#pragma unroll
            for (int j = 0; j < 4; ++j) { const float y = accd[pt][j] + el[j] * acco[pt][j] + Dh * xv[j];
                LAS u16* zp = ZY + (fq * 4 + j) * 72 + pt * 16 + fr;
                const float v = y * siluf_(bf2f(*zp)); ssq[j] += v * v; *zp = f2bf(v); }
        }
#pragma unroll
        for (int i = 0; i < 2; ++i) { const int q = lane + 64 * i, row = q >> 3, cc = q & 7;
            *(u32x4*)(YA + (size_t)(t0 + 16 * mb + row) * DM + h * 64 + cc * 8) = *(const LAS u32x4*)(ZY + row * 72 + cc * 8); }
    }
#pragma unroll
    for (int j = 0; j < 4; ++j) { float s = ssq[j]; s += __shfl_xor(s, 1); s += __shfl_xor(s, 2); s += __shfl_xor(s, 4); s += __shfl_xor(s, 8);
        if (fr == 0) CBW[fq * 4 + j] = rsqrtf(s * (1.f / 512.f) + 1e-6f); }
    const float* nw = p.in[I_SNW];
    asm volatile("s_waitcnt vmcnt(0)" ::: "memory");
    { u16* ybase = YA + (size_t)(t0 + 16 * mb) * DM + g * 512 + lane * 8;
      const f32x4 n0 = *(const f32x4*)(nw + g * 512 + lane * 8), n1 = *(const f32x4*)(nw + g * 512 + lane * 8 + 4);
#pragma unroll
      for (int hb = 0; hb < 2; ++hb) { u32x4 v[8];
#pragma unroll
          for (int i = 0; i < 8; ++i) v[i] = *(const u32x4*)(ybase + (size_t)(hb * 8 + i) * DM);
#pragma unroll
          for (int i = 0; i < 8; ++i) { const float rsv = CBW[hb * 8 + i];
              const float f[8] = {bflo(v[i].x) * rsv * n0.x, bfhi(v[i].x) * rsv * n0.y, bflo(v[i].y) * rsv * n0.z, bfhi(v[i].y) * rsv * n0.w, bflo(v[i].z) * rsv * n1.x, bfhi(v[i].z) * rsv * n1.y, bflo(v[i].w) * rsv * n1.z, bfhi(v[i].w) * rsv * n1.w};
              *(bf16x8*)(ybase + (size_t)(hb * 8 + i) * DM) = pack8(f); } } }
    __syncthreads();
}

template <bool OUT>
__device__ __forceinline__ void s5_item(const Params& p, LAS unsigned char* lds, int item) {
    unsigned char* ws = p.ws;
    const u16* U = (const u16*)(ws + WS_U); const u16* BBAR = (const u16*)(ws + WS_BBAR); const u16* CM = (const u16*)(ws + WS_CM);
    const f32x2* AV = (const f32x2*)(ws + WS_AV); f32x2* SEND = (f32x2*)(ws + WS_SEND); const f32x2* SINIT = (const f32x2*)(ws + WS_SINIT); u16* YB = (u16*)(ws + WS_YB);
    const int tid = threadIdx.x, lane = tid & 63, w = __builtin_amdgcn_readfirstlane(tid >> 6), fr = lane & 15, fq = lane >> 4;
    const int b = item >> 11, tc = (item >> 6) & 31, g = item & 63;
    LAS float* L = (LAS float*)(lds + w * 16896);
    LAS u16* OT = (LAS u16*)(lds + 8 * 16896 + w * 1024);
    const f32x2 a = AV[g * 64 + lane]; const float ar = a.x, ai = a.y;
    float sre = 0.f, sim = 0.f;
    if (OUT) { const f32x2 s0 = SINIT[((size_t)(b * 32 + tc) * 64 + g) * 64 + lane]; sre = s0.x; sim = s0.y; }
    const bf16x8 zero8 = (bf16x8){0, 0, 0, 0, 0, 0, 0, 0};
    bf16x8 bfr[8];
#pragma unroll
    for (int nt = 0; nt < 8; ++nt) { bfr[nt] = zero8; if (fq < 2) bfr[nt] = *(const bf16x8*)(BBAR + ((size_t)(g * 128 + nt * 16 + fr)) * 16 + fq * 8); }
    bf16x8 cfr[4], dfr = zero8;
    if (OUT) {
#pragma unroll
        for (int kk = 0; kk < 4; ++kk) cfr[kk] = *(const bf16x8*)(CM + ((size_t)(g * 16 + fr)) * 128 + kk * 32 + fq * 8);
        const unsigned dv = (unsigned)f2bf(p.in[I_S5D][g * 16 + fr]); const int kpos = fr - fq * 8; u32x4 dw = (u32x4){0u, 0u, 0u, 0u};
        if (kpos >= 0 && kpos < 8) { const unsigned word = (kpos & 1) ? (dv << 16) : dv; if ((kpos >> 1) == 0) dw.x = word; else if ((kpos >> 1) == 1) dw.y = word; else if ((kpos >> 1) == 2) dw.z = word; else dw.w = word; }
        dfr = __builtin_bit_cast(bf16x8, dw);
    }
    const size_t ubase = (size_t)(b * SEQ + tc * 256) * 1024 + g * 16 + (fq & 1) * 8;
    bf16x8 afn[2];
#pragma unroll
    for (int mt = 0; mt < 2; ++mt) { afn[mt] = zero8; if (fq < 2) afn[mt] = *(const bf16x8*)(U + ubase + (size_t)(mt * 16 + fr) * 1024); }
#pragma unroll 1
    for (int sb = 0; sb < 8; ++sb) {
        const int tok0 = b * SEQ + tc * 256 + sb * 32;
        bf16x8 af[2] = {afn[0], afn[1]};
        if (sb < 7) {
#pragma unroll
            for (int mt = 0; mt < 2; ++mt) if (fq < 2) afn[mt] = *(const bf16x8*)(U + ubase + (size_t)((sb + 1) * 32 + mt * 16 + fr) * 1024);
        }
#pragma unroll
        for (int mt = 0; mt < 2; ++mt) {
#pragma unroll
            for (int nt = 0; nt < 8; ++nt) { const f32x4 r = MFMA16(af[mt], bfr[nt], ((f32x4){0.f, 0.f, 0.f, 0.f}));
#pragma unroll
                for (int j = 0; j < 4; ++j) L[(mt * 16 + fq * 4 + j) * 132 + nt * 16 + fr] = r[j]; } }
#pragma unroll 8
        for (int t = 0; t < 32; ++t) { const float bre = L[t * 132 + lane], bim = L[t * 132 + 64 + lane];
            const float nre = ar * sre - ai * sim + bre, nim = ar * sim + ai * sre + bim; sre = nre; sim = nim;
            if (OUT) { L[t * 132 + lane] = sre; L[t * 132 + 64 + lane] = sim; } }
        if (OUT) {
#pragma unroll
            for (int mt = 0; mt < 2; ++mt) { f32x4 acc = MFMA16(af[mt], dfr, ((f32x4){0.f, 0.f, 0.f, 0.f}));
#pragma unroll
                for (int kk = 0; kk < 4; ++kk) { float f[8];
#pragma unroll
                    for (int i = 0; i < 8; ++i) f[i] = L[(mt * 16 + fr) * 132 + kk * 32 + fq * 8 + i];
                    acc = MFMA16(pack8(f), cfr[kk], acc); }
#pragma unroll
                for (int j = 0; j < 4; ++j) OT[(mt * 16 + fq * 4 + j) * 16 + fr] = f2bf(gelu_tanh(acc[j])); }
            *(u32x4*)(YB + (size_t)(tok0 + (lane >> 1)) * 1024 + g * 16 + (lane & 1) * 8) = *(const LAS u32x4*)(OT + lane * 8);
        }
    }
    if (!OUT) SEND[((size_t)(b * 32 + tc) * 64 + g) * 64 + lane] = (f32x2){sre, sim};
}

#define XB_TMO      128
#define XB_XCNT(j)  (256  + 64 * (j))
#define XB_XSUB(j)  (1280 + 64 * (j))
#define XB_XGEN(j)  (2304 + 64 * (j))
#define XB_TOP      3328
#define XB_TOPGEN   3392
#define XCD_BAR_WORDS 3456
#define XB_SPIN_CAP (1u << 23)
__device__ __forceinline__ unsigned xb_ld(unsigned* p)              { return __hip_atomic_load(p, __ATOMIC_RELAXED, __HIP_MEMORY_SCOPE_AGENT); }
__device__ __forceinline__ unsigned xb_add(unsigned* p, unsigned v) { return __hip_atomic_fetch_add(p, v, __ATOMIC_RELAXED, __HIP_MEMORY_SCOPE_AGENT); }
__device__ __forceinline__ unsigned xb_xcc_id() { return (unsigned)__builtin_amdgcn_s_getreg((3 << 11) | 20) & 0xFu; }
#define XB_SPIN(cond, bar) do { unsigned _sp = 0; while (cond) { __builtin_amdgcn_s_sleep(1); \
    if ((++_sp & 255u) == 0u) { if (xb_ld(&(bar)[XB_TMO])) break; if (_sp > XB_SPIN_CAP) { atomicAdd(&(bar)[XB_TMO], 1u); break; } } } } while (0)
struct XcdBarrier { unsigned* bar; unsigned x; volatile LAS unsigned* st; };
__device__ __forceinline__ XcdBarrier xcd_barrier_post(unsigned* bar, volatile LAS unsigned* st) {
    XcdBarrier b; b.bar = bar; b.x = xb_xcc_id(); b.st = st;
    if (threadIdx.x == 0) (void)xb_add(&bar[XB_XCNT(b.x)], 1u);
    return b;
}
__device__ __forceinline__ void xcd_barrier_complete(unsigned* bar, unsigned x, unsigned& nloc, unsigned& nx) {
    const unsigned G = gridDim.x * gridDim.y * gridDim.z;
    unsigned sum, cnt, mine, sp = 0u;
    for (;;) {
        sum = 0u; cnt = 0u; mine = 0u;
#pragma unroll
        for (unsigned j = 0; j < 16; ++j) { const unsigned c = xb_ld(&bar[XB_XCNT(j)]); sum += c; cnt += (c > 0u) ? 1u : 0u; mine = (j == x) ? c : mine; }
        if (sum == G) break;
        __builtin_amdgcn_s_sleep(1);
        if ((++sp & 255u) == 0u) { if (xb_ld(&bar[XB_TMO])) break; if (sp > XB_SPIN_CAP) { atomicAdd(&bar[XB_TMO], 1u); break; } }
    }
    nloc = mine > 0u ? mine : 1u; nx = cnt > 0u ? cnt : 1u;
}
__device__ __forceinline__ void xcd_barrier(const XcdBarrier& b) {
    asm volatile("s_waitcnt vmcnt(0)" ::: "memory");
    __syncthreads();
    if (threadIdx.x == 0) {
        unsigned* bar = b.bar;
        __builtin_amdgcn_s_waitcnt(0);
        unsigned nloc = b.st[0], nx = b.st[1];
        if (nloc == 0u) { xcd_barrier_complete(bar, b.x, nloc, nx); b.st[0] = nloc; b.st[1] = nx; }
        const unsigned old = xb_add(&bar[XB_XSUB(b.x)], 1u);
        const unsigned gen = old / nloc;
        if (old + 1u == (gen + 1u) * nloc) {
            __builtin_amdgcn_fence(__ATOMIC_RELEASE, "agent");
            asm volatile("s_waitcnt vmcnt(0)" ::: "memory");
            const unsigned og = xb_add(&bar[XB_TOP], 1u);
            const unsigned tg = og / nx;
            if (og + 1u == (tg + 1u) * nx) xb_add(&bar[XB_TOPGEN], 1u);
            else XB_SPIN(xb_ld(&bar[XB_TOPGEN]) == tg, bar);
            __builtin_amdgcn_fence(__ATOMIC_ACQUIRE, "agent");
            xb_add(&bar[XB_XGEN(b.x)], 1u);
            asm volatile("s_waitcnt vmcnt(0)" ::: "memory");
        } else {
            XB_SPIN(xb_ld(&bar[XB_XGEN(b.x)]) == gen, bar);
            __builtin_amdgcn_fence(__ATOMIC_ACQUIRE, "agent");
            asm volatile("s_waitcnt vmcnt(0)" ::: "memory");
        }
    }
    __syncthreads();
}

__global__ void __launch_bounds__(512, 2) mega(Params p) {
    extern __shared__ __attribute__((aligned(16))) unsigned char shm[];
    LAS unsigned char* lds = (LAS unsigned char*)shm;
    cg::grid_group grid = cg::this_grid();
    unsigned char* ws = p.ws;
    const int tid = threadIdx.x, G = gridDim.x, gtid = blockIdx.x * 512 + tid, nthr = G * 512;
    const int lo = p.ph_lo, hi = p.ph_hi;
    float* mods = (float*)(ws + WS_MODS);
    u16* H = (u16*)(ws + WS_H); u16* HID = (u16*)(ws + WS_HID);
#define IN(k) (lo <= (k) && (k) < hi)
    volatile LAS unsigned* xbst = (volatile LAS unsigned*)(lds + LDS_PHASE_BYTES);
    if (tid < 4) xbst[tid] = 0u;
    __syncthreads();
    XcdBarrier xbar = xcd_barrier_post((unsigned*)(ws + WS_BAR), xbst);
#define SYNC(k) do { if (IN(k) && IN((k) + 1)) { if ((k) == 0) grid.sync(); else xcd_barrier(xbar); } } while (0)
#ifndef REP_MASK
#define REP_MASK 0
#endif
#define REP(k) for (int _rep = 0; _rep < (((REP_MASK >> (k)) & 1) ? 2 : 1); ++_rep)

    if (IN(0)) REP(0) {
        LAS float* scl = (LAS float*)lds;
        for (int i = tid; i < 4096; i += 512) scl[i] = siluf_(p.in[I_C][i]);
        __syncthreads();
        float* part = (float*)(ws + WS_PART); const float* wada = p.in[I_WADA];
        for (int it = gtid; it < 32 * 4608; it += nthr) { const int kc = it / 4608, cgp = it % 4608;
            f32x4 a0 = (f32x4){0.f, 0.f, 0.f, 0.f}, a1 = a0; const float* wp = wada + (size_t)(kc * 64) * NMOD + cgp * 4;
#pragma unroll 8
            for (int k = 0; k < 64; ++k) { const f32x4 wv = *(const f32x4*)(wp + (size_t)k * NMOD); a0 += wv * scl[kc * 64 + k]; a1 += wv * scl[2048 + kc * 64 + k]; }
            *(f32x4*)(part + (size_t)(kc * 2 + 0) * NMOD + cgp * 4) = a0; *(f32x4*)(part + (size_t)(kc * 2 + 1) * NMOD + cgp * 4) = a1; }
        u16* BBAR = (u16*)(ws + WS_BBAR); f32x2* AV = (f32x2*)(ws + WS_AV); f32x2* AL = (f32x2*)(ws + WS_AL);
        for (int i = gtid; i < 4096; i += nthr) { const int g = i >> 6;
            const float dt = expf(p.in[I_LOGDT][g]); const float lr = fminf(p.in[I_LRE][i], -1e-4f), li = p.in[I_LIM][i];
            const float mag = expf(lr * dt); const float ar = mag * cosf(li * dt), ai = mag * sinf(li * dt);
            const float den = lr * lr + li * li, nr = ar - 1.f; const float kr = (nr * lr + ai * li) / den, ki = (ai * lr - nr * li) / den;
            const int pp = i & 63;
#pragma unroll
            for (int ii = 0; ii < 16; ++ii) { const float br = p.in[I_BRE][(size_t)i * 16 + ii], bi = p.in[I_BIM][(size_t)i * 16 + ii];
                BBAR[((size_t)(g * 128 + pp)) * 16 + ii] = f2bf(kr * br - ki * bi); BBAR[((size_t)(g * 128 + 64 + pp)) * 16 + ii] = f2bf(kr * bi + ki * br); }
            AV[i] = (f32x2){ar, ai}; float xr = ar, xi = ai;
#pragma unroll
            for (int s = 0; s < 8; ++s) { const float t = xr * xr - xi * xi; xi = 2.f * xr * xi; xr = t; }
            AL[i] = (f32x2){xr, xi}; }
        u16* CM = (u16*)(ws + WS_CM);
        for (int i = gtid; i < 131072; i += nthr) { const int gi = i >> 7, q = i & 127; CM[i] = f2bf(q < 64 ? p.in[I_CRE][(size_t)gi * 64 + q] : -p.in[I_CIM][(size_t)gi * 64 + q - 64]); }
    }
    SYNC(0);
    if (IN(1)) REP(1) {
        const float* part = (const float*)(ws + WS_PART);
        for (int i = gtid; i < 2 * NMOD; i += nthr) { const int b = i / NMOD, j = i % NMOD; float s = p.in[I_BADA][j];
#pragma unroll 8
            for (int kc = 0; kc < 32; ++kc) s += part[(size_t)(kc * 2 + b) * NMOD + j];
            mods[i] = s; }
        int tb = 0; LAS float* T = (LAS float*)lds;
        conv_weight(T, p.in[I_W1IN], (u16*)(ws + WS_W1IN), 2048, 2 * FF, 2 * FF, 0, tb, true);
        conv_weight(T, p.in[I_W1OUT], (u16*)(ws + WS_W1OUT), FF, 2048, 2048, 1, tb);
        conv_weight(T, p.in[I_WIN], (u16*)(ws + WS_WIN), 2048, 10272, NPROJ_C, 2, tb);
        conv_weight(T, p.in[I_WA], (u16*)(ws + WS_WA), 2048, 2048, 2048, 1, tb);
        conv_weight(T, p.in[I_WB], (u16*)(ws + WS_WB), 1024, 4096, 4096, 3, tb);
        conv_weight(T, p.in[I_WO], (u16*)(ws + WS_WO), 2048, 2048, 2048, 1, tb);
    }
    SYNC(1);
    if (IN(2)) REP(2) norm_rows<0, true>(p.in[I_X], p.in[I_NF1], mods + 0 * DM, mods + 1 * DM, H, nullptr);
    SYNC(2);
    if (IN(3)) REP(3) { pg8::Gemm g{H, (const u16*)(ws + WS_W1IN), M_TOK, 2 * FF, 2048}; pg8::StaticOrder S; S.init(M_TOK, 2 * FF, G, blockIdx.x); EpiSwiglu E{HID}; pg8::gemm_phase<EpiSwiglu, true, true>(lds, g, S, E); }
    SYNC(3);
    if (IN(4)) REP(4) { pg8::Gemm g{HID, (const u16*)(ws + WS_W1OUT), M_TOK, 2048, FF}; pg8::StaticOrder S; S.init(M_TOK, 2048, G, blockIdx.x, true); EpiResid E{p.in[I_X], p.out, mods + 2 * DM, 0.5f}; pg8::gemm_phase(lds, g, S, E); }
    SYNC(4);
    if (IN(5)) REP(5) {
        norm_dt_rows(p.out, p.in[I_NMIX], mods + 3 * DM, mods + 4 * DM, H, (const u16*)(ws + WS_WIN) + (size_t)NPROJ_G * 2048, p.in[I_DTB], (float*)(ws + WS_DT));
        int tb = 0; LAS float* T = (LAS float*)lds;
        conv_weight(T, p.in[I_W2IN], (u16*)(ws + WS_W1IN), 2048, 2 * FF, 2 * FF, 0, tb, true);
        conv_weight(T, p.in[I_W2OUT], (u16*)(ws + WS_W1OUT), FF, 2048, 2048, 1, tb);
    }
    SYNC(5);
    if (IN(6)) REP(6) { pg8::Gemm g{H, (const u16*)(ws + WS_WIN), M_TOK, NPROJ_G, 2048}; pg8::StaticOrder S; S.init(M_TOK, NPROJ_G, G, blockIdx.x);
        EpiProj E{(u16*)(ws + WS_Z), (u16*)(ws + WS_X), (u16*)(ws + WS_U), (u16*)(ws + WS_G), (float*)(ws + WS_DT), p.in[I_DTB]}; pg8::gemm_phase(lds, g, S, E); }
    SYNC(6);
    if (IN(7)) REP(7) {
        __syncthreads();
        REP(17) for (int it = blockIdx.x; it < 512; it += G) ssd_a_item(p, lds, it);
        REP(18) for (int it = blockIdx.x * 8 + (tid >> 6); it < 4096; it += G * 8) s5_item<false>(p, lds, it);
    }
    SYNC(7);
    if (IN(8)) REP(8) {
        u16* ST = (u16*)(ws + WS_ST); const float* CS = (const float*)(ws + WS_CS);
        for (int idx = gtid; idx < 131072; idx += nthr) { const int n4 = idx & 31, pp = (idx >> 5) & 63, h = (idx >> 11) & 31, b = idx >> 16;
            float run[4] = {0.f, 0.f, 0.f, 0.f};
#pragma unroll 1
            for (int cb = 0; cb < 64; cb += 16) {
                u32x2 sv[16]; float cse[16];
#pragma unroll
                for (int i = 0; i < 16; ++i) { const size_t hc = (size_t)((b * 64 + cb + i) * 32 + h); sv[i] = *(const u32x2*)(ST + (hc * 64 + pp) * 128 + n4 * 4); cse[i] = CS[hc * 128 + 127]; }
#pragma unroll
                for (int i = 0; i < 16; ++i) { const size_t hc = (size_t)((b * 64 + cb + i) * 32 + h); const float dec = __expf(cse[i]);
                    u32x2 o; o.x = cvt_pk_bf16(run[0], run[1]); o.y = cvt_pk_bf16(run[2], run[3]); *(u32x2*)(ST + (hc * 64 + pp) * 128 + n4 * 4) = o;
                    run[0] = dec * run[0] + bflo(sv[i].x); run[1] = dec * run[1] + bfhi(sv[i].x); run[2] = dec * run[2] + bflo(sv[i].y); run[3] = dec * run[3] + bfhi(sv[i].y); }
            } }
        const f32x2* AL = (const f32x2*)(ws + WS_AL); const f32x2* SEND = (const f32x2*)(ws + WS_SEND); f32x2* SINIT = (f32x2*)(ws + WS_SINIT);
        for (int idx = gtid; idx < 8192; idx += nthr) { const int gp = idx & 4095, b = idx >> 12; const f32x2 a = AL[gp]; float sr = 0.f, si = 0.f;
            f32x2 ev[32];
#pragma unroll
            for (int tc = 0; tc < 32; ++tc) ev[tc] = SEND[(size_t)(b * 32 + tc) * 4096 + gp];
#pragma unroll
            for (int tc = 0; tc < 32; ++tc) { SINIT[(size_t)(b * 32 + tc) * 4096 + gp] = (f32x2){sr, si};
                const float nr = a.x * sr - a.y * si + ev[tc].x, ni = a.x * si + a.y * sr + ev[tc].y; sr = nr; si = ni; } }
    }
    SYNC(8);
    if (IN(9)) REP(9) {
        __syncthreads();
        REP(19) for (int it = blockIdx.x; it < 512; it += G) ssd_c_item(p, lds, it);
        REP(20) for (int it = blockIdx.x * 8 + (tid >> 6); it < 4096; it += G * 8) s5_item<true>(p, lds, it);
    }
    SYNC(9);
    if (IN(10)) REP(10) { pg8::Gemm g{(const u16*)(ws + WS_YB), (const u16*)(ws + WS_WB), M_TOK, 4096, 1024}; pg8::StaticOrder S; S.init(M_TOK, 4096, G, blockIdx.x); EpiGlu E{(u16*)(ws + WS_MB), (const u16*)(ws + WS_G)}; pg8::gemm_phase(lds, g, S, E); }
    SYNC(10);
    if (IN(11)) REP(11) { pg8::Gemm g{(const u16*)(ws + WS_YA), (const u16*)(ws + WS_WA), M_TOK, 2048, 2048}; pg8::StaticOrder S; S.init(M_TOK, 2048, G, blockIdx.x); EpiMerge E{H, (const u16*)(ws + WS_G), (const u16*)(ws + WS_MB)}; pg8::gemm_phase(lds, g, S, E); }
    SYNC(11);
    if (IN(12)) REP(12) { pg8::Gemm g{H, (const u16*)(ws + WS_WO), M_TOK, 2048, 2048}; pg8::StaticOrder S; S.init(M_TOK, 2048, G, blockIdx.x); EpiResid E{p.out, p.out, mods + 5 * DM, 1.0f}; pg8::gemm_phase(lds, g, S, E); }
    SYNC(12);
    if (IN(13)) REP(13) norm_rows<0>(p.out, p.in[I_NF2], mods + 6 * DM, mods + 7 * DM, H, nullptr);
    SYNC(13);
    if (IN(14)) REP(14) { pg8::Gemm g{H, (const u16*)(ws + WS_W1IN), M_TOK, 2 * FF, 2048}; pg8::StaticOrder S; S.init(M_TOK, 2 * FF, G, blockIdx.x); EpiSwiglu E{HID}; pg8::gemm_phase<EpiSwiglu, false, true>(lds, g, S, E); }
    SYNC(14);
    if (IN(15)) REP(15) { pg8::Gemm g{HID, (const u16*)(ws + WS_W1OUT), M_TOK, 2048, FF}; pg8::StaticOrder S; S.init(M_TOK, 2048, G, blockIdx.x, true); EpiResid E{p.out, p.out, mods + 8 * DM, 0.5f}; pg8::gemm_phase(lds, g, S, E); }
    SYNC(15);
    if (IN(16)) REP(16) norm_rows<1>(p.out, p.in[I_NFIN], nullptr, nullptr, nullptr, p.out);
#undef IN
#undef SYNC
}

#ifndef MK_SPLIT
#define MK_SPLIT 0
#endif
extern "C" void kernel_launch(void* const* d_in, const int* in_sizes, int n_in, void* d_out, int out_size, void* d_ws, size_t ws_size, hipStream_t stream) {
    static int grid = 0;
    if (grid == 0) {
        if (n_in != 30 || ws_size < WS_END) { fprintf(stderr, "kernel_launch: n_in %d ws %zu (need %zu)\n", n_in, ws_size, (size_t)WS_END); grid = -1; return; }
        int dev = 0, cus = 0, per_cu = 0;
        (void)hipGetDevice(&dev); (void)hipDeviceGetAttribute(&cus, hipDeviceAttributeMultiprocessorCount, dev);
        (void)hipFuncSetAttribute((const void*)mega, hipFuncAttributeMaxDynamicSharedMemorySize, LDS_BYTES);
        (void)hipOccupancyMaxActiveBlocksPerMultiprocessor(&per_cu, (const void*)mega, 512, LDS_BYTES);
        if (per_cu < 1) per_cu = 1;
        grid = cus * per_cu; if (grid > 256) grid = 256;
    }
    if (grid < 0) return;
    Params p{};
    for (int i = 0; i < 30; ++i) p.in[i] = (const float*)d_in[i];
    p.out = (float*)d_out; p.ws = (unsigned char*)d_ws;
    (void)hipMemsetAsync((unsigned char*)d_ws + WS_BAR, 0, 16384, stream);
#if MK_SPLIT
    for (int ph = 0; ph < NPH; ++ph) { p.ph_lo = ph; p.ph_hi = ph + 1; void* args[] = {&p};
        (void)hipLaunchCooperativeKernel((void*)mega, dim3(grid), dim3(512), args, LDS_BYTES, stream); }
#else
    p.ph_lo = 0; p.ph_hi = NPH; void* args[] = {&p};
    hipError_t e = hipLaunchCooperativeKernel((void*)mega, dim3(grid), dim3(512), args, LDS_BYTES, stream);
    if (e != hipSuccess) fprintf(stderr, "cooperative launch failed: %s (grid %d)\n", hipGetErrorString(e), grid);
#endif
}
```

```cpp
#include <hip/hip_runtime.h>
#include <hip/hip_cooperative_groups.h>
#include <cstdio>
#define REP_MASK 0
namespace cg = cooperative_groups;

#define LAS __attribute__((address_space(3)))
typedef unsigned short u16;
typedef short bf16x8 __attribute__((ext_vector_type(8)));
typedef float f32x4 __attribute__((ext_vector_type(4)));
typedef float f32x2 __attribute__((ext_vector_type(2)));
typedef unsigned u32x4 __attribute__((ext_vector_type(4)));
typedef unsigned u32x2 __attribute__((ext_vector_type(2)));

constexpr int M_TOK = 16384, DM = 2048, FF = 5504, SEQ = 8192;
constexpr int NPROJ = 10496;
constexpr int NPROJ_G = 10240, NPROJ_C = 10304;
constexpr int NMOD = 18432;
constexpr int LDS_PHASE_BYTES = 147456;
constexpr int LDS_BYTES = LDS_PHASE_BYTES + 16;
constexpr int NPH = 17;

constexpr size_t WS_W1IN = 0;
constexpr size_t WS_W1OUT = WS_W1IN + (size_t)11008 * 2048 * 2;
constexpr size_t WS_WIN = WS_W1OUT + (size_t)2048 * 5504 * 2;
constexpr size_t WS_WA = WS_WIN + (size_t)NPROJ * 2048 * 2;
constexpr size_t WS_WB = WS_WA + (size_t)2048 * 2048 * 2;
constexpr size_t WS_WO = WS_WB + (size_t)4096 * 1024 * 2;
constexpr size_t WS_H = WS_WO + (size_t)2048 * 2048 * 2;
constexpr size_t WS_HID = WS_H + (size_t)M_TOK * 2048 * 2;
constexpr size_t WS_X = WS_HID + (size_t)M_TOK * FF * 2;
constexpr size_t WS_G = WS_X + (size_t)M_TOK * 3072 * 2;
constexpr size_t WS_MISC = WS_G + (size_t)M_TOK * 4096 * 2;
constexpr size_t WS_Z = WS_HID;
constexpr size_t WS_U = WS_Z + (size_t)M_TOK * 2048 * 2;
constexpr size_t WS_DT = WS_U + (size_t)M_TOK * 1024 * 2;
constexpr size_t WS_CS = WS_DT + (size_t)M_TOK * 32 * 4;
constexpr size_t WS_ST = WS_CS + (size_t)M_TOK * 32 * 4;
constexpr size_t WS_MB = WS_ST;
static_assert(WS_ST + (size_t)M_TOK * 2048 * 2 <= WS_X, "mixer buffers overflow HID");
constexpr size_t WS_BC = WS_WIN;
constexpr size_t WS_CC = WS_BC + (size_t)M_TOK * 512 * 2;
constexpr size_t WS_YA = WS_X;
constexpr size_t WS_YB = WS_YA + (size_t)M_TOK * 2048 * 2;
constexpr size_t WS_PART = WS_MISC;
constexpr size_t WS_MODS = WS_PART + (size_t)32 * 2 * NMOD * 4;
constexpr size_t WS_BBAR = WS_MODS + (size_t)2 * NMOD * 4;
constexpr size_t WS_CM = WS_BBAR + (size_t)64 * 128 * 16 * 2;
constexpr size_t WS_AV = WS_CM + (size_t)64 * 16 * 128 * 2;
constexpr size_t WS_AL = WS_AV + (size_t)4096 * 8;
constexpr size_t WS_SEND = WS_AL + (size_t)4096 * 8;
constexpr size_t WS_SINIT = WS_SEND + (size_t)2 * 32 * 4096 * 8;
constexpr size_t WS_BAR = WS_SINIT + (size_t)2 * 32 * 4096 * 8;
constexpr size_t WS_BCT = WS_BAR + 16384;
constexpr size_t WS_END = WS_BCT + (size_t)512 * 16384 * 2;

struct Params {
    const float* in[30];
    float* out; unsigned char* ws; int ph_lo, ph_hi;
};
enum { I_X = 0, I_C, I_WADA, I_BADA, I_NF1, I_W1IN, I_W1OUT, I_NMIX, I_WIN, I_CONVW, I_CONVB, I_DTB, I_ALOG, I_DSSD, I_SNW, I_WA,
       I_LRE, I_LIM, I_BRE, I_BIM, I_CRE, I_CIM, I_S5D, I_LOGDT, I_WB, I_WO, I_NF2, I_W2IN, I_W2OUT, I_NFIN };

__device__ __forceinline__ unsigned cvt_pk_bf16(float lo, float hi) { unsigned r; asm volatile("v_cvt_pk_bf16_f32 %0, %1, %2" : "=v"(r) : "v"(lo), "v"(hi)); return r; }
__device__ __forceinline__ u16 f2bf(float f) { return (u16)(cvt_pk_bf16(f, 0.f) & 0xffffu); }
__device__ __forceinline__ float bf2f(u16 b) { return __uint_as_float(((unsigned)b) << 16); }
__device__ __forceinline__ float bflo(unsigned w) { return __uint_as_float(w << 16); }
__device__ __forceinline__ float bfhi(unsigned w) { return __uint_as_float(w & 0xffff0000u); }
__device__ __forceinline__ float sigmoidf_(float v) { return __builtin_amdgcn_rcpf(1.f + __expf(-v)); }
__device__ __forceinline__ float siluf_(float v) { return v * sigmoidf_(v); }
__device__ __forceinline__ float gelu_tanh(float v) { const float z = 0.7978845608028654f * (v + 0.044715f * v * v * v); const float t = 1.f - 2.f * __builtin_amdgcn_rcpf(__expf(2.f * z) + 1.f); return 0.5f * v * (1.f + t); }
__device__ __forceinline__ bf16x8 pack8(const float* f) { u32x4 w; w.x = cvt_pk_bf16(f[0], f[1]); w.y = cvt_pk_bf16(f[2], f[3]); w.z = cvt_pk_bf16(f[4], f[5]); w.w = cvt_pk_bf16(f[6], f[7]); return __builtin_bit_cast(bf16x8, w); }
#define MFMA16(a, b, c) __builtin_amdgcn_mfma_f32_16x16x32_bf16((a), (b), (c), 0, 0, 0)

namespace pg8 {
constexpr int BM = 256, BK = 64, HALF = 128, HTB = HALF * BK * 2, STAGE_BYTES = 8 * HTB, NXCD = 8, WGM = 8;
__device__ __forceinline__ int lds_byte(int r, int c) { const int st = (r >> 4) * 2 + (c >> 5), rr = r & 15, cc = c & 31, ob = rr * 64 + cc * 2; return st * 1024 + (ob ^ (((ob >> 9) & 1) << 5)); }
__device__ __forceinline__ void stage_rc(int b, int& R, int& C) { const int st = b / 1024, sb = b % 1024, swz = sb ^ (((sb >> 9) & 1) << 5); R = (st >> 1) * 16 + swz / 64; C = (st & 1) * 32 + (swz % 64) / 2; }
__device__ __forceinline__ int perm32(int rho) { const int n = rho >> 4, i = rho & 15; return 8 * (i >> 2) + 4 * n + (i & 3); }
struct Unit { int pm, pn; };
struct Gemm { const u16* A; const u16* Bt; int M, N, K; };
struct StaticOrder {
    int nM, nN, nwg, G, c; bool pnfast;
    __device__ void init(int M, int N, int G_, int c_, bool pf = false) { nM = M / BM; nN = N / BM; nwg = nM * nN; G = G_; c = c_; pnfast = pf; }
    __device__ bool next(int i, Unit& u) const {
        const long L = (long)i * G + c; if (L >= nwg) return false;
        int wgid = (int)L; { const int q = nwg / NXCD, r = nwg % NXCD, xcd = wgid % NXCD, off = wgid / NXCD; wgid = (xcd < r ? xcd * (q + 1) : r * (q + 1) + (xcd - r) * q) + off; }
        const int nig = WGM * nN, gid = wgid / nig, fm = gid * WGM, gsz = (nM - fm) < WGM ? (nM - fm) : WGM;
        if (pnfast) { u.pm = fm + (wgid % nig) / nN; u.pn = (wgid % nig) % nN; } else { u.pm = fm + ((wgid % nig) % gsz); u.pn = (wgid % nig) / gsz; }
        return true;
    }
};

template <class Epi, bool TA = false, bool TB = false>
__device__ __forceinline__ void gemm_phase(LAS unsigned char* lds, const Gemm g, const StaticOrder& S, const Epi& E) {
    const int tid = threadIdx.x, wid = __builtin_amdgcn_readfirstlane(tid >> 6), lane = tid & 63, wr = wid >> 2, wc = wid & 3, fr = lane & 15, fq = lane >> 4;
    const int K = g.K, nt = K / BK;
    unsigned voffA[2], voffB[2];
#pragma unroll
    for (int i = 0; i < 2; ++i) { int R, C; stage_rc(tid * 16 + i * 8192, R, C); const int Rb = Epi::PERM ? ((R & ~31) + perm32(R & 31)) : R;
        voffA[i] = (unsigned)(R * (TA ? BK : K) + C) * 2u; voffB[i] = (unsigned)(Rb * (TB ? BK : K) + C) * 2u; }
    const size_t kstepA = TA ? (size_t)HTB : (size_t)(BK * 2), kstepB = TB ? (size_t)HTB : (size_t)(BK * 2);
    const size_t hstepA = TA ? (size_t)nt * HTB : (size_t)HALF * K * 2, hstepB = TB ? (size_t)nt * HTB : (size_t)HALF * K * 2;
    const size_t tstep = (size_t)BM * K * 2;
    const unsigned ldsw = (unsigned)wid * 1024u;
    const int aoff = lds_byte(wr * 64 + fr, fq * 8), boff = lds_byte(wc * 32 + fr, fq * 8);
#define PG8_SA(b, h) (((b) * 2 + (h)) * HTB)
#define PG8_SB(b, h) ((4 + (b) * 2 + (h)) * HTB)
#define PG8_STAGE(bufoff, gbase, voff) do { _Pragma("unroll") for (int _i = 0; _i < 2; ++_i) \
        __builtin_amdgcn_global_load_lds((const unsigned*)((const char*)(gbase) + (voff)[_i]), (LAS unsigned*)(lds + (bufoff) + ldsw + _i * 8192), 16, 0, 0); } while (0)
#define PG8_LDA(dst, b, h) do { _Pragma("unroll") for (int m = 0; m < 4; ++m) _Pragma("unroll") for (int k = 0; k < 2; ++k) dst[m][k] = *(const LAS bf16x8*)(lds + PG8_SA(b, h) + aoff + m * 2048 + k * 1024); } while (0)
#define PG8_LDB(dst, b, h) do { _Pragma("unroll") for (int n = 0; n < 2; ++n) _Pragma("unroll") for (int k = 0; k < 2; ++k) dst[n][k] = *(const LAS bf16x8*)(lds + PG8_SB(b, h) + boff + n * 2048 + k * 1024); } while (0)
#define PG8_MMA(ai, bj, At, Bt) do { __builtin_amdgcn_s_setprio(1); _Pragma("unroll") for (int m = 0; m < 4; ++m) _Pragma("unroll") for (int n = 0; n < 2; ++n) _Pragma("unroll") for (int k = 0; k < 2; ++k) \
        acc[ai][bj][m][n] = __builtin_amdgcn_mfma_f32_16x16x32_bf16(Bt[n][k], At[m][k], acc[ai][bj][m][n], 0, 0, 0); __builtin_amdgcn_s_setprio(0); } while (0)
#define PG8_WAIT_V(n) asm volatile("s_waitcnt vmcnt(" #n ")" ::: "memory")
#define PG8_WAIT_L(n) asm volatile("s_waitcnt lgkmcnt(" #n ")" ::: "memory")
#define PG8_BAR __builtin_amdgcn_s_barrier()
#define PG8_SCHED __builtin_amdgcn_sched_barrier(0)
    Unit cur, nxt; int ui = 0;
    if (!S.next(0, cur)) return;
    f32x4 acc[2][2][4][2];
#pragma unroll
    for (int a = 0; a < 2; ++a)
#pragma unroll
        for (int b = 0; b < 2; ++b)
#pragma unroll
            for (int m = 0; m < 4; ++m)
#pragma unroll
                for (int n = 0; n < 2; ++n) acc[a][b][m][n] = (f32x4){0.f, 0.f, 0.f, 0.f};
    bf16x8 At[4][2], B0[2][2], B1[2][2];
    const char* cA = (const char*)g.A + (size_t)cur.pm * tstep; const char* cB = (const char*)g.Bt + (size_t)cur.pn * tstep;
    PG8_STAGE(PG8_SB(0, 0), cB, voffB); PG8_STAGE(PG8_SA(0, 0), cA, voffA); PG8_STAGE(PG8_SB(0, 1), cB + hstepB, voffB); PG8_STAGE(PG8_SA(0, 1), cA + hstepA, voffA);
    if (wr == 1) PG8_BAR;
    PG8_WAIT_V(4); PG8_BAR;
    PG8_STAGE(PG8_SB(1, 0), cB + kstepB, voffB); PG8_STAGE(PG8_SA(1, 0), cA + kstepA, voffA); PG8_STAGE(PG8_SB(1, 1), cB + hstepB + kstepB, voffB);
    PG8_WAIT_V(6); PG8_BAR;
    for (;;) {
        const bool has_next = S.next(ui + 1, nxt);
        const char* nA = has_next ? (const char*)g.A + (size_t)nxt.pm * tstep : cA; const char* nB = has_next ? (const char*)g.Bt + (size_t)nxt.pn * tstep : cB;
        for (int t = 0; t < nt; t += 2) {
            const bool last = (t == nt - 2);
            const char* a1 = cA + (size_t)(t + 1) * kstepA;
            const char* a2 = last ? nA : cA + (size_t)(t + 2) * kstepA; const char* b2 = last ? nB : cB + (size_t)(t + 2) * kstepB;
            const char* a3 = a2 + kstepA; const char* b3 = b2 + kstepB;
            PG8_LDB(B0, 0, 0); PG8_SCHED; PG8_LDA(At, 0, 0); PG8_STAGE(PG8_SA(1, 1), a1 + hstepA, voffA);
            PG8_WAIT_L(8); PG8_BAR; PG8_WAIT_L(0); PG8_MMA(0, 0, At, B0); PG8_BAR; PG8_SCHED;
            PG8_LDB(B1, 0, 1); PG8_STAGE(PG8_SB(0, 0), b2, voffB);
            PG8_BAR; PG8_WAIT_L(0); PG8_MMA(0, 1, At, B1); PG8_BAR;
            PG8_LDA(At, 0, 1); PG8_STAGE(PG8_SA(0, 0), a2, voffA);
            PG8_BAR; PG8_WAIT_L(0); PG8_MMA(1, 0, At, B0); PG8_BAR; PG8_SCHED;
            PG8_STAGE(PG8_SB(0, 1), b2 + hstepB, voffB);
            PG8_WAIT_V(6); PG8_BAR; PG8_MMA(1, 1, At, B1); PG8_BAR;
            PG8_LDB(B0, 1, 0); PG8_SCHED; PG8_LDA(At, 1, 0); PG8_STAGE(PG8_SA(0, 1), a2 + hstepA, voffA);
            PG8_WAIT_L(8); PG8_BAR; PG8_WAIT_L(0); PG8_MMA(0, 0, At, B0); PG8_BAR; PG8_SCHED;
            PG8_LDB(B1, 1, 1); PG8_STAGE(PG8_SB(1, 0), b3, voffB);
            PG8_BAR; PG8_WAIT_L(0); PG8_MMA(0, 1, At, B1); PG8_BAR;
            PG8_LDA(At, 1, 1); PG8_STAGE(PG8_SA(1, 0), a3, voffA);
            PG8_BAR; PG8_WAIT_L(0); PG8_MMA(1, 0, At, B0); PG8_BAR; PG8_SCHED;
            PG8_STAGE(PG8_SB(1, 1), b3 + hstepB, voffB);
            PG8_WAIT_V(6); PG8_BAR; PG8_MMA(1, 1, At, B1); PG8_BAR;
        }
        E(acc, cur, wr, wc, fr, fq);
        if (!has_next) break;
#pragma unroll
        for (int a = 0; a < 2; ++a)
#pragma unroll
            for (int b = 0; b < 2; ++b)
#pragma unroll
                for (int m = 0; m < 4; ++m)
#pragma unroll
                    for (int n = 0; n < 2; ++n) acc[a][b][m][n] = (f32x4){0.f, 0.f, 0.f, 0.f};
        cur = nxt; cA = nA; cB = nB; ++ui;
    }
    PG8_WAIT_V(0);
    if (wr == 0) PG8_BAR;
    PG8_BAR;
#undef PG8_SA
#undef PG8_SB
#undef PG8_STAGE
#undef PG8_LDA
#undef PG8_LDB
#undef PG8_MMA
#undef PG8_WAIT_V
#undef PG8_WAIT_L
#undef PG8_BAR
#undef PG8_SCHED
}
}

struct EpiSwiglu {
    static constexpr bool PERM = true;
    u16* O;
    __device__ __forceinline__ void operator()(const f32x4 (&acc)[2][2][4][2], const pg8::Unit& u, int wr, int wc, int fr, int fq) const {
        const int row0 = u.pm * 256 + wr * 64 + fr, col0 = u.pn * 128 + wc * 32 + 8 * fq;
#pragma unroll
        for (int ai = 0; ai < 2; ++ai)
#pragma unroll
            for (int m = 0; m < 4; ++m) {
                float v[8];
#pragma unroll
                for (int n = 0; n < 2; ++n)
#pragma unroll
                    for (int j = 0; j < 4; ++j) v[n * 4 + j] = siluf_(acc[ai][0][m][n][j]) * acc[ai][1][m][n][j];
                *(bf16x8*)(O + (size_t)(row0 + ai * 128 + m * 16) * FF + col0) = pack8(v);
            }
    }
};
struct EpiResid {
    static constexpr bool PERM = false;
    const float* xin; float* xout; const float* gate; float scale;
    __device__ __forceinline__ void operator()(const f32x4 (&acc)[2][2][4][2], const pg8::Unit& u, int wr, int wc, int fr, int fq) const {
        const int row0 = u.pm * 256 + wr * 64 + fr, col0 = u.pn * 256 + wc * 32 + 4 * fq;
        const float* gp = gate + (u.pm >= 32 ? NMOD : 0) + col0;
        f32x4 gv[2][2];
#pragma unroll
        for (int bj = 0; bj < 2; ++bj)
#pragma unroll
            for (int n = 0; n < 2; ++n) gv[bj][n] = *(const f32x4*)(gp + bj * 128 + n * 16) * scale;
#pragma unroll
        for (int ai = 0; ai < 2; ++ai) {
            f32x4 xi[4][2][2];
#pragma unroll
            for (int m = 0; m < 4; ++m)
#pragma unroll
                for (int bj = 0; bj < 2; ++bj)
#pragma unroll
                    for (int n = 0; n < 2; ++n) xi[m][bj][n] = *(const f32x4*)(xin + (size_t)(row0 + ai * 128 + m * 16) * DM + col0 + bj * 128 + n * 16);
#pragma unroll
            for (int m = 0; m < 4; ++m)
#pragma unroll
                for (int bj = 0; bj < 2; ++bj)
#pragma unroll
                    for (int n = 0; n < 2; ++n) *(f32x4*)(xout + (size_t)(row0 + ai * 128 + m * 16) * DM + col0 + bj * 128 + n * 16) = xi[m][bj][n] + gv[bj][n] * acc[ai][bj][m][n];
        }
    }
};
struct EpiProj {
    static constexpr bool PERM = true;
    u16* Z; u16* XBC; u16* U; u16* G; float* DT; const float* dt_bias;
    __device__ __forceinline__ void operator()(const f32x4 (&acc)[2][2][4][2], const pg8::Unit& u, int wr, int wc, int fr, int fq) const {
        const int row0 = u.pm * 256 + wr * 64 + fr, pn = u.pn;
        if (pn == 40) {
            if (wc == 0) {
#pragma unroll
                for (int ai = 0; ai < 2; ++ai)
#pragma unroll
                    for (int m = 0; m < 4; ++m) {
#pragma unroll
                        for (int n = 0; n < 2; ++n) { f32x4 o;
#pragma unroll
                            for (int j = 0; j < 4; ++j) { const float v = acc[ai][0][m][n][j] + dt_bias[8 * fq + 4 * n + j]; o[j] = v > 20.f ? v : log1pf(__expf(v)); }
                            *(f32x4*)(DT + (size_t)(row0 + ai * 128 + m * 16) * 32 + 8 * fq + 4 * n) = o; }
                    }
            }
            return;
        }
        u16* base; int ld, colt; bool sg = false;
        if (pn < 8) { base = Z; ld = 2048; colt = pn * 256; }
        else if (pn < 20) { base = XBC; ld = 3072; colt = (pn - 8) * 256; }
        else if (pn < 24) { base = U; ld = 1024; colt = (pn - 20) * 256; }
        else { base = G; ld = 4096; colt = (pn - 24) * 256; sg = true; }
        const int col0 = colt + wc * 32 + 8 * fq;
#pragma unroll
        for (int ai = 0; ai < 2; ++ai)
#pragma unroll
            for (int m = 0; m < 4; ++m)
#pragma unroll
                for (int bj = 0; bj < 2; ++bj) {
                    float v[8];
#pragma unroll
                    for (int n = 0; n < 2; ++n)
#pragma unroll
                        for (int j = 0; j < 4; ++j) { const float a = acc[ai][bj][m][n][j]; v[n * 4 + j] = sg ? sigmoidf_(a) : a; }
                    *(bf16x8*)(base + (size_t)(row0 + ai * 128 + m * 16) * ld + col0 + bj * 128) = pack8(v);
                }
    }
};
struct EpiGlu {
    static constexpr bool PERM = true;
    u16* O; const u16* G;
    __device__ __forceinline__ void operator()(const f32x4 (&acc)[2][2][4][2], const pg8::Unit& u, int wr, int wc, int fr, int fq) const {
        const int row0 = u.pm * 256 + wr * 64 + fr, col0 = u.pn * 128 + wc * 32 + 8 * fq;
        u32x4 gw[2][4];
#pragma unroll
        for (int ai = 0; ai < 2; ++ai)
#pragma unroll
            for (int m = 0; m < 4; ++m) gw[ai][m] = *(const u32x4*)(G + (size_t)(row0 + ai * 128 + m * 16) * 4096 + 2048 + col0);
#pragma unroll
        for (int ai = 0; ai < 2; ++ai)
#pragma unroll
            for (int m = 0; m < 4; ++m) {
                const size_t row = (size_t)(row0 + ai * 128 + m * 16);
                const u32x4 g4 = gw[ai][m];
                const float gb[8] = {bflo(g4.x), bfhi(g4.x), bflo(g4.y), bfhi(g4.y), bflo(g4.z), bfhi(g4.z), bflo(g4.w), bfhi(g4.w)};
                float v[8];
#pragma unroll
                for (int n = 0; n < 2; ++n)
#pragma unroll
                    for (int j = 0; j < 4; ++j) v[n * 4 + j] = gb[n * 4 + j] * acc[ai][0][m][n][j] * sigmoidf_(acc[ai][1][m][n][j]);
                *(bf16x8*)(O + row * DM + col0) = pack8(v);
            }
    }
};
struct EpiMerge {
    static constexpr bool PERM = true;
    u16* O; const u16* G; const u16* MB;
    __device__ __forceinline__ void operator()(const f32x4 (&acc)[2][2][4][2], const pg8::Unit& u, int wr, int wc, int fr, int fq) const {
        const int row0 = u.pm * 256 + wr * 64 + fr, col0 = u.pn * 256 + wc * 32 + 8 * fq;
#pragma unroll
        for (int ai = 0; ai < 2; ++ai) {
            u32x4 gw[4][2], mw[4][2];
#pragma unroll
            for (int m = 0; m < 4; ++m)
#pragma unroll
                for (int bj = 0; bj < 2; ++bj) { const size_t row = (size_t)(row0 + ai * 128 + m * 16); const int col = col0 + bj * 128;
                    gw[m][bj] = *(const u32x4*)(G + row * 4096 + col); mw[m][bj] = *(const u32x4*)(MB + row * DM + col); }
#pragma unroll
            for (int m = 0; m < 4; ++m)
#pragma unroll
                for (int bj = 0; bj < 2; ++bj) {
                    const size_t row = (size_t)(row0 + ai * 128 + m * 16); const int col = col0 + bj * 128;
                    const u32x4 g4 = gw[m][bj], m4 = mw[m][bj];
                    const float ga[8] = {bflo(g4.x), bfhi(g4.x), bflo(g4.y), bfhi(g4.y), bflo(g4.z), bfhi(g4.z), bflo(g4.w), bfhi(g4.w)};
                    const float mb[8] = {bflo(m4.x), bfhi(m4.x), bflo(m4.y), bfhi(m4.y), bflo(m4.z), bfhi(m4.z), bflo(m4.w), bfhi(m4.w)};
                    float v[8];
#pragma unroll
                    for (int n = 0; n < 2; ++n)
#pragma unroll
                        for (int j = 0; j < 4; ++j) v[n * 4 + j] = ga[n * 4 + j] * acc[ai][bj][m][n][j] + mb[n * 4 + j];
                    *(bf16x8*)(O + row * DM + col) = pack8(v);
                }
        }
    }
};

__device__ __forceinline__ size_t tiled_off(int row, int col, int K) { return ((size_t)(row >> 7) * (K >> 6) + (col >> 6)) * 8192 + (size_t)(row & 127) * 64 + (col & 63); }

__device__ __forceinline__ int map_col(int wsel, int n) {
    if (wsel == 0) return ((n >> 7) & 1) * FF + (n >> 8) * 128 + (n & 127);
    if (wsel == 3) return ((n >> 7) & 1) * 2048 + (n >> 8) * 128 + (n & 127);
    if (wsel == 2) { if (n < 5120) return n; if (n < 6144) return 5152 + (n - 5120); if (n < 10240) return 6176 + (n - 6144); if (n < 10272) return 5120 + (n - 10240); return -1; }
    return n;
}
__device__ __forceinline__ void conv_weight(LAS float* T, const float* __restrict__ src, u16* __restrict__ dst, int K, int ld, int ndst, int wsel, int& tbase, bool tiled = false) {
    const int nnt = ndst / 64, ntiles = (K / 128) * nnt, tid = threadIdx.x, G = gridDim.x;
    const int first = (((int)blockIdx.x - tbase) % G + G) % G;
    for (int t = first; t < ntiles; t += G) {
        const int n0 = (t % nnt) * 64, k0 = (t / nnt) * 128;
        { const int c4 = tid & 15, r = tid >> 4; const int sc = map_col(wsel, n0 + c4 * 4);
#pragma unroll
          for (int ps = 0; ps < 4; ++ps) { const int kr = r + ps * 32;
              f32x4 v = (f32x4){0.f, 0.f, 0.f, 0.f}; if (sc >= 0) v = *(const f32x4*)(src + (size_t)(k0 + kr) * ld + sc);
              LAS float* tp = T + kr * 65 + c4 * 4; tp[0] = v.x; tp[1] = v.y; tp[2] = v.z; tp[3] = v.w; } }
        __syncthreads();
        { const int kg = tid >> 5, nl = tid & 31;
#pragma unroll
          for (int ps = 0; ps < 2; ++ps) { const int n = nl + ps * 32; float f[8];
#pragma unroll
              for (int j = 0; j < 8; ++j) f[j] = T[(kg * 8 + j) * 65 + n];
              *(bf16x8*)(dst + (tiled ? tiled_off(n0 + n, k0 + kg * 8, K) : (size_t)(n0 + n) * K + k0 + kg * 8)) = pack8(f); } }
        __syncthreads();
    }
    tbase += ntiles;
}

template <int MODE, bool TILED = false>
__device__ __forceinline__ void norm_rows(const float* src, const float* __restrict__ gw, const float* __restrict__ sh, const float* __restrict__ sc, u16* dst, float* fdst) {
    const int lane = threadIdx.x & 63, wg = blockIdx.x * 8 + (threadIdx.x >> 6), nw = gridDim.x * 8;
    for (int rp = wg; rp < M_TOK / 2; rp += nw) {
        f32x4 v[2][8]; float ss[2] = {0.f, 0.f};
#pragma unroll
        for (int q = 0; q < 2; ++q)
#pragma unroll
            for (int i = 0; i < 8; ++i) v[q][i] = *(const f32x4*)(src + (size_t)(rp * 2 + q) * DM + i * 256 + lane * 4);
#pragma unroll
        for (int q = 0; q < 2; ++q) {
#pragma unroll
            for (int i = 0; i < 8; ++i) ss[q] += v[q][i].x * v[q][i].x + v[q][i].y * v[q][i].y + v[q][i].z * v[q][i].z + v[q][i].w * v[q][i].w;
#pragma unroll
            for (int off = 32; off >= 1; off >>= 1) ss[q] += __shfl_xor(ss[q], off); }
#pragma unroll
        for (int q = 0; q < 2; ++q) { const int row = rp * 2 + q, bo = (row >> 13) * NMOD; const float rstd = rsqrtf(ss[q] * (1.f / 2048.f) + 1e-6f);
#pragma unroll
            for (int i = 0; i < 8; ++i) { const int col = i * 256 + lane * 4; const f32x4 g4 = *(const f32x4*)(gw + col);
                if (MODE == 0) { const f32x4 s4 = *(const f32x4*)(sc + bo + col), h4 = *(const f32x4*)(sh + bo + col);
                    const f32x4 o = v[q][i] * rstd * g4 * (s4 + 1.f) + h4;
                    u32x2 w; w.x = cvt_pk_bf16(o.x, o.y); w.y = cvt_pk_bf16(o.z, o.w); *(u32x2*)(dst + (TILED ? tiled_off(row, col, DM) : (size_t)row * DM + col)) = w; }
                else { *(f32x4*)(fdst + (size_t)row * DM + col) = v[q][i] * rstd * g4; } } }
    }
}

__device__ __forceinline__ void norm_dt_rows(const float* src, const float* __restrict__ gw, const float* __restrict__ sh, const float* __restrict__ sc, u16* dst,
                                             const u16* __restrict__ wdt  , const float* __restrict__ dt_bias, float* DT) {
    const int lane = threadIdx.x & 63, wg = blockIdx.x * 8 + (threadIdx.x >> 6), nw = gridDim.x * 8, fr = lane & 15, fq = lane >> 4;
    for (int rb = wg; rb < M_TOK / 8; rb += nw) {
        const int row0 = rb * 8, bo = (row0 >> 13) * NMOD;
#pragma unroll 1
        for (int i8 = 0; i8 < 8; ++i8) { const int row = row0 + i8;
            f32x4 v[8]; float ss = 0.f;
#pragma unroll
            for (int i = 0; i < 8; ++i) { v[i] = *(const f32x4*)(src + (size_t)row * DM + i * 256 + lane * 4); ss += v[i].x * v[i].x + v[i].y * v[i].y + v[i].z * v[i].z + v[i].w * v[i].w; }
#pragma unroll
            for (int off = 32; off >= 1; off >>= 1) ss += __shfl_xor(ss, off);
            const float rstd = rsqrtf(ss * (1.f / 2048.f) + 1e-6f);
#pragma unroll
            for (int i = 0; i < 8; ++i) { const int col = i * 256 + lane * 4; const f32x4 g4 = *(const f32x4*)(gw + col), s4 = *(const f32x4*)(sc + bo + col), h4 = *(const f32x4*)(sh + bo + col);
                const f32x4 o = v[i] * rstd * g4 * (s4 + 1.f) + h4;
                u32x2 wv; wv.x = cvt_pk_bf16(o.x, o.y); wv.y = cvt_pk_bf16(o.z, o.w); *(u32x2*)(dst + (size_t)row * DM + col) = wv; } }
        f32x4 a0 = (f32x4){0.f, 0.f, 0.f, 0.f}, a1 = a0;
        const u16* ap = dst + (size_t)(row0 + (fr & 7)) * DM + fq * 8; const u16* bp = wdt + (size_t)fr * 2048 + fq * 8;
        asm volatile("s_waitcnt vmcnt(0)" ::: "memory");
#pragma unroll 8
        for (int ks = 0; ks < 64; ++ks) { const bf16x8 a = *(const bf16x8*)(ap + ks * 32), b0 = *(const bf16x8*)(bp + ks * 32), b1 = *(const bf16x8*)(bp + 16 * 2048 + ks * 32);
            a0 = MFMA16(a, b0, a0); a1 = MFMA16(a, b1, a1); }
        if (fq < 2) {
#pragma unroll
            for (int j = 0; j < 4; ++j) { const float v0 = a0[j] + dt_bias[fr], v1 = a1[j] + dt_bias[16 + fr]; float* dp = DT + (size_t)(row0 + fq * 4 + j) * 32;
                dp[fr] = v0 > 20.f ? v0 : log1pf(__expf(v0)); dp[16 + fr] = v1 > 20.f ? v1 : log1pf(__expf(v1)); } }
    }
}

__device__ __forceinline__ void conv_tile4(const u32x4 (&raw)[11], const int jh, const float* __restrict__ cw, const float* __restrict__ cbp, float (&o)[8][4]) {
    const f32x4 w0 = *(const f32x4*)(cw + jh * 4), w1 = *(const f32x4*)(cw + 3072 + jh * 4), w2 = *(const f32x4*)(cw + 6144 + jh * 4), w3 = *(const f32x4*)(cw + 9216 + jh * 4), bb = *(const f32x4*)(cbp + jh * 4);
    f32x4 xr[11];
#pragma unroll
    for (int k = 0; k < 11; ++k) { const unsigned a = jh ? raw[k].z : raw[k].x, b2 = jh ? raw[k].w : raw[k].y; xr[k] = (f32x4){bflo(a), bfhi(a), bflo(b2), bfhi(b2)}; }
#pragma unroll
    for (int i = 0; i < 8; ++i) { const f32x4 v = bb + w0 * xr[i] + w1 * xr[i + 1] + w2 * xr[i + 2] + w3 * xr[i + 3];
#pragma unroll
        for (int jj = 0; jj < 4; ++jj) o[i][jj] = siluf_(v[jj]); }
}
constexpr int SA_XT = 17408, SA_CS_OFF = 8 * SA_XT, SA_DT_OFF = SA_CS_OFF + 4096, SA_BYTES = SA_DT_OFF + 4096;
__device__ __forceinline__ void ssd_a_item(const Params& p, LAS unsigned char* lds, int item) {
    unsigned char* ws = p.ws;
    const u16* XBC = (const u16*)(ws + WS_X); const float* DT = (const float*)(ws + WS_DT); float* CS = (float*)(ws + WS_CS);
    u16* Bc = (u16*)(ws + WS_BC); u16* Cc = (u16*)(ws + WS_CC); u16* XTG = (u16*)(ws + WS_H); u16* ST = (u16*)(ws + WS_ST);
    u16* BCT = (u16*)(ws + WS_BCT) + (size_t)item * 16384;
    const float* conv_w = p.in[I_CONVW]; const float* conv_b = p.in[I_CONVB];
    const int tid = threadIdx.x, lane = tid & 63, w = __builtin_amdgcn_readfirstlane(tid >> 6), fr = lane & 15, fq = lane >> 4;
    const int b = item >> 8, c = (item >> 2) & 63, g = item & 3, t0 = b * SEQ + c * 128, h = g * 8 + w;
    LAS u16* XT = (LAS u16*)(lds + w * SA_XT);
    LAS float* CSL = (LAS float*)(lds + SA_CS_OFF) + w * 128;
    LAS float* DTL = (LAS float*)(lds + SA_DT_OFF) + w * 128;
    { const float ah = -__expf(p.in[I_ALOG][h]); float carry = 0.f;
#pragma unroll
      for (int half = 0; half < 2; ++half) { const int l = lane + 64 * half; const float dtv = DT[(size_t)(t0 + l) * 32 + h]; float v = dtv * ah;
#pragma unroll
          for (int off = 1; off < 64; off <<= 1) { const float nb = __shfl_up(v, off); if (lane >= off) v += nb; }
          v += carry; carry = __shfl(v, 63);
          CSL[l] = v; DTL[l] = dtv; CS[((size_t)(b * 64 + c) * 32 + h) * 128 + l] = v; } }
    { const int cgx = tid & 31, l0 = (tid >> 5) * 8; const bool isC = cgx >= 16; const int n0 = (cgx & 15) * 8;
      const int col0 = 2048 + (isC ? 512 : 0) + g * 128 + n0;
      u32x4 raw[11];
#pragma unroll
      for (int k = 0; k < 11; ++k) { const int l = l0 - 3 + k; raw[k] = (u32x4){0u, 0u, 0u, 0u}; if (c * 128 + l >= 0) raw[k] = *(const u32x4*)(XBC + (size_t)((long)t0 + l) * 3072 + col0); }
      u16* op = (isC ? Cc : Bc) + (size_t)(t0 + l0) * 512 + g * 128 + n0;
#pragma unroll
      for (int jh = 0; jh < 2; ++jh) { float o[8][4]; conv_tile4(raw, jh, conv_w + col0, conv_b + col0, o);
#pragma unroll
          for (int i = 0; i < 8; ++i) { u32x2 wv; wv.x = cvt_pk_bf16(o[i][0], o[i][1]); wv.y = cvt_pk_bf16(o[i][2], o[i][3]); *(u32x2*)(op + (size_t)i * 512 + jh * 4) = wv; }
          if (!isC) {
#pragma unroll
              for (int j = 0; j < 4; ++j) { const float f[8] = {o[0][j], o[1][j], o[2][j], o[3][j], o[4][j], o[5][j], o[6][j], o[7][j]}; *(bf16x8*)(BCT + (size_t)(n0 + jh * 4 + j) * 128 + l0) = pack8(f); } } } }
    { const int p0 = (lane & 7) * 8, rg = lane >> 3, col0 = h * 64 + p0;
      u16* xtg = XTG + ((size_t)((b * 64 + c) * 32 + h) * 64) * 128;
      const float cs_end = CSL[127];
#pragma unroll 1
      for (int half = 0; half < 2; ++half) {
          const int l0 = half * 64 + rg * 8;
          u32x4 raw[11];
#pragma unroll
          for (int k = 0; k < 11; ++k) { const int l = l0 - 3 + k; raw[k] = (u32x4){0u, 0u, 0u, 0u}; if (c * 128 + l >= 0) raw[k] = *(const u32x4*)(XBC + (size_t)((long)t0 + l) * 3072 + col0); }
          float scl[8];
#pragma unroll
          for (int i = 0; i < 8; ++i) scl[i] = DTL[l0 + i] * __expf(cs_end - CSL[l0 + i]);
#pragma unroll
          for (int jh = 0; jh < 2; ++jh) { float o[8][4]; conv_tile4(raw, jh, conv_w + col0, conv_b + col0, o);
#pragma unroll
              for (int j = 0; j < 4; ++j) { const float f[8] = {o[0][j], o[1][j], o[2][j], o[3][j], o[4][j], o[5][j], o[6][j], o[7][j]};
                  *(bf16x8*)(xtg + (size_t)(p0 + jh * 4 + j) * 128 + l0) = pack8(f);
                  const float f2[8] = {f[0] * scl[0], f[1] * scl[1], f[2] * scl[2], f[3] * scl[3], f[4] * scl[4], f[5] * scl[5], f[6] * scl[6], f[7] * scl[7]};
                  *(LAS bf16x8*)(XT + (p0 + jh * 4 + j) * 136 + l0) = pack8(f2); } }
      } }
    __syncthreads();
    { f32x4 acc[4][8];
#pragma unroll
      for (int mt = 0; mt < 4; ++mt)
#pragma unroll
          for (int nt = 0; nt < 8; ++nt) acc[mt][nt] = (f32x4){0.f, 0.f, 0.f, 0.f};
#pragma unroll 1
      for (int kk = 0; kk < 4; ++kk) { bf16x8 xf[4];
#pragma unroll
          for (int mt = 0; mt < 4; ++mt) xf[mt] = *(const LAS bf16x8*)(XT + (mt * 16 + fr) * 136 + kk * 32 + fq * 8);
#pragma unroll
          for (int nt = 0; nt < 8; ++nt) { const bf16x8 bf = *(const bf16x8*)(BCT + (size_t)(nt * 16 + fr) * 128 + kk * 32 + fq * 8);
#pragma unroll
              for (int mt = 0; mt < 4; ++mt) acc[mt][nt] = MFMA16(bf, xf[mt], acc[mt][nt]); } }
      u16* sp = ST + ((size_t)((b * 64 + c) * 32 + h) * 64) * 128;
#pragma unroll
      for (int mt = 0; mt < 4; ++mt)
#pragma unroll
          for (int nt = 0; nt < 8; ++nt) { u32x2 wv; wv.x = cvt_pk_bf16(acc[mt][nt][0], acc[mt][nt][1]); wv.y = cvt_pk_bf16(acc[mt][nt][2], acc[mt][nt][3]);
              *(u32x2*)(sp + (mt * 16 + fr) * 128 + nt * 16 + fq * 4) = wv; }
    }
    __syncthreads();
}

#define SC_LBAR() do { asm volatile("s_waitcnt lgkmcnt(0)" ::: "memory"); __builtin_amdgcn_s_barrier(); asm volatile("" ::: "memory"); } while (0)
constexpr int SC_CBW = 8448, SC_ZY = 2304, SC_ZY_OFF = 8 * SC_CBW, SC_CS_OFF = SC_ZY_OFF + 8 * SC_ZY, SC_DT_OFF = SC_CS_OFF + 4096, SC_PV_OFF = SC_DT_OFF + 4096, SC_XT_OFF = SC_PV_OFF + 17408, SC_BYTES = SC_XT_OFF + 17408;
static_assert(SC_BYTES <= LDS_PHASE_BYTES, "ssd_c LDS");
__device__ __forceinline__ void ssd_c_item(const Params& p, LAS unsigned char* lds, int item) {
    unsigned char* ws = p.ws;
    const float* DT = (const float*)(ws + WS_DT); const float* CS = (const float*)(ws + WS_CS);
    const u16* Bc = (const u16*)(ws + WS_BC); const u16* Cc = (const u16*)(ws + WS_CC); const u16* XTG = (const u16*)(ws + WS_H); const u16* ST = (const u16*)(ws + WS_ST);
    const u16* Z = (const u16*)(ws + WS_Z); u16* YA = (u16*)(ws + WS_YA);
    const int tid = threadIdx.x, lane = tid & 63, w = __builtin_amdgcn_readfirstlane(tid >> 6), fr = lane & 15, fq = lane >> 4;
    const int b = item >> 8, c = (item >> 2) & 63, g = item & 3, t0 = b * SEQ + c * 128;
    const int mb = (w < 4) ? w : 11 - w;
    LAS float* CBW = (LAS float*)(lds + w * SC_CBW);
    LAS u16* ZY = (LAS u16*)(lds + SC_ZY_OFF + w * SC_ZY);
    LAS float* CSL = (LAS float*)(lds + SC_CS_OFF);
    LAS float* DTL = (LAS float*)(lds + SC_DT_OFF);
    LAS u16* PV = (LAS u16*)(lds + SC_PV_OFF);
    LAS u16* XS = (LAS u16*)(lds + SC_XT_OFF);
#pragma unroll
    for (int i = 0; i < 2; ++i) { const int idx = tid + 512 * i, hd = idx >> 7, l = idx & 127;
        CSL[idx] = CS[((size_t)(b * 64 + c) * 32 + g * 8 + hd) * 128 + l]; DTL[idx] = DT[(size_t)(t0 + l) * 32 + g * 8 + hd]; }
    const int la = 16 * mb + fr;
    bf16x8 afc[4];
#pragma unroll
    for (int kk = 0; kk < 4; ++kk) afc[kk] = *(const bf16x8*)(Cc + (size_t)(t0 + la) * 512 + g * 128 + kk * 32 + fq * 8);
    { LAS u16* BCL = (LAS u16*)(lds + SC_PV_OFF);
#pragma unroll
      for (int i = 0; i < 4; ++i) { const int q = tid + 512 * i, row = q >> 4, cc = q & 15;
          *(LAS u32x4*)(BCL + row * 136 + cc * 8) = *(const u32x4*)(Bc + (size_t)(t0 + row) * 512 + g * 128 + cc * 8); }
      __syncthreads();
#pragma unroll
      for (int st = 0; st < 8; ++st) { f32x4 acc = (f32x4){0.f, 0.f, 0.f, 0.f};
#pragma unroll
          for (int kk = 0; kk < 4; ++kk) { const bf16x8 bf = *(const LAS bf16x8*)(BCL + (st * 16 + fr) * 136 + kk * 32 + fq * 8); acc = MFMA16(afc[kk], bf, acc); }
#pragma unroll
          for (int j = 0; j < 4; ++j) CBW[(fq * 4 + j) * 132 + st * 16 + fr] = acc[j]; } }
    float ssq[4] = {0.f, 0.f, 0.f, 0.f};
    u32x4 rpv[2], rxs[2], rz[2];
    { const size_t hb = ((size_t)((b * 64 + c) * 32 + g * 8) * 64) * 128;
#pragma unroll
      for (int i = 0; i < 2; ++i) { const int q = tid + 512 * i, row = q >> 4, cc = q & 15; rpv[i] = *(const u32x4*)(ST + hb + row * 128 + cc * 8); rxs[i] = *(const u32x4*)(XTG + hb + row * 128 + cc * 8); }
#pragma unroll
      for (int i = 0; i < 2; ++i) { const int q = lane + 64 * i, row = q >> 3, cc = q & 7; rz[i] = *(const u32x4*)(Z + (size_t)(t0 + 16 * mb + row) * DM + g * 512 + cc * 8); } }
#pragma unroll 1
    for (int r = 0; r < 8; ++r) {
        const int h = g * 8 + r;
        const u16* xtg = XTG + ((size_t)((b * 64 + c) * 32 + h) * 64) * 128;
        const u16* pvg = ST + ((size_t)((b * 64 + c) * 32 + h) * 64) * 128;
        SC_LBAR();
#pragma unroll
        for (int i = 0; i < 2; ++i) { const int q = tid + 512 * i, row = q >> 4, cc = q & 15;
            *(LAS u32x4*)(PV + row * 136 + cc * 8) = rpv[i]; *(LAS u32x4*)(XS + row * 136 + cc * 8) = rxs[i]; }
#pragma unroll
        for (int i = 0; i < 2; ++i) { const int q = lane + 64 * i, row = q >> 3, cc = q & 7;
            *(LAS u32x4*)(ZY + row * 72 + cc * 8) = rz[i]; }
        SC_LBAR();
        if (r < 7) {
#pragma unroll
            for (int i = 0; i < 2; ++i) { const int q = tid + 512 * i, row = q >> 4, cc = q & 15;
                rpv[i] = *(const u32x4*)(pvg + 8192 + row * 128 + cc * 8); rxs[i] = *(const u32x4*)(xtg + 8192 + row * 128 + cc * 8); }
#pragma unroll
            for (int i = 0; i < 2; ++i) { const int q = lane + 64 * i, row = q >> 3, cc = q & 7;
                rz[i] = *(const u32x4*)(Z + (size_t)(t0 + 16 * mb + row) * DM + (h + 1) * 64 + cc * 8); }
        }
        const float csl = CSL[r * 128 + la], Dh = p.in[I_DSSD][h];
        f32x4 accd[4], acco[4];
#pragma unroll
        for (int pt = 0; pt < 4; ++pt) { accd[pt] = (f32x4){0.f, 0.f, 0.f, 0.f}; acco[pt] = (f32x4){0.f, 0.f, 0.f, 0.f}; }
#pragma unroll
        for (int kk = 0; kk < 4; ++kk) {
#pragma unroll
            for (int pt = 0; pt < 4; ++pt) { const bf16x8 pf = *(const LAS bf16x8*)(PV + (pt * 16 + fr) * 136 + kk * 32 + fq * 8); acco[pt] = MFMA16(afc[kk], pf, acco[pt]); }
            if (kk * 32 <= 16 * mb + 15) {
                const int s0 = kk * 32 + fq * 8; float mv[8];
#pragma unroll
                for (int i = 0; i < 8; ++i) { const int s = s0 + i; const float e = CBW[fr * 132 + s] * __expf(csl - CSL[r * 128 + s]) * DTL[r * 128 + s]; mv[i] = (s <= la) ? e : 0.f; }
                const bf16x8 afm = pack8(mv);
#pragma unroll
                for (int pt = 0; pt < 4; ++pt) { const bf16x8 xf = *(const LAS bf16x8*)(XS + (pt * 16 + fr) * 136 + kk * 32 + fq * 8); accd[pt] = MFMA16(afm, xf, accd[pt]); }
            }
        }
        float el[4];
#pragma unroll
        for (int j = 0; j < 4; ++j) el[j] = __expf(CSL[r * 128 + 16 * mb + fq * 4 + j]);
#pragma unroll
        for (int pt = 0; pt < 4; ++pt) {
            const u32x2 xr = *(const LAS u32x2*)(XS + (pt * 16 + fr) * 136 + 16 * mb + fq * 4);
            const float xv[4] = {bflo(xr.x), bfhi(xr.x), bflo(xr.y), bfhi(xr.y)};
#pragma unroll
            for (int j = 0; j < 4; ++j) { const float y = accd[pt][j] + el[j] * acco[pt][j] + Dh * xv[j];
                LAS u16* zp = ZY + (fq * 4 + j) * 72 + pt * 16 + fr;
                const float v = y * siluf_(bf2f(*zp)); ssq[j] += v * v; *zp = f2bf(v); }
        }
#pragma unroll
        for (int i = 0; i < 2; ++i) { const int q = lane + 64 * i, row = q >> 3, cc = q & 7;
            *(u32x4*)(YA + (size_t)(t0 + 16 * mb + row) * DM + h * 64 + cc * 8) = *(const LAS u32x4*)(ZY + row * 72 + cc * 8); }
    }
#pragma unroll
    for (int j = 0; j < 4; ++j) { float s = ssq[j]; s += __shfl_xor(s, 1); s += __shfl_xor(s, 2); s += __shfl_xor(s, 4); s += __shfl_xor(s, 8);
        if (fr == 0) CBW[fq * 4 + j] = rsqrtf(s * (1.f / 512.f) + 1e-6f); }
    const float* nw = p.in[I_SNW];
    asm volatile("s_waitcnt vmcnt(0)" ::: "memory");
    { u16* ybase = YA + (size_t)(t0 + 16 * mb) * DM + g * 512 + lane * 8;
      const f32x4 n0 = *(const f32x4*)(nw + g * 512 + lane * 8), n1 = *(const f32x4*)(nw + g * 512 + lane * 8 + 4);
#pragma unroll
      for (int hb = 0; hb < 2; ++hb) { u32x4 v[8];
#pragma unroll
          for (int i = 0; i < 8; ++i) v[i] = *(const u32x4*)(ybase + (size_t)(hb * 8 + i) * DM);
#pragma unroll
          for (int i = 0; i < 8; ++i) { const float rsv = CBW[hb * 8 + i];
              const float f[8] = {bflo(v[i].x) * rsv * n0.x, bfhi(v[i].x) * rsv * n0.y, bflo(v[i].y) * rsv * n0.z, bfhi(v[i].y) * rsv * n0.w, bflo(v[i].z) * rsv * n1.x, bfhi(v[i].z) * rsv * n1.y, bflo(v[i].w) * rsv * n1.z, bfhi(v[i].w) * rsv * n1.w};
              *(bf16x8*)(ybase + (size_t)(hb * 8 + i) * DM) = pack8(f); } } }
    __syncthreads();
}

template <bool OUT>
__device__ __forceinline__ void s5_item(const Params& p, LAS unsigned char* lds, int item) {
    unsigned char* ws = p.ws;
    const u16* U = (const u16*)(ws + WS_U); const u16* BBAR = (const u16*)(ws + WS_BBAR); const u16* CM = (const u16*)(ws + WS_CM);
    const f32x2* AV = (const f32x2*)(ws + WS_AV); f32x2* SEND = (f32x2*)(ws + WS_SEND); const f32x2* SINIT = (const f32x2*)(ws + WS_SINIT); u16* YB = (u16*)(ws + WS_YB);
    const int tid = threadIdx.x, lane = tid & 63, w = __builtin_amdgcn_readfirstlane(tid >> 6), fr = lane & 15, fq = lane >> 4;
    const int b = item >> 11, tc = (item >> 6) & 31, g = item & 63;
    LAS float* L = (LAS float*)(lds + w * 16896);
    LAS u16* OT = (LAS u16*)(lds + 8 * 16896 + w * 1024);
    const f32x2 a = AV[g * 64 + lane]; const float ar = a.x, ai = a.y;
    float sre = 0.f, sim = 0.f;
    if (OUT) { const f32x2 s0 = SINIT[((size_t)(b * 32 + tc) * 64 + g) * 64 + lane]; sre = s0.x; sim = s0.y; }
    const bf16x8 zero8 = (bf16x8){0, 0, 0, 0, 0, 0, 0, 0};
    bf16x8 bfr[8];
#pragma unroll
    for (int nt = 0; nt < 8; ++nt) { bfr[nt] = zero8; if (fq < 2) bfr[nt] = *(const bf16x8*)(BBAR + ((size_t)(g * 128 + nt * 16 + fr)) * 16 + fq * 8); }
    bf16x8 cfr[4], dfr = zero8;
    if (OUT) {
#pragma unroll
        for (int kk = 0; kk < 4; ++kk) cfr[kk] = *(const bf16x8*)(CM + ((size_t)(g * 16 + fr)) * 128 + kk * 32 + fq * 8);
        const unsigned dv = (unsigned)f2bf(p.in[I_S5D][g * 16 + fr]); const int kpos = fr - fq * 8; u32x4 dw = (u32x4){0u, 0u, 0u, 0u};
        if (kpos >= 0 && kpos < 8) { const unsigned word = (kpos & 1) ? (dv << 16) : dv; if ((kpos >> 1) == 0) dw.x = word; else if ((kpos >> 1) == 1) dw.y = word; else if ((kpos >> 1) == 2) dw.z = word; else dw.w = word; }
        dfr = __builtin_bit_cast(bf16x8, dw);
    }
    const size_t ubase = (size_t)(b * SEQ + tc * 256) * 1024 + g * 16 + (fq & 1) * 8;
    bf16x8 afn[2];
#pragma unroll
    for (int mt = 0; mt < 2; ++mt) { afn[mt] = zero8; if (fq < 2) afn[mt] = *(const bf16x8*)(U + ubase + (size_t)(mt * 16 + fr) * 1024); }
#pragma unroll 1
    for (int sb = 0; sb < 8; ++sb) {
        const int tok0 = b * SEQ + tc * 256 + sb * 32;
        bf16x8 af[2] = {afn[0], afn[1]};
        if (sb < 7) {
#pragma unroll
            for (int mt = 0; mt < 2; ++mt) if (fq < 2) afn[mt] = *(const bf16x8*)(U + ubase + (size_t)((sb + 1) * 32 + mt * 16 + fr) * 1024);
        }
#pragma unroll
        for (int mt = 0; mt < 2; ++mt) {
#pragma unroll
            for (int nt = 0; nt < 8; ++nt) { const f32x4 r = MFMA16(af[mt], bfr[nt], ((f32x4){0.f, 0.f, 0.f, 0.f}));
#pragma unroll
                for (int j = 0; j < 4; ++j) L[(mt * 16 + fq * 4 + j) * 132 + nt * 16 + fr] = r[j]; } }
#pragma unroll 8
        for (int t = 0; t < 32; ++t) { const float bre = L[t * 132 + lane], bim = L[t * 132 + 64 + lane];
            const float nre = ar * sre - ai * sim + bre, nim = ar * sim + ai * sre + bim; sre = nre; sim = nim;
            if (OUT) { L[t * 132 + lane] = sre; L[t * 132 + 64 + lane] = sim; } }
        if (OUT) {
#pragma unroll
            for (int mt = 0; mt < 2; ++mt) { f32x4 acc = MFMA16(af[mt], dfr, ((f32x4){0.f, 0.f, 0.f, 0.f}));
#pragma unroll
                for (int kk = 0; kk < 4; ++kk) { float f[8];
#pragma unroll
                    for (int i = 0; i < 8; ++i) f[i] = L[(mt * 16 + fr) * 132 + kk * 32 + fq * 8 + i];
                    acc = MFMA16(pack8(f), cfr[kk], acc); }
#pragma unroll
                for (int j = 0; j < 4; ++j) OT[(mt * 16 + fq * 4 + j) * 16 + fr] = f2bf(gelu_tanh(acc[j])); }
            *(u32x4*)(YB + (size_t)(tok0 + (lane >> 1)) * 1024 + g * 16 + (lane & 1) * 8) = *(const LAS u32x4*)(OT + lane * 8);
        }
    }
    if (!OUT) SEND[((size_t)(b * 32 + tc) * 64 + g) * 64 + lane] = (f32x2){sre, sim};
}

#define XB_TMO      128
#define XB_XCNT(j)  (256  + 64 * (j))
#define XB_XSUB(j)  (1280 + 64 * (j))
#define XB_XGEN(j)  (2304 + 64 * (j))
#define XB_TOP      3328
#define XB_TOPGEN   3392
#define XCD_BAR_WORDS 3456
#define XB_SPIN_CAP (1u << 23)
__device__ __forceinline__ unsigned xb_ld(unsigned* p)              { return __hip_atomic_load(p, __ATOMIC_RELAXED, __HIP_MEMORY_SCOPE_AGENT); }
__device__ __forceinline__ unsigned xb_add(unsigned* p, unsigned v) { return __hip_atomic_fetch_add(p, v, __ATOMIC_RELAXED, __HIP_MEMORY_SCOPE_AGENT); }
__device__ __forceinline__ unsigned xb_xcc_id() { return (unsigned)__builtin_amdgcn_s_getreg((3 << 11) | 20) & 0xFu; }
#define XB_SPIN(cond, bar) do { unsigned _sp = 0; while (cond) { __builtin_amdgcn_s_sleep(1); \
    if ((++_sp & 255u) == 0u) { if (xb_ld(&(bar)[XB_TMO])) break; if (_sp > XB_SPIN_CAP) { atomicAdd(&(bar)[XB_TMO], 1u); break; } } } } while (0)
struct XcdBarrier { unsigned* bar; unsigned x; volatile LAS unsigned* st; };
__device__ __forceinline__ XcdBarrier xcd_barrier_post(unsigned* bar, volatile LAS unsigned* st) {
    XcdBarrier b; b.bar = bar; b.x = xb_xcc_id(); b.st = st;
    if (threadIdx.x == 0) (void)xb_add(&bar[XB_XCNT(b.x)], 1u);
    return b;
}
__device__ __forceinline__ void xcd_barrier_complete(unsigned* bar, unsigned x, unsigned& nloc, unsigned& nx) {
    const unsigned G = gridDim.x * gridDim.y * gridDim.z;
    unsigned sum, cnt, mine, sp = 0u;
    for (;;) {
        sum = 0u; cnt = 0u; mine = 0u;
#pragma unroll
        for (unsigned j = 0; j < 16; ++j) { const unsigned c = xb_ld(&bar[XB_XCNT(j)]); sum += c; cnt += (c > 0u) ? 1u : 0u; mine = (j == x) ? c : mine; }
        if (sum == G) break;
        __builtin_amdgcn_s_sleep(1);
        if ((++sp & 255u) == 0u) { if (xb_ld(&bar[XB_TMO])) break; if (sp > XB_SPIN_CAP) { atomicAdd(&bar[XB_TMO], 1u); break; } }
    }
    nloc = mine > 0u ? mine : 1u; nx = cnt > 0u ? cnt : 1u;
}
__device__ __forceinline__ void xcd_barrier(const XcdBarrier& b) {
    asm volatile("s_waitcnt vmcnt(0)" ::: "memory");
    __syncthreads();
    if (threadIdx.x == 0) {
        unsigned* bar = b.bar;
        __builtin_amdgcn_s_waitcnt(0);
        unsigned nloc = b.st[0], nx = b.st[1];
        if (nloc == 0u) { xcd_barrier_complete(bar, b.x, nloc, nx); b.st[0] = nloc; b.st[1] = nx; }
        const unsigned old = xb_add(&bar[XB_XSUB(b.x)], 1u);
        const unsigned gen = old / nloc;
        if (old + 1u == (gen + 1u) * nloc) {
            __builtin_amdgcn_fence(__ATOMIC_RELEASE, "agent");
            asm volatile("s_waitcnt vmcnt(0)" ::: "memory");
            const unsigned og = xb_add(&bar[XB_TOP], 1u);
            const unsigned tg = og / nx;
            if (og + 1u == (tg + 1u) * nx) xb_add(&bar[XB_TOPGEN], 1u);
            else XB_SPIN(xb_ld(&bar[XB_TOPGEN]) == tg, bar);
            __builtin_amdgcn_fence(__ATOMIC_ACQUIRE, "agent");
            xb_add(&bar[XB_XGEN(b.x)], 1u);
            asm volatile("s_waitcnt vmcnt(0)" ::: "memory");
        } else {
            XB_SPIN(xb_ld(&bar[XB_XGEN(b.x)]) == gen, bar);
            __builtin_amdgcn_fence(__ATOMIC_ACQUIRE, "agent");
            asm volatile("s_waitcnt vmcnt(0)" ::: "memory");
        }
    }
    __syncthreads();
}

__global__ void __launch_bounds__(512, 2) mega(Params p) {
    extern __shared__ __attribute__((aligned(16))) unsigned char shm[];
    LAS unsigned char* lds = (LAS unsigned char*)shm;
    cg::grid_group grid = cg::this_grid();
    unsigned char* ws = p.ws;
    const int tid = threadIdx.x, G = gridDim.x, gtid = blockIdx.x * 512 + tid, nthr = G * 512;
    const int lo = p.ph_lo, hi = p.ph_hi;
    float* mods = (float*)(ws + WS_MODS);
    u16* H = (u16*)(ws + WS_H); u16* HID = (u16*)(ws + WS_HID);
#define IN(k) (lo <= (k) && (k) < hi)
    volatile LAS unsigned* xbst = (volatile LAS unsigned*)(lds + LDS_PHASE_BYTES);
    if (tid < 4) xbst[tid] = 0u;
    __syncthreads();
    XcdBarrier xbar = xcd_barrier_post((unsigned*)(ws + WS_BAR), xbst);
#define SYNC(k) do { if (IN(k) && IN((k) + 1)) xcd_barrier(xbar); } while (0)
#ifndef REP_MASK
#define REP_MASK 0
#endif
#define REP(k) for (int _rep = 0; _rep < (((REP_MASK >> (k)) & 1) ? 2 : 1); ++_rep)

    if (IN(0)) REP(0) {
        LAS float* scl = (LAS float*)lds;
        for (int i = tid; i < 4096; i += 512) scl[i] = siluf_(p.in[I_C][i]);
        __syncthreads();
        float* part = (float*)(ws + WS_PART); const float* wada = p.in[I_WADA];
        for (int it = gtid; it < 32 * 4608; it += nthr) { const int kc = it / 4608, cgp = it % 4608;
            f32x4 a0 = (f32x4){0.f, 0.f, 0.f, 0.f}, a1 = a0; const float* wp = wada + (size_t)(kc * 64) * NMOD + cgp * 4;
#pragma unroll 8
            for (int k = 0; k < 64; ++k) { const f32x4 wv = *(const f32x4*)(wp + (size_t)k * NMOD); a0 += wv * scl[kc * 64 + k]; a1 += wv * scl[2048 + kc * 64 + k]; }
            *(f32x4*)(part + (size_t)(kc * 2 + 0) * NMOD + cgp * 4) = a0; *(f32x4*)(part + (size_t)(kc * 2 + 1) * NMOD + cgp * 4) = a1; }
        u16* BBAR = (u16*)(ws + WS_BBAR); f32x2* AV = (f32x2*)(ws + WS_AV); f32x2* AL = (f32x2*)(ws + WS_AL);
        for (int i = gtid; i < 4096; i += nthr) { const int g = i >> 6;
            const float dt = expf(p.in[I_LOGDT][g]); const float lr = fminf(p.in[I_LRE][i], -1e-4f), li = p.in[I_LIM][i];
            const float mag = expf(lr * dt); const float ar = mag * cosf(li * dt), ai = mag * sinf(li * dt);
            const float den = lr * lr + li * li, nr = ar - 1.f; const float kr = (nr * lr + ai * li) / den, ki = (ai * lr - nr * li) / den;
            const int pp = i & 63;
#pragma unroll
            for (int ii = 0; ii < 16; ++ii) { const float br = p.in[I_BRE][(size_t)i * 16 + ii], bi = p.in[I_BIM][(size_t)i * 16 + ii];
                BBAR[((size_t)(g * 128 + pp)) * 16 + ii] = f2bf(kr * br - ki * bi); BBAR[((size_t)(g * 128 + 64 + pp)) * 16 + ii] = f2bf(kr * bi + ki * br); }
            AV[i] = (f32x2){ar, ai}; float xr = ar, xi = ai;
#pragma unroll
            for (int s = 0; s < 8; ++s) { const float t = xr * xr - xi * xi; xi = 2.f * xr * xi; xr = t; }
            AL[i] = (f32x2){xr, xi}; }
        u16* CM = (u16*)(ws + WS_CM);
        for (int i = gtid; i < 131072; i += nthr) { const int gi = i >> 7, q = i & 127; CM[i] = f2bf(q < 64 ? p.in[I_CRE][(size_t)gi * 64 + q] : -p.in[I_CIM][(size_t)gi * 64 + q - 64]); }
    }
    SYNC(0);
    if (IN(1)) REP(1) {
        const float* part = (const float*)(ws + WS_PART);
        for (int i = gtid; i < 2 * NMOD; i += nthr) { const int b = i / NMOD, j = i % NMOD; float s = p.in[I_BADA][j];
#pragma unroll 8
            for (int kc = 0; kc < 32; ++kc) s += part[(size_t)(kc * 2 + b) * NMOD + j];
            mods[i] = s; }
        int tb = 0; LAS float* T = (LAS float*)lds;
        conv_weight(T, p.in[I_W1IN], (u16*)(ws + WS_W1IN), 2048, 2 * FF, 2 * FF, 0, tb, true);
        conv_weight(T, p.in[I_W1OUT], (u16*)(ws + WS_W1OUT), FF, 2048, 2048, 1, tb);
        conv_weight(T, p.in[I_WIN], (u16*)(ws + WS_WIN), 2048, 10272, NPROJ_C, 2, tb);
        conv_weight(T, p.in[I_WA], (u16*)(ws + WS_WA), 2048, 2048, 2048, 1, tb);
        conv_weight(T, p.in[I_WB], (u16*)(ws + WS_WB), 1024, 4096, 4096, 3, tb);
        conv_weight(T, p.in[I_WO], (u16*)(ws + WS_WO), 2048, 2048, 2048, 1, tb);
    }
    SYNC(1);
    if (IN(2)) REP(2) norm_rows<0, true>(p.in[I_X], p.in[I_NF1], mods + 0 * DM, mods + 1 * DM, H, nullptr);
    SYNC(2);
    if (IN(3)) REP(3) { pg8::Gemm g{H, (const u16*)(ws + WS_W1IN), M_TOK, 2 * FF, 2048}; pg8::StaticOrder S; S.init(M_TOK, 2 * FF, G, blockIdx.x); EpiSwiglu E{HID}; pg8::gemm_phase<EpiSwiglu, true, true>(lds, g, S, E); }
    SYNC(3);
    if (IN(4)) REP(4) { pg8::Gemm g{HID, (const u16*)(ws + WS_W1OUT), M_TOK, 2048, FF}; pg8::StaticOrder S; S.init(M_TOK, 2048, G, blockIdx.x, true); EpiResid E{p.in[I_X], p.out, mods + 2 * DM, 0.5f}; pg8::gemm_phase(lds, g, S, E); }
    SYNC(4);
    if (IN(5)) REP(5) {
        norm_dt_rows(p.out, p.in[I_NMIX], mods + 3 * DM, mods + 4 * DM, H, (const u16*)(ws + WS_WIN) + (size_t)NPROJ_G * 2048, p.in[I_DTB], (float*)(ws + WS_DT));
        int tb = 0; LAS float* T = (LAS float*)lds;
        conv_weight(T, p.in[I_W2IN], (u16*)(ws + WS_W1IN), 2048, 2 * FF, 2 * FF, 0, tb, true);
        conv_weight(T, p.in[I_W2OUT], (u16*)(ws + WS_W1OUT), FF, 2048, 2048, 1, tb);
    }
    SYNC(5);
    if (IN(6)) REP(6) { pg8::Gemm g{H, (const u16*)(ws + WS_WIN), M_TOK, NPROJ_G, 2048}; pg8::StaticOrder S; S.init(M_TOK, NPROJ_G, G, blockIdx.x);
        EpiProj E{(u16*)(ws + WS_Z), (u16*)(ws + WS_X), (u16*)(ws + WS_U), (u16*)(ws + WS_G), (float*)(ws + WS_DT), p.in[I_DTB]}; pg8::gemm_phase(lds, g, S, E); }
    SYNC(6);
    if (IN(7)) REP(7) {
        __syncthreads();
        REP(17) for (int it = blockIdx.x; it < 512; it += G) ssd_a_item(p, lds, it);
        REP(18) for (int it = blockIdx.x * 8 + (tid >> 6); it < 4096; it += G * 8) s5_item<false>(p, lds, it);
    }
    SYNC(7);
    if (IN(8)) REP(8) {
        u16* ST = (u16*)(ws + WS_ST); const float* CS = (const float*)(ws + WS_CS);
        for (int idx = gtid; idx < 131072; idx += nthr) { const int n4 = idx & 31, pp = (idx >> 5) & 63, h = (idx >> 11) & 31, b = idx >> 16;
            float run[4] = {0.f, 0.f, 0.f, 0.f};
#pragma unroll 1
            for (int cb = 0; cb < 64; cb += 16) {
                u32x2 sv[16]; float cse[16];
#pragma unroll
                for (int i = 0; i < 16; ++i) { const size_t hc = (size_t)((b * 64 + cb + i) * 32 + h); sv[i] = *(const u32x2*)(ST + (hc * 64 + pp) * 128 + n4 * 4); cse[i] = CS[hc * 128 + 127]; }
                asm volatile("" ::: "memory");
#pragma unroll
                for (int i = 0; i < 16; ++i) { const size_t hc = (size_t)((b * 64 + cb + i) * 32 + h); const float dec = __expf(cse[i]);
                    u32x2 o; o.x = cvt_pk_bf16(run[0], run[1]); o.y = cvt_pk_bf16(run[2], run[3]); *(u32x2*)(ST + (hc * 64 + pp) * 128 + n4 * 4) = o;
                    run[0] = dec * run[0] + bflo(sv[i].x); run[1] = dec * run[1] + bfhi(sv[i].x); run[2] = dec * run[2] + bflo(sv[i].y); run[3] = dec * run[3] + bfhi(sv[i].y); }
                asm volatile("" ::: "memory");
            } }
        const f32x2* AL = (const f32x2*)(ws + WS_AL); const f32x2* SEND = (const f32x2*)(ws + WS_SEND); f32x2* SINIT = (f32x2*)(ws + WS_SINIT);
        for (int idx = gtid; idx < 8192; idx += nthr) { const int gp = idx & 4095, b = idx >> 12; const f32x2 a = AL[gp]; float sr = 0.f, si = 0.f;
            f32x2 ev[32];
#pragma unroll
            for (int tc = 0; tc < 32; ++tc) ev[tc] = SEND[(size_t)(b * 32 + tc) * 4096 + gp];
            asm volatile("" ::: "memory");
#pragma unroll
            for (int tc = 0; tc < 32; ++tc) { SINIT[(size_t)(b * 32 + tc) * 4096 + gp] = (f32x2){sr, si};
                const float nr = a.x * sr - a.y * si + ev[tc].x, ni = a.x * si + a.y * sr + ev[tc].y; sr = nr; si = ni; } }
    }
    SYNC(8);
    if (IN(9)) REP(9) {
        __syncthreads();
        REP(19) for (int it = blockIdx.x; it < 512; it += G) ssd_c_item(p, lds, it);
        REP(20) for (int it = blockIdx.x * 8 + (tid >> 6); it < 4096; it += G * 8) s5_item<true>(p, lds, it);
    }
    SYNC(9);
    if (IN(10)) REP(10) { pg8::Gemm g{(const u16*)(ws + WS_YB), (const u16*)(ws + WS_WB), M_TOK, 4096, 1024}; pg8::StaticOrder S; S.init(M_TOK, 4096, G, blockIdx.x); EpiGlu E{(u16*)(ws + WS_MB), (const u16*)(ws + WS_G)}; pg8::gemm_phase(lds, g, S, E); }
    SYNC(10);
    if (IN(11)) REP(11) { pg8::Gemm g{(const u16*)(ws + WS_YA), (const u16*)(ws + WS_WA), M_TOK, 2048, 2048}; pg8::StaticOrder S; S.init(M_TOK, 2048, G, blockIdx.x); EpiMerge E{H, (const u16*)(ws + WS_G), (const u16*)(ws + WS_MB)}; pg8::gemm_phase(lds, g, S, E); }
    SYNC(11);
    if (IN(12)) REP(12) { pg8::Gemm g{H, (const u16*)(ws + WS_WO), M_TOK, 2048, 2048}; pg8::StaticOrder S; S.init(M_TOK, 2048, G, blockIdx.x); EpiResid E{p.out, p.out, mods + 5 * DM, 1.0f}; pg8::gemm_phase(lds, g, S, E); }
    SYNC(12);
    if (IN(13)) REP(13) norm_rows<0>(p.out, p.in[I_NF2], mods + 6 * DM, mods + 7 * DM, H, nullptr);
    SYNC(13);
    if (IN(14)) REP(14) { pg8::Gemm g{H, (const u16*)(ws + WS_W1IN), M_TOK, 2 * FF, 2048}; pg8::StaticOrder S; S.init(M_TOK, 2 * FF, G, blockIdx.x); EpiSwiglu E{HID}; pg8::gemm_phase<EpiSwiglu, false, true>(lds, g, S, E); }
    SYNC(14);
    if (IN(15)) REP(15) { pg8::Gemm g{HID, (const u16*)(ws + WS_W1OUT), M_TOK, 2048, FF}; pg8::StaticOrder S; S.init(M_TOK, 2048, G, blockIdx.x, true); EpiResid E{p.out, p.out, mods + 8 * DM, 0.5f}; pg8::gemm_phase(lds, g, S, E); }
    SYNC(15);
    if (IN(16)) REP(16) norm_rows<1>(p.out, p.in[I_NFIN], nullptr, nullptr, nullptr, p.out);
    if (hi > NPH) grid.sync();
#undef IN
#undef SYNC
}

#ifndef MK_SPLIT
#define MK_SPLIT 0
#endif
extern "C" void kernel_launch(void* const* d_in, const int* in_sizes, int n_in, void* d_out, int out_size, void* d_ws, size_t ws_size, hipStream_t stream) {
    static int grid = 0;
    if (grid == 0) {
        if (n_in != 30 || ws_size < WS_END) { fprintf(stderr, "kernel_launch: n_in %d ws %zu (need %zu)\n", n_in, ws_size, (size_t)WS_END); grid = -1; return; }
        int dev = 0, cus = 0, per_cu = 0;
        (void)hipGetDevice(&dev); (void)hipDeviceGetAttribute(&cus, hipDeviceAttributeMultiprocessorCount, dev);
        (void)hipFuncSetAttribute((const void*)mega, hipFuncAttributeMaxDynamicSharedMemorySize, LDS_BYTES);
        (void)hipOccupancyMaxActiveBlocksPerMultiprocessor(&per_cu, (const void*)mega, 512, LDS_BYTES);
        if (per_cu < 1) per_cu = 1;
        grid = cus * per_cu; if (grid > 256) grid = 256;
    }
    if (grid < 0) return;
    Params p{};
    for (int i = 0; i < 30; ++i) p.in[i] = (const float*)d_in[i];
    p.out = (float*)d_out; p.ws = (unsigned char*)d_ws;
    (void)hipMemsetAsync((unsigned char*)d_ws + WS_BAR, 0, 16384, stream);
#if MK_SPLIT
    for (int ph = 0; ph < NPH; ++ph) { p.ph_lo = ph; p.ph_hi = ph + 1; void* args[] = {&p};
        (void)hipLaunchCooperativeKernel((void*)mega, dim3(grid), dim3(512), args, LDS_BYTES, stream); }
#else
    p.ph_lo = 0; p.ph_hi = NPH; void* args[] = {&p};
    hipError_t e = hipLaunchCooperativeKernel((void*)mega, dim3(grid), dim3(512), args, LDS_BYTES, stream);
    if (e != hipSuccess) fprintf(stderr, "cooperative launch failed: %s (grid %d)\n", hipGetErrorString(e), grid);
#endif
}
```

```cpp
#include <hip/hip_runtime.h>
#include <hip/hip_cooperative_groups.h>
#include <cstdio>
#define REP_MASK 0
namespace cg = cooperative_groups;

#define LAS __attribute__((address_space(3)))
typedef unsigned short u16;
typedef short bf16x8 __attribute__((ext_vector_type(8)));
typedef float f32x4 __attribute__((ext_vector_type(4)));
typedef float f32x2 __attribute__((ext_vector_type(2)));
typedef unsigned u32x4 __attribute__((ext_vector_type(4)));
typedef unsigned u32x2 __attribute__((ext_vector_type(2)));

constexpr int M_TOK = 16384, DM = 2048, FF = 5504, SEQ = 8192;
constexpr int NPROJ = 10496;
constexpr int NPROJ_G = 10240, NPROJ_C = 10304;
constexpr int NMOD = 18432;
constexpr int LDS_PHASE_BYTES = 147456;
constexpr int LDS_BYTES = LDS_PHASE_BYTES + 16;
constexpr int NPH = 17;

constexpr size_t WS_W1IN = 0;
constexpr size_t WS_W1OUT = WS_W1IN + (size_t)11008 * 2048 * 2;
constexpr size_t WS_WIN = WS_W1OUT + (size_t)2048 * 5504 * 2;
constexpr size_t WS_WA = WS_WIN + (size_t)NPROJ * 2048 * 2;
constexpr size_t WS_WB = WS_WA + (size_t)2048 * 2048 * 2;
constexpr size_t WS_WO = WS_WB + (size_t)4096 * 1024 * 2;
constexpr size_t WS_H = WS_WO + (size_t)2048 * 2048 * 2;
constexpr size_t WS_HID = WS_H + (size_t)M_TOK * 2048 * 2;
constexpr size_t WS_X = WS_HID + (size_t)M_TOK * FF * 2;
constexpr size_t WS_G = WS_X + (size_t)M_TOK * 3072 * 2;
constexpr size_t WS_MISC = WS_G + (size_t)M_TOK * 4096 * 2;
constexpr size_t WS_Z = WS_HID;
constexpr size_t WS_U = WS_Z + (size_t)M_TOK * 2048 * 2;
constexpr size_t WS_DT = WS_U + (size_t)M_TOK * 1024 * 2;
constexpr size_t WS_CS = WS_DT + (size_t)M_TOK * 32 * 4;
constexpr size_t WS_ST = WS_CS + (size_t)M_TOK * 32 * 4;
constexpr size_t WS_MB = WS_ST;
static_assert(WS_ST + (size_t)M_TOK * 2048 * 2 <= WS_X, "mixer buffers overflow HID");
constexpr size_t WS_BC = WS_WIN;
constexpr size_t WS_CC = WS_BC + (size_t)M_TOK * 512 * 2;
constexpr size_t WS_YA = WS_X;
constexpr size_t WS_YB = WS_YA + (size_t)M_TOK * 2048 * 2;
constexpr size_t WS_PART = WS_MISC;
constexpr size_t WS_MODS = WS_PART + (size_t)32 * 2 * NMOD * 4;
constexpr size_t WS_BBAR = WS_MODS + (size_t)2 * NMOD * 4;
constexpr size_t WS_CM = WS_BBAR + (size_t)64 * 128 * 16 * 2;
constexpr size_t WS_AV = WS_CM + (size_t)64 * 16 * 128 * 2;
constexpr size_t WS_AL = WS_AV + (size_t)4096 * 8;
constexpr size_t WS_SEND = WS_AL + (size_t)4096 * 8;
constexpr size_t WS_SINIT = WS_SEND + (size_t)2 * 32 * 4096 * 8;
constexpr size_t WS_BAR = WS_SINIT + (size_t)2 * 32 * 4096 * 8;
constexpr size_t WS_BCT = WS_BAR + 16384;
constexpr size_t WS_END = WS_BCT + (size_t)512 * 16384 * 2;

struct Params {
    const float* in[30];
    float* out; unsigned char* ws; int ph_lo, ph_hi;
};
enum { I_X = 0, I_C, I_WADA, I_BADA, I_NF1, I_W1IN, I_W1OUT, I_NMIX, I_WIN, I_CONVW, I_CONVB, I_DTB, I_ALOG, I_DSSD, I_SNW, I_WA,
       I_LRE, I_LIM, I_BRE, I_BIM, I_CRE, I_CIM, I_S5D, I_LOGDT, I_WB, I_WO, I_NF2, I_W2IN, I_W2OUT, I_NFIN };

__device__ __forceinline__ unsigned cvt_pk_bf16(float lo, float hi) { unsigned r; asm volatile("v_cvt_pk_bf16_f32 %0, %1, %2" : "=v"(r) : "v"(lo), "v"(hi)); return r; }
__device__ __forceinline__ u16 f2bf(float f) { return (u16)(cvt_pk_bf16(f, 0.f) & 0xffffu); }
__device__ __forceinline__ float bf2f(u16 b) { return __uint_as_float(((unsigned)b) << 16); }
__device__ __forceinline__ float bflo(unsigned w) { return __uint_as_float(w << 16); }
__device__ __forceinline__ float bfhi(unsigned w) { return __uint_as_float(w & 0xffff0000u); }
__device__ __forceinline__ float sigmoidf_(float v) { return __builtin_amdgcn_rcpf(1.f + __expf(-v)); }
__device__ __forceinline__ float siluf_(float v) { return v * sigmoidf_(v); }
__device__ __forceinline__ float gelu_tanh(float v) { const float z = 0.7978845608028654f * (v + 0.044715f * v * v * v); const float t = 1.f - 2.f * __builtin_amdgcn_rcpf(__expf(2.f * z) + 1.f); return 0.5f * v * (1.f + t); }
__device__ __forceinline__ bf16x8 pack8(const float* f) { u32x4 w; w.x = cvt_pk_bf16(f[0], f[1]); w.y = cvt_pk_bf16(f[2], f[3]); w.z = cvt_pk_bf16(f[4], f[5]); w.w = cvt_pk_bf16(f[6], f[7]); return __builtin_bit_cast(bf16x8, w); }
#define MFMA16(a, b, c) __builtin_amdgcn_mfma_f32_16x16x32_bf16((a), (b), (c), 0, 0, 0)

namespace pg8 {
constexpr int BM = 256, BK = 64, HALF = 128, HTB = HALF * BK * 2, STAGE_BYTES = 8 * HTB, NXCD = 8, WGM = 8;
__device__ __forceinline__ int lds_byte(int r, int c) { const int st = (r >> 4) * 2 + (c >> 5), rr = r & 15, cc = c & 31, ob = rr * 64 + cc * 2; return st * 1024 + (ob ^ (((ob >> 9) & 1) << 5)); }
__device__ __forceinline__ void stage_rc(int b, int& R, int& C) { const int st = b / 1024, sb = b % 1024, swz = sb ^ (((sb >> 9) & 1) << 5); R = (st >> 1) * 16 + swz / 64; C = (st & 1) * 32 + (swz % 64) / 2; }
__device__ __forceinline__ int perm32(int rho) { const int n = rho >> 4, i = rho & 15; return 8 * (i >> 2) + 4 * n + (i & 3); }
struct Unit { int pm, pn; };
struct Gemm { const u16* A; const u16* Bt; int M, N, K; };
struct StaticOrder {
    int nM, nN, nwg, G, c; bool pnfast;
    __device__ void init(int M, int N, int G_, int c_, bool pf = false) { nM = M / BM; nN = N / BM; nwg = nM * nN; G = G_; c = c_; pnfast = pf; }
    __device__ bool next(int i, Unit& u) const {
        const long L = (long)i * G + c; if (L >= nwg) return false;
        int wgid = (int)L; { const int q = nwg / NXCD, r = nwg % NXCD, xcd = wgid % NXCD, off = wgid / NXCD; wgid = (xcd < r ? xcd * (q + 1) : r * (q + 1) + (xcd - r) * q) + off; }
        const int nig = WGM * nN, gid = wgid / nig, fm = gid * WGM, gsz = (nM - fm) < WGM ? (nM - fm) : WGM;
        if (pnfast) { u.pm = fm + (wgid % nig) / nN; u.pn = (wgid % nig) % nN; } else { u.pm = fm + ((wgid % nig) % gsz); u.pn = (wgid % nig) / gsz; }
        return true;
    }
};

template <class Epi, bool TA = false, bool TB = false>
__device__ __forceinline__ void gemm_phase(LAS unsigned char* lds, const Gemm g, const StaticOrder& S, const Epi& E) {
    const int tid = threadIdx.x, wid = __builtin_amdgcn_readfirstlane(tid >> 6), lane = tid & 63, wr = wid >> 2, wc = wid & 3, fr = lane & 15, fq = lane >> 4;
    const int K = g.K, nt = K / BK;
    unsigned voffA[2], voffB[2];
#pragma unroll
    for (int i = 0; i < 2; ++i) { int R, C; stage_rc(tid * 16 + i * 8192, R, C); const int Rb = Epi::PERM ? ((R & ~31) + perm32(R & 31)) : R;
        voffA[i] = (unsigned)(R * (TA ? BK : K) + C) * 2u; voffB[i] = (unsigned)(Rb * (TB ? BK : K) + C) * 2u; }
    const size_t kstepA = TA ? (size_t)HTB : (size_t)(BK * 2), kstepB = TB ? (size_t)HTB : (size_t)(BK * 2);
    const size_t hstepA = TA ? (size_t)nt * HTB : (size_t)HALF * K * 2, hstepB = TB ? (size_t)nt * HTB : (size_t)HALF * K * 2;
    const size_t tstep = (size_t)BM * K * 2;
    const unsigned ldsw = (unsigned)wid * 1024u;
    const int aoff = lds_byte(wr * 64 + fr, fq * 8), boff = lds_byte(wc * 32 + fr, fq * 8);
#define PG8_SA(b, h) (((b) * 2 + (h)) * HTB)
#define PG8_SB(b, h) ((4 + (b) * 2 + (h)) * HTB)
#define PG8_STAGE(bufoff, gbase, voff) do { _Pragma("unroll") for (int _i = 0; _i < 2; ++_i) \
        __builtin_amdgcn_global_load_lds((const unsigned*)((const char*)(gbase) + (voff)[_i]), (LAS unsigned*)(lds + (bufoff) + ldsw + _i * 8192), 16, 0, 0); } while (0)
#define PG8_LDA(dst, b, h) do { _Pragma("unroll") for (int m = 0; m < 4; ++m) _Pragma("unroll") for (int k = 0; k < 2; ++k) dst[m][k] = *(const LAS bf16x8*)(lds + PG8_SA(b, h) + aoff + m * 2048 + k * 1024); } while (0)
#define PG8_LDB(dst, b, h) do { _Pragma("unroll") for (int n = 0; n < 2; ++n) _Pragma("unroll") for (int k = 0; k < 2; ++k) dst[n][k] = *(const LAS bf16x8*)(lds + PG8_SB(b, h) + boff + n * 2048 + k * 1024); } while (0)
#define PG8_MMA(ai, bj, At, Bt) do { __builtin_amdgcn_s_setprio(1); _Pragma("unroll") for (int m = 0; m < 4; ++m) _Pragma("unroll") for (int n = 0; n < 2; ++n) _Pragma("unroll") for (int k = 0; k < 2; ++k) \
        acc[ai][bj][m][n] = __builtin_amdgcn_mfma_f32_16x16x32_bf16(Bt[n][k], At[m][k], acc[ai][bj][m][n], 0, 0, 0); __builtin_amdgcn_s_setprio(0); } while (0)
#define PG8_WAIT_V(n) asm volatile("s_waitcnt vmcnt(" #n ")" ::: "memory")
#define PG8_WAIT_L(n) asm volatile("s_waitcnt lgkmcnt(" #n ")" ::: "memory")
#define PG8_BAR __builtin_amdgcn_s_barrier()
#define PG8_SCHED __builtin_amdgcn_sched_barrier(0)
    Unit cur, nxt; int ui = 0;
    if (!S.next(0, cur)) return;
    f32x4 acc[2][2][4][2];
#pragma unroll
    for (int a = 0; a < 2; ++a)
#pragma unroll
        for (int b = 0; b < 2; ++b)
#pragma unroll
            for (int m = 0; m < 4; ++m)
#pragma unroll
                for (int n = 0; n < 2; ++n) acc[a][b][m][n] = (f32x4){0.f, 0.f, 0.f, 0.f};
    bf16x8 At[4][2], B0[2][2], B1[2][2];
    const char* cA = (const char*)g.A + (size_t)cur.pm * tstep; const char* cB = (const char*)g.Bt + (size_t)cur.pn * tstep;
    PG8_STAGE(PG8_SB(0, 0), cB, voffB); PG8_STAGE(PG8_SA(0, 0), cA, voffA); PG8_STAGE(PG8_SB(0, 1), cB + hstepB, voffB); PG8_STAGE(PG8_SA(0, 1), cA + hstepA, voffA);
    if (wr == 1) PG8_BAR;
    PG8_WAIT_V(4); PG8_BAR;
    PG8_STAGE(PG8_SB(1, 0), cB + kstepB, voffB); PG8_STAGE(PG8_SA(1, 0), cA + kstepA, voffA); PG8_STAGE(PG8_SB(1, 1), cB + hstepB + kstepB, voffB);
    PG8_WAIT_V(6); PG8_BAR;
    for (;;) {
        const bool has_next = S.next(ui + 1, nxt);
        const char* nA = has_next ? (const char*)g.A + (size_t)nxt.pm * tstep : cA; const char* nB = has_next ? (const char*)g.Bt + (size_t)nxt.pn * tstep : cB;
        for (int t = 0; t < nt; t += 2) {
            const bool last = (t == nt - 2);
            const char* a1 = cA + (size_t)(t + 1) * kstepA;
            const char* a2 = last ? nA : cA + (size_t)(t + 2) * kstepA; const char* b2 = last ? nB : cB + (size_t)(t + 2) * kstepB;
            const char* a3 = a2 + kstepA; const char* b3 = b2 + kstepB;
            PG8_LDB(B0, 0, 0); PG8_SCHED; PG8_LDA(At, 0, 0); PG8_STAGE(PG8_SA(1, 1), a1 + hstepA, voffA);
            PG8_WAIT_L(8); PG8_BAR; PG8_WAIT_L(0); PG8_MMA(0, 0, At, B0); PG8_BAR; PG8_SCHED;
            PG8_LDB(B1, 0, 1); PG8_STAGE(PG8_SB(0, 0), b2, voffB);
            PG8_BAR; PG8_WAIT_L(0); PG8_MMA(0, 1, At, B1); PG8_BAR;
            PG8_LDA(At, 0, 1); PG8_STAGE(PG8_SA(0, 0), a2, voffA);
            PG8_BAR; PG8_WAIT_L(0); PG8_MMA(1, 0, At, B0); PG8_BAR; PG8_SCHED;
            PG8_STAGE(PG8_SB(0, 1), b2 + hstepB, voffB);
            PG8_WAIT_V(6); PG8_BAR; PG8_MMA(1, 1, At, B1); PG8_BAR;
            PG8_LDB(B0, 1, 0); PG8_SCHED; PG8_LDA(At, 1, 0); PG8_STAGE(PG8_SA(0, 1), a2 + hstepA, voffA);
            PG8_WAIT_L(8); PG8_BAR; PG8_WAIT_L(0); PG8_MMA(0, 0, At, B0); PG8_BAR; PG8_SCHED;
            PG8_LDB(B1, 1, 1); PG8_STAGE(PG8_SB(1, 0), b3, voffB);
            PG8_BAR; PG8_WAIT_L(0); PG8_MMA(0, 1, At, B1); PG8_BAR;
            PG8_LDA(At, 1, 1); PG8_STAGE(PG8_SA(1, 0), a3, voffA);
            PG8_BAR; PG8_WAIT_L(0); PG8_MMA(1, 0, At, B0); PG8_BAR; PG8_SCHED;
            PG8_STAGE(PG8_SB(1, 1), b3 + hstepB, voffB);
            PG8_WAIT_V(6); PG8_BAR; PG8_MMA(1, 1, At, B1); PG8_BAR;
        }
        E(acc, cur, wr, wc, fr, fq);
        if (!has_next) break;
#pragma unroll
        for (int a = 0; a < 2; ++a)
#pragma unroll
            for (int b = 0; b < 2; ++b)
#pragma unroll
                for (int m = 0; m < 4; ++m)
#pragma unroll
                    for (int n = 0; n < 2; ++n) acc[a][b][m][n] = (f32x4){0.f, 0.f, 0.f, 0.f};
        cur = nxt; cA = nA; cB = nB; ++ui;
    }
    PG8_WAIT_V(0);
    if (wr == 0) PG8_BAR;
    PG8_BAR;
#undef PG8_SA
#undef PG8_SB
#undef PG8_STAGE
#undef PG8_LDA
#undef PG8_LDB
#undef PG8_MMA
#undef PG8_WAIT_V
#undef PG8_WAIT_L
#undef PG8_BAR
#undef PG8_SCHED
}
}

struct EpiSwiglu {
    static constexpr bool PERM = true;
    u16* O;
    __device__ __forceinline__ void operator()(const f32x4 (&acc)[2][2][4][2], const pg8::Unit& u, int wr, int wc, int fr, int fq) const {
        const int row0 = u.pm * 256 + wr * 64 + fr, col0 = u.pn * 128 + wc * 32 + 8 * fq;
#pragma unroll
        for (int ai = 0; ai < 2; ++ai)
#pragma unroll
            for (int m = 0; m < 4; ++m) {
                float v[8];
#pragma unroll
                for (int n = 0; n < 2; ++n)
#pragma unroll
                    for (int j = 0; j < 4; ++j) v[n * 4 + j] = siluf_(acc[ai][0][m][n][j]) * acc[ai][1][m][n][j];
                *(bf16x8*)(O + (size_t)(row0 + ai * 128 + m * 16) * FF + col0) = pack8(v);
            }
    }
};
struct EpiResid {
    static constexpr bool PERM = false;
    const float* xin; float* xout; const float* gate; float scale;
    __device__ __forceinline__ void operator()(const f32x4 (&acc)[2][2][4][2], const pg8::Unit& u, int wr, int wc, int fr, int fq) const {
        const int row0 = u.pm * 256 + wr * 64 + fr, col0 = u.pn * 256 + wc * 32 + 4 * fq;
        const float* gp = gate + (u.pm >= 32 ? NMOD : 0) + col0;
        f32x4 gv[2][2];
#pragma unroll
        for (int bj = 0; bj < 2; ++bj)
#pragma unroll
            for (int n = 0; n < 2; ++n) gv[bj][n] = *(const f32x4*)(gp + bj * 128 + n * 16) * scale;
#pragma unroll
        for (int ai = 0; ai < 2; ++ai) {
            f32x4 xi[4][2][2];
#pragma unroll
            for (int m = 0; m < 4; ++m)
#pragma unroll
                for (int bj = 0; bj < 2; ++bj)
#pragma unroll
                    for (int n = 0; n < 2; ++n) xi[m][bj][n] = *(const f32x4*)(xin + (size_t)(row0 + ai * 128 + m * 16) * DM + col0 + bj * 128 + n * 16);
#pragma unroll
            for (int m = 0; m < 4; ++m)
#pragma unroll
                for (int bj = 0; bj < 2; ++bj)
#pragma unroll
                    for (int n = 0; n < 2; ++n) *(f32x4*)(xout + (size_t)(row0 + ai * 128 + m * 16) * DM + col0 + bj * 128 + n * 16) = xi[m][bj][n] + gv[bj][n] * acc[ai][bj][m][n];
        }
    }
};
struct EpiProj {
    static constexpr bool PERM = true;
    u16* Z; u16* XBC; u16* U; u16* G; float* DT; const float* dt_bias;
    __device__ __forceinline__ void operator()(const f32x4 (&acc)[2][2][4][2], const pg8::Unit& u, int wr, int wc, int fr, int fq) const {
        const int row0 = u.pm * 256 + wr * 64 + fr, pn = u.pn;
        if (pn == 40) {
            if (wc == 0) {
#pragma unroll
                for (int ai = 0; ai < 2; ++ai)
#pragma unroll
                    for (int m = 0; m < 4; ++m) {
#pragma unroll
                        for (int n = 0; n < 2; ++n) { f32x4 o;
#pragma unroll
                            for (int j = 0; j < 4; ++j) { const float v = acc[ai][0][m][n][j] + dt_bias[8 * fq + 4 * n + j]; o[j] = v > 20.f ? v : log1pf(__expf(v)); }
                            *(f32x4*)(DT + (size_t)(row0 + ai * 128 + m * 16) * 32 + 8 * fq + 4 * n) = o; }
                    }
            }
            return;
        }
        u16* base; int ld, colt; bool sg = false;
        if (pn < 8) { base = Z; ld = 2048; colt = pn * 256; }
        else if (pn < 20) { base = XBC; ld = 3072; colt = (pn - 8) * 256; }
        else if (pn < 24) { base = U; ld = 1024; colt = (pn - 20) * 256; }
        else { base = G; ld = 4096; colt = (pn - 24) * 256; sg = true; }
        const int col0 = colt + wc * 32 + 8 * fq;
#pragma unroll
        for (int ai = 0; ai < 2; ++ai)
#pragma unroll
            for (int m = 0; m < 4; ++m)
#pragma unroll
                for (int bj = 0; bj < 2; ++bj) {
                    float v[8];
#pragma unroll
                    for (int n = 0; n < 2; ++n)
#pragma unroll
                        for (int j = 0; j < 4; ++j) { const float a = acc[ai][bj][m][n][j]; v[n * 4 + j] = sg ? sigmoidf_(a) : a; }
                    *(bf16x8*)(base + (size_t)(row0 + ai * 128 + m * 16) * ld + col0 + bj * 128) = pack8(v);
                }
    }
};
struct EpiGlu {
    static constexpr bool PERM = true;
    u16* O; const u16* G;
    __device__ __forceinline__ void operator()(const f32x4 (&acc)[2][2][4][2], const pg8::Unit& u, int wr, int wc, int fr, int fq) const {
        const int row0 = u.pm * 256 + wr * 64 + fr, col0 = u.pn * 128 + wc * 32 + 8 * fq;
        u32x4 gw[2][4];
#pragma unroll
        for (int ai = 0; ai < 2; ++ai)
#pragma unroll
            for (int m = 0; m < 4; ++m) gw[ai][m] = *(const u32x4*)(G + (size_t)(row0 + ai * 128 + m * 16) * 4096 + 2048 + col0);
#pragma unroll
        for (int ai = 0; ai < 2; ++ai)
#pragma unroll
            for (int m = 0; m < 4; ++m) {
                const size_t row = (size_t)(row0 + ai * 128 + m * 16);
                const u32x4 g4 = gw[ai][m];
                const float gb[8] = {bflo(g4.x), bfhi(g4.x), bflo(g4.y), bfhi(g4.y), bflo(g4.z), bfhi(g4.z), bflo(g4.w), bfhi(g4.w)};
                float v[8];
#pragma unroll
                for (int n = 0; n < 2; ++n)
#pragma unroll
                    for (int j = 0; j < 4; ++j) v[n * 4 + j] = gb[n * 4 + j] * acc[ai][0][m][n][j] * sigmoidf_(acc[ai][1][m][n][j]);
                *(bf16x8*)(O + row * DM + col0) = pack8(v);
            }
    }
};
struct EpiMerge {
    static constexpr bool PERM = true;
    u16* O; const u16* G; const u16* MB;
    __device__ __forceinline__ void operator()(const f32x4 (&acc)[2][2][4][2], const pg8::Unit& u, int wr, int wc, int fr, int fq) const {
        const int row0 = u.pm * 256 + wr * 64 + fr, col0 = u.pn * 256 + wc * 32 + 8 * fq;
#pragma unroll
        for (int ai = 0; ai < 2; ++ai) {
            u32x4 gw[4][2], mw[4][2];
#pragma unroll
            for (int m = 0; m < 4; ++m)
#pragma unroll
                for (int bj = 0; bj < 2; ++bj) { const size_t row = (size_t)(row0 + ai * 128 + m * 16); const int col = col0 + bj * 128;
                    gw[m][bj] = *(const u32x4*)(G + row * 4096 + col); mw[m][bj] = *(const u32x4*)(MB + row * DM + col); }
#pragma unroll
            for (int m = 0; m < 4; ++m)
#pragma unroll
                for (int bj = 0; bj < 2; ++bj) {
                    const size_t row = (size_t)(row0 + ai * 128 + m * 16); const int col = col0 + bj * 128;
                    const u32x4 g4 = gw[m][bj], m4 = mw[m][bj];
                    const float ga[8] = {bflo(g4.x), bfhi(g4.x), bflo(g4.y), bfhi(g4.y), bflo(g4.z), bfhi(g4.z), bflo(g4.w), bfhi(g4.w)};
                    const float mb[8] = {bflo(m4.x), bfhi(m4.x), bflo(m4.y), bfhi(m4.y), bflo(m4.z), bfhi(m4.z), bflo(m4.w), bfhi(m4.w)};
                    float v[8];
#pragma unroll
                    for (int n = 0; n < 2; ++n)
#pragma unroll
                        for (int j = 0; j < 4; ++j) v[n * 4 + j] = ga[n * 4 + j] * acc[ai][bj][m][n][j] + mb[n * 4 + j];
                    *(bf16x8*)(O + row * DM + col) = pack8(v);
                }
        }
    }
};

__device__ __forceinline__ size_t tiled_off(int row, int col, int K) { return ((size_t)(row >> 7) * (K >> 6) + (col >> 6)) * 8192 + (size_t)(row & 127) * 64 + (col & 63); }

__device__ __forceinline__ int map_col(int wsel, int n) {
    if (wsel == 0) return ((n >> 7) & 1) * FF + (n >> 8) * 128 + (n & 127);
    if (wsel == 3) return ((n >> 7) & 1) * 2048 + (n >> 8) * 128 + (n & 127);
    if (wsel == 2) { if (n < 5120) return n; if (n < 6144) return 5152 + (n - 5120); if (n < 10240) return 6176 + (n - 6144); if (n < 10272) return 5120 + (n - 10240); return -1; }
    return n;
}
__device__ __forceinline__ void conv_weight(LAS float* T, const float* __restrict__ src, u16* __restrict__ dst, int K, int ld, int ndst, int wsel, int& tbase, bool tiled = false) {
    const int nnt = ndst / 64, ntiles = (K / 128) * nnt, tid = threadIdx.x, G = gridDim.x;
    const int first = (((int)blockIdx.x - tbase) % G + G) % G;
    for (int t = first; t < ntiles; t += G) {
        const int n0 = (t % nnt) * 64, k0 = (t / nnt) * 128;
        { const int c4 = tid & 15, r = tid >> 4; const int sc = map_col(wsel, n0 + c4 * 4);
#pragma unroll
          for (int ps = 0; ps < 4; ++ps) { const int kr = r + ps * 32;
              f32x4 v = (f32x4){0.f, 0.f, 0.f, 0.f}; if (sc >= 0) v = *(const f32x4*)(src + (size_t)(k0 + kr) * ld + sc);
              LAS float* tp = T + kr * 65 + c4 * 4; tp[0] = v.x; tp[1] = v.y; tp[2] = v.z; tp[3] = v.w; } }
        __syncthreads();
        { const int kg = tid >> 5, nl = tid & 31;
#pragma unroll
          for (int ps = 0; ps < 2; ++ps) { const int n = nl + ps * 32; float f[8];
#pragma unroll
              for (int j = 0; j < 8; ++j) f[j] = T[(kg * 8 + j) * 65 + n];
              *(bf16x8*)(dst + (tiled ? tiled_off(n0 + n, k0 + kg * 8, K) : (size_t)(n0 + n) * K + k0 + kg * 8)) = pack8(f); } }
        __syncthreads();
    }
    tbase += ntiles;
}

template <int MODE, bool TILED = false>
__device__ __forceinline__ void norm_rows(const float* src, const float* __restrict__ gw, const float* __restrict__ sh, const float* __restrict__ sc, u16* dst, float* fdst) {
    const int lane = threadIdx.x & 63, wg = blockIdx.x * 8 + (threadIdx.x >> 6), nw = gridDim.x * 8;
    for (int rp = wg; rp < M_TOK / 2; rp += nw) {
        f32x4 v[2][8]; float ss[2] = {0.f, 0.f};
#pragma unroll
        for (int q = 0; q < 2; ++q)
#pragma unroll
            for (int i = 0; i < 8; ++i) v[q][i] = *(const f32x4*)(src + (size_t)(rp * 2 + q) * DM + i * 256 + lane * 4);
#pragma unroll
        for (int q = 0; q < 2; ++q) {
#pragma unroll
            for (int i = 0; i < 8; ++i) ss[q] += v[q][i].x * v[q][i].x + v[q][i].y * v[q][i].y + v[q][i].z * v[q][i].z + v[q][i].w * v[q][i].w;
#pragma unroll
            for (int off = 32; off >= 1; off >>= 1) ss[q] += __shfl_xor(ss[q], off); }
#pragma unroll
        for (int q = 0; q < 2; ++q) { const int row = rp * 2 + q, bo = (row >> 13) * NMOD; const float rstd = rsqrtf(ss[q] * (1.f / 2048.f) + 1e-6f);
#pragma unroll
            for (int i = 0; i < 8; ++i) { const int col = i * 256 + lane * 4; const f32x4 g4 = *(const f32x4*)(gw + col);
                if (MODE == 0) { const f32x4 s4 = *(const f32x4*)(sc + bo + col), h4 = *(const f32x4*)(sh + bo + col);
                    const f32x4 o = v[q][i] * rstd * g4 * (s4 + 1.f) + h4;
                    u32x2 w; w.x = cvt_pk_bf16(o.x, o.y); w.y = cvt_pk_bf16(o.z, o.w); *(u32x2*)(dst + (TILED ? tiled_off(row, col, DM) : (size_t)row * DM + col)) = w; }
                else { *(f32x4*)(fdst + (size_t)row * DM + col) = v[q][i] * rstd * g4; } } }
    }
}

__device__ __forceinline__ void norm_dt_rows(const float* src, const float* __restrict__ gw, const float* __restrict__ sh, const float* __restrict__ sc, u16* dst,
                                             const u16* __restrict__ wdt  , const float* __restrict__ dt_bias, float* DT) {
    const int lane = threadIdx.x & 63, wg = blockIdx.x * 8 + (threadIdx.x >> 6), nw = gridDim.x * 8, fr = lane & 15, fq = lane >> 4;
    for (int rb = wg; rb < M_TOK / 8; rb += nw) {
        const int row0 = rb * 8, bo = (row0 >> 13) * NMOD;
#pragma unroll 1
        for (int i8 = 0; i8 < 8; i8 += 2) {
            f32x4 v[2][8]; float ss[2] = {0.f, 0.f};
#pragma unroll
            for (int q = 0; q < 2; ++q)
#pragma unroll
                for (int i = 0; i < 8; ++i) v[q][i] = *(const f32x4*)(src + (size_t)(row0 + i8 + q) * DM + i * 256 + lane * 4);
#pragma unroll
            for (int q = 0; q < 2; ++q) {
#pragma unroll
                for (int i = 0; i < 8; ++i) ss[q] += v[q][i].x * v[q][i].x + v[q][i].y * v[q][i].y + v[q][i].z * v[q][i].z + v[q][i].w * v[q][i].w;
#pragma unroll
                for (int off = 32; off >= 1; off >>= 1) ss[q] += __shfl_xor(ss[q], off); }
#pragma unroll
            for (int q = 0; q < 2; ++q) { const int row = row0 + i8 + q; const float rstd = rsqrtf(ss[q] * (1.f / 2048.f) + 1e-6f);
#pragma unroll
                for (int i = 0; i < 8; ++i) { const int col = i * 256 + lane * 4; const f32x4 g4 = *(const f32x4*)(gw + col), s4 = *(const f32x4*)(sc + bo + col), h4 = *(const f32x4*)(sh + bo + col);
                    const f32x4 o = v[q][i] * rstd * g4 * (s4 + 1.f) + h4;
                    u32x2 wv; wv.x = cvt_pk_bf16(o.x, o.y); wv.y = cvt_pk_bf16(o.z, o.w); *(u32x2*)(dst + (size_t)row * DM + col) = wv; } } }
        f32x4 a0 = (f32x4){0.f, 0.f, 0.f, 0.f}, a1 = a0;
        const u16* ap = dst + (size_t)(row0 + (fr & 7)) * DM + fq * 8; const u16* bp = wdt + (size_t)fr * 2048 + fq * 8;
        asm volatile("s_waitcnt vmcnt(0)" ::: "memory");
#pragma unroll 8
        for (int ks = 0; ks < 64; ++ks) { const bf16x8 a = *(const bf16x8*)(ap + ks * 32), b0 = *(const bf16x8*)(bp + ks * 32), b1 = *(const bf16x8*)(bp + 16 * 2048 + ks * 32);
            a0 = MFMA16(a, b0, a0); a1 = MFMA16(a, b1, a1); }
        if (fq < 2) {
#pragma unroll
            for (int j = 0; j < 4; ++j) { const float v0 = a0[j] + dt_bias[fr], v1 = a1[j] + dt_bias[16 + fr]; float* dp = DT + (size_t)(row0 + fq * 4 + j) * 32;
                dp[fr] = v0 > 20.f ? v0 : log1pf(__expf(v0)); dp[16 + fr] = v1 > 20.f ? v1 : log1pf(__expf(v1)); } }
    }
}

__device__ __forceinline__ void conv_tile4(const u32x4 (&raw)[11], const int jh, const float* __restrict__ cw, const float* __restrict__ cbp, float (&o)[8][4]) {
    const f32x4 w0 = *(const f32x4*)(cw + jh * 4), w1 = *(const f32x4*)(cw + 3072 + jh * 4), w2 = *(const f32x4*)(cw + 6144 + jh * 4), w3 = *(const f32x4*)(cw + 9216 + jh * 4), bb = *(const f32x4*)(cbp + jh * 4);
    f32x4 xr[11];
#pragma unroll
    for (int k = 0; k < 11; ++k) { const unsigned a = jh ? raw[k].z : raw[k].x, b2 = jh ? raw[k].w : raw[k].y; xr[k] = (f32x4){bflo(a), bfhi(a), bflo(b2), bfhi(b2)}; }
#pragma unroll
    for (int i = 0; i < 8; ++i) { const f32x4 v = bb + w0 * xr[i] + w1 * xr[i + 1] + w2 * xr[i + 2] + w3 * xr[i + 3];
#pragma unroll
        for (int jj = 0; jj < 4; ++jj) o[i][jj] = siluf_(v[jj]); }
}
constexpr int SA_XT = 17408, SA_CS_OFF = 8 * SA_XT, SA_DT_OFF = SA_CS_OFF + 4096, SA_BYTES = SA_DT_OFF + 4096;
__device__ __forceinline__ void ssd_a_item(const Params& p, LAS unsigned char* lds, int item) {
    unsigned char* ws = p.ws;
    const u16* XBC = (const u16*)(ws + WS_X); const float* DT = (const float*)(ws + WS_DT); float* CS = (float*)(ws + WS_CS);
    u16* Bc = (u16*)(ws + WS_BC); u16* Cc = (u16*)(ws + WS_CC); u16* XTG = (u16*)(ws + WS_H); u16* ST = (u16*)(ws + WS_ST);
    u16* BCT = (u16*)(ws + WS_BCT) + (size_t)item * 16384;
    const float* conv_w = p.in[I_CONVW]; const float* conv_b = p.in[I_CONVB];
    const int tid = threadIdx.x, lane = tid & 63, w = __builtin_amdgcn_readfirstlane(tid >> 6), fr = lane & 15, fq = lane >> 4;
    const int b = item >> 8, c = (item >> 2) & 63, g = item & 3, t0 = b * SEQ + c * 128, h = g * 8 + w;
    LAS u16* XT = (LAS u16*)(lds + w * SA_XT);
    LAS float* CSL = (LAS float*)(lds + SA_CS_OFF) + w * 128;
    LAS float* DTL = (LAS float*)(lds + SA_DT_OFF) + w * 128;
    { const float ah = -__expf(p.in[I_ALOG][h]); float carry = 0.f;
#pragma unroll
      for (int half = 0; half < 2; ++half) { const int l = lane + 64 * half; const float dtv = DT[(size_t)(t0 + l) * 32 + h]; float v = dtv * ah;
#pragma unroll
          for (int off = 1; off < 64; off <<= 1) { const float nb = __shfl_up(v, off); if (lane >= off) v += nb; }
          v += carry; carry = __shfl(v, 63);
          CSL[l] = v; DTL[l] = dtv; CS[((size_t)(b * 64 + c) * 32 + h) * 128 + l] = v; } }
    { const int cgx = tid & 31, l0 = (tid >> 5) * 8; const bool isC = cgx >= 16; const int n0 = (cgx & 15) * 8;
      const int col0 = 2048 + (isC ? 512 : 0) + g * 128 + n0;
      u32x4 raw[11];
#pragma unroll
      for (int k = 0; k < 11; ++k) { const int l = l0 - 3 + k; raw[k] = (u32x4){0u, 0u, 0u, 0u}; if (c * 128 + l >= 0) raw[k] = *(const u32x4*)(XBC + (size_t)((long)t0 + l) * 3072 + col0); }
      u16* op = (isC ? Cc : Bc) + (size_t)(t0 + l0) * 512 + g * 128 + n0;
#pragma unroll
      for (int jh = 0; jh < 2; ++jh) { float o[8][4]; conv_tile4(raw, jh, conv_w + col0, conv_b + col0, o);
#pragma unroll
          for (int i = 0; i < 8; ++i) { u32x2 wv; wv.x = cvt_pk_bf16(o[i][0], o[i][1]); wv.y = cvt_pk_bf16(o[i][2], o[i][3]); *(u32x2*)(op + (size_t)i * 512 + jh * 4) = wv; }
          if (!isC) {
#pragma unroll
              for (int j = 0; j < 4; ++j) { const float f[8] = {o[0][j], o[1][j], o[2][j], o[3][j], o[4][j], o[5][j], o[6][j], o[7][j]}; *(bf16x8*)(BCT + (size_t)(n0 + jh * 4 + j) * 128 + l0) = pack8(f); } } } }
    { const int p0 = (lane & 7) * 8, rg = lane >> 3, col0 = h * 64 + p0;
      u16* xtg = XTG + ((size_t)((b * 64 + c) * 32 + h) * 64) * 128;
      const float cs_end = CSL[127];
#pragma unroll 1
      for (int half = 0; half < 2; ++half) {
          const int l0 = half * 64 + rg * 8;
          u32x4 raw[11];
#pragma unroll
          for (int k = 0; k < 11; ++k) { const int l = l0 - 3 + k; raw[k] = (u32x4){0u, 0u, 0u, 0u}; if (c * 128 + l >= 0) raw[k] = *(const u32x4*)(XBC + (size_t)((long)t0 + l) * 3072 + col0); }
          float scl[8];
#pragma unroll
          for (int i = 0; i < 8; ++i) scl[i] = DTL[l0 + i] * __expf(cs_end - CSL[l0 + i]);
#pragma unroll
          for (int jh = 0; jh < 2; ++jh) { float o[8][4]; conv_tile4(raw, jh, conv_w + col0, conv_b + col0, o);
#pragma unroll
              for (int j = 0; j < 4; ++j) { const float f[8] = {o[0][j], o[1][j], o[2][j], o[3][j], o[4][j], o[5][j], o[6][j], o[7][j]};
                  *(bf16x8*)(xtg + (size_t)(p0 + jh * 4 + j) * 128 + l0) = pack8(f);
                  const float f2[8] = {f[0] * scl[0], f[1] * scl[1], f[2] * scl[2], f[3] * scl[3], f[4] * scl[4], f[5] * scl[5], f[6] * scl[6], f[7] * scl[7]};
                  *(LAS bf16x8*)(XT + (p0 + jh * 4 + j) * 136 + l0) = pack8(f2); } }
      } }
    __syncthreads();
    { f32x4 acc[4][8];
#pragma unroll
      for (int mt = 0; mt < 4; ++mt)
#pragma unroll
          for (int nt = 0; nt < 8; ++nt) acc[mt][nt] = (f32x4){0.f, 0.f, 0.f, 0.f};
#pragma unroll 1
      for (int kk = 0; kk < 4; ++kk) { bf16x8 xf[4];
#pragma unroll
          for (int mt = 0; mt < 4; ++mt) xf[mt] = *(const LAS bf16x8*)(XT + (mt * 16 + fr) * 136 + kk * 32 + fq * 8);
#pragma unroll
          for (int nt = 0; nt < 8; ++nt) { const bf16x8 bf = *(const bf16x8*)(BCT + (size_t)(nt * 16 + fr) * 128 + kk * 32 + fq * 8);
#pragma unroll
              for (int mt = 0; mt < 4; ++mt) acc[mt][nt] = MFMA16(bf, xf[mt], acc[mt][nt]); } }
      u16* sp = ST + ((size_t)((b * 64 + c) * 32 + h) * 64) * 128;
#pragma unroll
      for (int mt = 0; mt < 4; ++mt)
#pragma unroll
          for (int nt = 0; nt < 8; ++nt) { u32x2 wv; wv.x = cvt_pk_bf16(acc[mt][nt][0], acc[mt][nt][1]); wv.y = cvt_pk_bf16(acc[mt][nt][2], acc[mt][nt][3]);
              *(u32x2*)(sp + (mt * 16 + fr) * 128 + nt * 16 + fq * 4) = wv; }
    }
    __syncthreads();
}

#define SC_LBAR() do { asm volatile("s_waitcnt lgkmcnt(0)" ::: "memory"); __builtin_amdgcn_s_barrier(); asm volatile("" ::: "memory"); } while (0)
constexpr int SC_CBW = 8448, SC_ZY = 2304, SC_ZY_OFF = 8 * SC_CBW, SC_CS_OFF = SC_ZY_OFF + 8 * SC_ZY, SC_DT_OFF = SC_CS_OFF + 4096, SC_PV_OFF = SC_DT_OFF + 4096, SC_XT_OFF = SC_PV_OFF + 17408, SC_BYTES = SC_XT_OFF + 17408;
static_assert(SC_BYTES <= LDS_PHASE_BYTES, "ssd_c LDS");
__device__ __forceinline__ void ssd_c_item(const Params& p, LAS unsigned char* lds, int item) {
    unsigned char* ws = p.ws;
    const float* DT = (const float*)(ws + WS_DT); const float* CS = (const float*)(ws + WS_CS);
    const u16* Bc = (const u16*)(ws + WS_BC); const u16* Cc = (const u16*)(ws + WS_CC); const u16* XTG = (const u16*)(ws + WS_H); const u16* ST = (const u16*)(ws + WS_ST);
    const u16* Z = (const u16*)(ws + WS_Z); u16* YA = (u16*)(ws + WS_YA);
    const int tid = threadIdx.x, lane = tid & 63, w = __builtin_amdgcn_readfirstlane(tid >> 6), fr = lane & 15, fq = lane >> 4;
    const int b = item >> 8, c = (item >> 2) & 63, g = item & 3, t0 = b * SEQ + c * 128;
    const int mb = (w < 4) ? w : 11 - w;
    LAS float* CBW = (LAS float*)(lds + w * SC_CBW);
    LAS u16* ZY = (LAS u16*)(lds + SC_ZY_OFF + w * SC_ZY);
    LAS float* CSL = (LAS float*)(lds + SC_CS_OFF);
    LAS float* DTL = (LAS float*)(lds + SC_DT_OFF);
    LAS u16* PV = (LAS u16*)(lds + SC_PV_OFF);
    LAS u16* XS = (LAS u16*)(lds + SC_XT_OFF);
#pragma unroll
    for (int i = 0; i < 2; ++i) { const int idx = tid + 512 * i, hd = idx >> 7, l = idx & 127;
        CSL[idx] = CS[((size_t)(b * 64 + c) * 32 + g * 8 + hd) * 128 + l]; DTL[idx] = DT[(size_t)(t0 + l) * 32 + g * 8 + hd]; }
    const int la = 16 * mb + fr;
    bf16x8 afc[4];
#pragma unroll
    for (int kk = 0; kk < 4; ++kk) afc[kk] = *(const bf16x8*)(Cc + (size_t)(t0 + la) * 512 + g * 128 + kk * 32 + fq * 8);
    { LAS u16* BCL = (LAS u16*)(lds + SC_PV_OFF);
#pragma unroll
      for (int i = 0; i < 4; ++i) { const int q = tid + 512 * i, row = q >> 4, cc = q & 15;
          *(LAS u32x4*)(BCL + row * 136 + cc * 8) = *(const u32x4*)(Bc + (size_t)(t0 + row) * 512 + g * 128 + cc * 8); }
      __syncthreads();
#pragma unroll
      for (int st = 0; st < 8; ++st) { f32x4 acc = (f32x4){0.f, 0.f, 0.f, 0.f};
#pragma unroll
          for (int kk = 0; kk < 4; ++kk) { const bf16x8 bf = *(const LAS bf16x8*)(BCL + (st * 16 + fr) * 136 + kk * 32 + fq * 8); acc = MFMA16(afc[kk], bf, acc); }
#pragma unroll
          for (int j = 0; j < 4; ++j) CBW[(fq * 4 + j) * 132 + st * 16 + fr] = acc[j]; } }
    float ssq[4] = {0.f, 0.f, 0.f, 0.f};
    u32x4 rpv[2], rxs[2], rz[2];
    { const size_t hb = ((size_t)((b * 64 + c) * 32 + g * 8) * 64) * 128;
#pragma unroll
      for (int i = 0; i < 2; ++i) { const int q = tid + 512 * i, row = q >> 4, cc = q & 15; rpv[i] = *(const u32x4*)(ST + hb + row * 128 + cc * 8); rxs[i] = *(const u32x4*)(XTG + hb + row * 128 + cc * 8); }
#pragma unroll
      for (int i = 0; i < 2; ++i) { const int q = lane + 64 * i, row = q >> 3, cc = q & 7; rz[i] = *(const u32x4*)(Z + (size_t)(t0 + 16 * mb + row) * DM + g * 512 + cc * 8); } }
#pragma unroll 1
    for (int r = 0; r < 8; ++r) {
        const int h = g * 8 + r;
        const u16* xtg = XTG + ((size_t)((b * 64 + c) * 32 + h) * 64) * 128;
        const u16* pvg = ST + ((size_t)((b * 64 + c) * 32 + h) * 64) * 128;
        SC_LBAR();
#pragma unroll
        for (int i = 0; i < 2; ++i) { const int q = tid + 512 * i, row = q >> 4, cc = q & 15;
            *(LAS u32x4*)(PV + row * 136 + cc * 8) = rpv[i]; *(LAS u32x4*)(XS + row * 136 + cc * 8) = rxs[i]; }
#pragma unroll
        for (int i = 0; i < 2; ++i) { const int q = lane + 64 * i, row = q >> 3, cc = q & 7;
            *(LAS u32x4*)(ZY + row * 72 + cc * 8) = rz[i]; }
        SC_LBAR();
        if (r < 7) {
#pragma unroll
            for (int i = 0; i < 2; ++i) { const int q = tid + 512 * i, row = q >> 4, cc = q & 15;
                rpv[i] = *(const u32x4*)(pvg + 8192 + row * 128 + cc * 8); rxs[i] = *(const u32x4*)(xtg + 8192 + row * 128 + cc * 8); }
#pragma unroll
            for (int i = 0; i < 2; ++i) { const int q = lane + 64 * i, row = q >> 3, cc = q & 7;
                rz[i] = *(const u32x4*)(Z + (size_t)(t0 + 16 * mb + row) * DM + (h + 1) * 64 + cc * 8); }
        }
        const float csl = CSL[r * 128 + la], Dh = p.in[I_DSSD][h];
        f32x4 accd[4], acco[4];
#pragma unroll
        for (int pt = 0; pt < 4; ++pt) { accd[pt] = (f32x4){0.f, 0.f, 0.f, 0.f}; acco[pt] = (f32x4){0.f, 0.f, 0.f, 0.f}; }
#pragma unroll
        for (int kk = 0; kk < 4; ++kk) {
#pragma unroll
            for (int pt = 0; pt < 4; ++pt) { const bf16x8 pf = *(const LAS bf16x8*)(PV + (pt * 16 + fr) * 136 + kk * 32 + fq * 8); acco[pt] = MFMA16(afc[kk], pf, acco[pt]); }
            if (kk * 32 <= 16 * mb + 15) {
                const int s0 = kk * 32 + fq * 8; float mv[8];
#pragma unroll
                for (int i = 0; i < 8; ++i) { const int s = s0 + i; const float e = CBW[fr * 132 + s] * __expf(csl - CSL[r * 128 + s]) * DTL[r * 128 + s]; mv[i] = (s <= la) ? e : 0.f; }
                const bf16x8 afm = pack8(mv);
#pragma unroll
                for (int pt = 0; pt < 4; ++pt) { const bf16x8 xf = *(const LAS bf16x8*)(XS + (pt * 16 + fr) * 136 + kk * 32 + fq * 8); accd[pt] = MFMA16(afm, xf, accd[pt]); }
            }
        }
        float el[4];
#pragma unroll
        for (int j = 0; j < 4; ++j) el[j] = __expf(CSL[r * 128 + 16 * mb + fq * 4 + j]);
#pragma unroll
        for (int pt = 0; pt < 4; ++pt) {
            const u32x2 xr = *(const LAS u32x2*)(XS + (pt * 16 + fr) * 136 + 16 * mb + fq * 4);
            const float xv[4] = {bflo(xr.x), bfhi(xr.x), bflo(xr.y), bfhi(xr.y)};
#pragma unroll
            for (int j = 0; j < 4; ++j) { const float y = accd[pt][j] + el[j] * acco[pt][j] + Dh * xv[j];
                LAS u16* zp = ZY + (fq * 4 + j) * 72 + pt * 16 + fr;
                const float v = y * siluf_(bf2f(*zp)); ssq[j] += v * v; *zp = f2bf(v); }
        }
#pragma unroll
        for (int i = 0; i < 2; ++i) { const int q = lane + 64 * i, row = q >> 3, cc = q & 7;
            *(u32x4*)(YA + (size_t)(t0 + 16 * mb + row) * DM + h * 64 + cc * 8) = *(const LAS u32x4*)(ZY + row * 72 + cc * 8); }
    }
#pragma unroll
    for (int j = 0; j < 4; ++j) { float s = ssq[j]; s += __shfl_xor(s, 1); s += __shfl_xor(s, 2); s += __shfl_xor(s, 4); s += __shfl_xor(s, 8);
        if (fr == 0) CBW[fq * 4 + j] = rsqrtf(s * (1.f / 512.f) + 1e-6f); }
    const float* nw = p.in[I_SNW];
    asm volatile("s_waitcnt vmcnt(0)" ::: "memory");
    { u16* ybase = YA + (size_t)(t0 + 16 * mb) * DM + g * 512 + lane * 8;
      const f32x4 n0 = *(const f32x4*)(nw + g * 512 + lane * 8), n1 = *(const f32x4*)(nw + g * 512 + lane * 8 + 4);
#pragma unroll
      for (int hb = 0; hb < 2; ++hb) { u32x4 v[8];
#pragma unroll
          for (int i = 0; i < 8; ++i) v[i] = *(const u32x4*)(ybase + (size_t)(hb * 8 + i) * DM);
#pragma unroll
          for (int i = 0; i < 8; ++i) { const float rsv = CBW[hb * 8 + i];
              const float f[8] = {bflo(v[i].x) * rsv * n0.x, bfhi(v[i].x) * rsv * n0.y, bflo(v[i].y) * rsv * n0.z, bfhi(v[i].y) * rsv * n0.w, bflo(v[i].z) * rsv * n1.x, bfhi(v[i].z) * rsv * n1.y, bflo(v[i].w) * rsv * n1.z, bfhi(v[i].w) * rsv * n1.w};
              *(bf16x8*)(ybase + (size_t)(hb * 8 + i) * DM) = pack8(f); } } }
    __syncthreads();
}

template <bool OUT>
__device__ __forceinline__ void s5_item(const Params& p, LAS unsigned char* lds, int item) {
    unsigned char* ws = p.ws;
    const u16* U = (const u16*)(ws + WS_U); const u16* BBAR = (const u16*)(ws + WS_BBAR); const u16* CM = (const u16*)(ws + WS_CM);
    const f32x2* AV = (const f32x2*)(ws + WS_AV); f32x2* SEND = (f32x2*)(ws + WS_SEND); const f32x2* SINIT = (const f32x2*)(ws + WS_SINIT); u16* YB = (u16*)(ws + WS_YB);
    const int tid = threadIdx.x, lane = tid & 63, w = __builtin_amdgcn_readfirstlane(tid >> 6), fr = lane & 15, fq = lane >> 4;
    const int b = item >> 11, tc = (item >> 6) & 31, g = item & 63;
    LAS float* L = (LAS float*)(lds + w * 16896);
    LAS u16* OT = (LAS u16*)(lds + 8 * 16896 + w * 1024);
    const f32x2 a = AV[g * 64 + lane]; const float ar = a.x, ai = a.y;
    float sre = 0.f, sim = 0.f;
    if (OUT) { const f32x2 s0 = SINIT[((size_t)(b * 32 + tc) * 64 + g) * 64 + lane]; sre = s0.x; sim = s0.y; }
    const bf16x8 zero8 = (bf16x8){0, 0, 0, 0, 0, 0, 0, 0};
    bf16x8 bfr[8];
#pragma unroll
    for (int nt = 0; nt < 8; ++nt) { bfr[nt] = zero8; if (fq < 2) bfr[nt] = *(const bf16x8*)(BBAR + ((size_t)(g * 128 + nt * 16 + fr)) * 16 + fq * 8); }
    bf16x8 cfr[4], dfr = zero8;
    if (OUT) {
#pragma unroll
        for (int kk = 0; kk < 4; ++kk) cfr[kk] = *(const bf16x8*)(CM + ((size_t)(g * 16 + fr)) * 128 + kk * 32 + fq * 8);
        const unsigned dv = (unsigned)f2bf(p.in[I_S5D][g * 16 + fr]); const int kpos = fr - fq * 8; u32x4 dw = (u32x4){0u, 0u, 0u, 0u};
        if (kpos >= 0 && kpos < 8) { const unsigned word = (kpos & 1) ? (dv << 16) : dv; if ((kpos >> 1) == 0) dw.x = word; else if ((kpos >> 1) == 1) dw.y = word; else if ((kpos >> 1) == 2) dw.z = word; else dw.w = word; }
        dfr = __builtin_bit_cast(bf16x8, dw);
    }
    const size_t ubase = (size_t)(b * SEQ + tc * 256) * 1024 + g * 16 + (fq & 1) * 8;
    bf16x8 afn[2];
#pragma unroll
    for (int mt = 0; mt < 2; ++mt) { afn[mt] = zero8; if (fq < 2) afn[mt] = *(const bf16x8*)(U + ubase + (size_t)(mt * 16 + fr) * 1024); }
#pragma unroll 1
    for (int sb = 0; sb < 8; ++sb) {
        const int tok0 = b * SEQ + tc * 256 + sb * 32;
        bf16x8 af[2] = {afn[0], afn[1]};
        if (sb < 7) {
#pragma unroll
            for (int mt = 0; mt < 2; ++mt) if (fq < 2) afn[mt] = *(const bf16x8*)(U + ubase + (size_t)((sb + 1) * 32 + mt * 16 + fr) * 1024);
        }
#pragma unroll
        for (int mt = 0; mt < 2; ++mt) {
#pragma unroll
            for (int nt = 0; nt < 8; ++nt) { const f32x4 r = MFMA16(af[mt], bfr[nt], ((f32x4){0.f, 0.f, 0.f, 0.f}));
#pragma unroll
                for (int j = 0; j < 4; ++j) L[(mt * 16 + fq * 4 + j) * 132 + nt * 16 + fr] = r[j]; } }
#pragma unroll 8
        for (int t = 0; t < 32; ++t) { const float bre = L[t * 132 + lane], bim = L[t * 132 + 64 + lane];
            const float nre = ar * sre - ai * sim + bre, nim = ar * sim + ai * sre + bim; sre = nre; sim = nim;
            if (OUT) { L[t * 132 + lane] = sre; L[t * 132 + 64 + lane] = sim; } }
        if (OUT) {
#pragma unroll
            for (int mt = 0; mt < 2; ++mt) { f32x4 acc = MFMA16(af[mt], dfr, ((f32x4){0.f, 0.f, 0.f, 0.f}));
#pragma unroll
                for (int kk = 0; kk < 4; ++kk) { float f[8];
#pragma unroll
                    for (int i = 0; i < 8; ++i) f[i] = L[(mt * 16 + fr) * 132 + kk * 32 + fq * 8 + i];
                    acc = MFMA16(pack8(f), cfr[kk], acc); }
#pragma unroll
                for (int j = 0; j < 4; ++j) OT[(mt * 16 + fq * 4 + j) * 16 + fr] = f2bf(gelu_tanh(acc[j])); }
            *(u32x4*)(YB + (size_t)(tok0 + (lane >> 1)) * 1024 + g * 16 + (lane & 1) * 8) = *(const LAS u32x4*)(OT + lane * 8);
        }
    }
    if (!OUT) SEND[((size_t)(b * 32 + tc) * 64 + g) * 64 + lane] = (f32x2){sre, sim};
}

#define XB_TMO      128
#define XB_XCNT(j)  (256  + 64 * (j))
#define XB_XSUB(j)  (1280 + 64 * (j))
#define XB_XGEN(j)  (2304 + 64 * (j))
#define XB_TOP      3328
#define XB_TOPGEN   3392
#define XCD_BAR_WORDS 3456
#define XB_SPIN_CAP (1u << 23)
__device__ __forceinline__ unsigned xb_ld(unsigned* p)              { return __hip_atomic_load(p, __ATOMIC_RELAXED, __HIP_MEMORY_SCOPE_AGENT); }
__device__ __forceinline__ unsigned xb_add(unsigned* p, unsigned v) { return __hip_atomic_fetch_add(p, v, __ATOMIC_RELAXED, __HIP_MEMORY_SCOPE_AGENT); }
__device__ __forceinline__ unsigned xb_xcc_id() { return (unsigned)__builtin_amdgcn_s_getreg((3 << 11) | 20) & 0xFu; }
#define XB_SPIN(cond, bar) do { unsigned _sp = 0; while (cond) { __builtin_amdgcn_s_sleep(1); \
    if ((++_sp & 255u) == 0u) { if (xb_ld(&(bar)[XB_TMO])) break; if (_sp > XB_SPIN_CAP) { atomicAdd(&(bar)[XB_TMO], 1u); break; } } } } while (0)
struct XcdBarrier { unsigned* bar; unsigned x; volatile LAS unsigned* st; };
__device__ __forceinline__ XcdBarrier xcd_barrier_post(unsigned* bar, volatile LAS unsigned* st) {
    XcdBarrier b; b.bar = bar; b.x = xb_xcc_id(); b.st = st;
    if (threadIdx.x == 0) (void)xb_add(&bar[XB_XCNT(b.x)], 1u);
    return b;
}
__device__ __forceinline__ void xcd_barrier_complete(unsigned* bar, unsigned x, unsigned& nloc, unsigned& nx) {
    const unsigned G = gridDim.x * gridDim.y * gridDim.z;
    unsigned sum, cnt, mine, sp = 0u;
    for (;;) {
        sum = 0u; cnt = 0u; mine = 0u;
#pragma unroll
        for (unsigned j = 0; j < 16; ++j) { const unsigned c = xb_ld(&bar[XB_XCNT(j)]); sum += c; cnt += (c > 0u) ? 1u : 0u; mine = (j == x) ? c : mine; }
        if (sum == G) break;
        __builtin_amdgcn_s_sleep(1);
        if ((++sp & 255u) == 0u) { if (xb_ld(&bar[XB_TMO])) break; if (sp > XB_SPIN_CAP) { atomicAdd(&bar[XB_TMO], 1u); break; } }
    }
    nloc = mine > 0u ? mine : 1u; nx = cnt > 0u ? cnt : 1u;
}
__device__ __forceinline__ void xcd_barrier(const XcdBarrier& b) {
    asm volatile("s_waitcnt vmcnt(0)" ::: "memory");
    __syncthreads();
    if (threadIdx.x == 0) {
        unsigned* bar = b.bar;
        __builtin_amdgcn_s_waitcnt(0);
        unsigned nloc = b.st[0], nx = b.st[1];
        if (nloc == 0u) { xcd_barrier_complete(bar, b.x, nloc, nx); b.st[0] = nloc; b.st[1] = nx; }
        const unsigned old = xb_add(&bar[XB_XSUB(b.x)], 1u);
        const unsigned gen = old / nloc;
        if (old + 1u == (gen + 1u) * nloc) {
            __builtin_amdgcn_fence(__ATOMIC_RELEASE, "agent");
            asm volatile("s_waitcnt vmcnt(0)" ::: "memory");
            const unsigned og = xb_add(&bar[XB_TOP], 1u);
            const unsigned tg = og / nx;
            if (og + 1u == (tg + 1u) * nx) xb_add(&bar[XB_TOPGEN], 1u);
            else XB_SPIN(xb_ld(&bar[XB_TOPGEN]) == tg, bar);
            __builtin_amdgcn_fence(__ATOMIC_ACQUIRE, "agent");
            xb_add(&bar[XB_XGEN(b.x)], 1u);
            asm volatile("s_waitcnt vmcnt(0)" ::: "memory");
        } else {
            XB_SPIN(xb_ld(&bar[XB_XGEN(b.x)]) == gen, bar);
            __builtin_amdgcn_fence(__ATOMIC_ACQUIRE, "agent");
            asm volatile("s_waitcnt vmcnt(0)" ::: "memory");
        }
    }
    __syncthreads();
}

__global__ void __launch_bounds__(512, 2) mega(Params p) {
    extern __shared__ __attribute__((aligned(16))) unsigned char shm[];
    LAS unsigned char* lds = (LAS unsigned char*)shm;
    cg::grid_group grid = cg::this_grid();
    unsigned char* ws = p.ws;
    const int tid = threadIdx.x, G = gridDim.x, gtid = blockIdx.x * 512 + tid, nthr = G * 512;
    const int lo = p.ph_lo, hi = p.ph_hi;
    float* mods = (float*)(ws + WS_MODS);
    u16* H = (u16*)(ws + WS_H); u16* HID = (u16*)(ws + WS_HID);
#define IN(k) (lo <= (k) && (k) < hi)
    volatile LAS unsigned* xbst = (volatile LAS unsigned*)(lds + LDS_PHASE_BYTES);
    if (tid < 4) xbst[tid] = 0u;
    __syncthreads();
    XcdBarrier xbar = xcd_barrier_post((unsigned*)(ws + WS_BAR), xbst);
#define SYNC(k) do { if (IN(k) && IN((k) + 1)) xcd_barrier(xbar); } while (0)
#ifndef REP_MASK
#define REP_MASK 0
#endif
#define REP(k) for (int _rep = 0; _rep < (((REP_MASK >> (k)) & 1) ? 2 : 1); ++_rep)

    if (IN(0)) REP(0) {
        LAS float* scl = (LAS float*)lds;
        for (int i = tid; i < 4096; i += 512) scl[i] = siluf_(p.in[I_C][i]);
        __syncthreads();
        float* part = (float*)(ws + WS_PART); const float* wada = p.in[I_WADA];
        for (int it = gtid; it < 32 * 4608; it += nthr) { const int kc = it / 4608, cgp = it % 4608;
            f32x4 a0 = (f32x4){0.f, 0.f, 0.f, 0.f}, a1 = a0; const float* wp = wada + (size_t)(kc * 64) * NMOD + cgp * 4;
#pragma unroll 8
            for (int k = 0; k < 64; ++k) { const f32x4 wv = *(const f32x4*)(wp + (size_t)k * NMOD); a0 += wv * scl[kc * 64 + k]; a1 += wv * scl[2048 + kc * 64 + k]; }
            *(f32x4*)(part + (size_t)(kc * 2 + 0) * NMOD + cgp * 4) = a0; *(f32x4*)(part + (size_t)(kc * 2 + 1) * NMOD + cgp * 4) = a1; }
        u16* BBAR = (u16*)(ws + WS_BBAR); f32x2* AV = (f32x2*)(ws + WS_AV); f32x2* AL = (f32x2*)(ws + WS_AL);
        for (int i = gtid; i < 4096; i += nthr) { const int g = i >> 6;
            const float dt = expf(p.in[I_LOGDT][g]); const float lr = fminf(p.in[I_LRE][i], -1e-4f), li = p.in[I_LIM][i];
            const float mag = expf(lr * dt); const float ar = mag * cosf(li * dt), ai = mag * sinf(li * dt);
            const float den = lr * lr + li * li, nr = ar - 1.f; const float kr = (nr * lr + ai * li) / den, ki = (ai * lr - nr * li) / den;
            const int pp = i & 63;
#pragma unroll
            for (int ii = 0; ii < 16; ++ii) { const float br = p.in[I_BRE][(size_t)i * 16 + ii], bi = p.in[I_BIM][(size_t)i * 16 + ii];
                BBAR[((size_t)(g * 128 + pp)) * 16 + ii] = f2bf(kr * br - ki * bi); BBAR[((size_t)(g * 128 + 64 + pp)) * 16 + ii] = f2bf(kr * bi + ki * br); }
            AV[i] = (f32x2){ar, ai}; float xr = ar, xi = ai;
#pragma unroll
            for (int s = 0; s < 8; ++s) { const float t = xr * xr - xi * xi; xi = 2.f * xr * xi; xr = t; }
            AL[i] = (f32x2){xr, xi}; }
        u16* CM = (u16*)(ws + WS_CM);
        for (int i = gtid; i < 131072; i += nthr) { const int gi = i >> 7, q = i & 127; CM[i] = f2bf(q < 64 ? p.in[I_CRE][(size_t)gi * 64 + q] : -p.in[I_CIM][(size_t)gi * 64 + q - 64]); }
    }
    SYNC(0);
    if (IN(1)) REP(1) {
        const float* part = (const float*)(ws + WS_PART);
        for (int i = gtid; i < 2 * NMOD; i += nthr) { const int b = i / NMOD, j = i % NMOD; float s = p.in[I_BADA][j];
#pragma unroll 8
            for (int kc = 0; kc < 32; ++kc) s += part[(size_t)(kc * 2 + b) * NMOD + j];
            mods[i] = s; }
        int tb = 0; LAS float* T = (LAS float*)lds;
        conv_weight(T, p.in[I_W1IN], (u16*)(ws + WS_W1IN), 2048, 2 * FF, 2 * FF, 0, tb, true);
        conv_weight(T, p.in[I_W1OUT], (u16*)(ws + WS_W1OUT), FF, 2048, 2048, 1, tb);
        conv_weight(T, p.in[I_WIN], (u16*)(ws + WS_WIN), 2048, 10272, NPROJ_C, 2, tb);
        conv_weight(T, p.in[I_WA], (u16*)(ws + WS_WA), 2048, 2048, 2048, 1, tb);
        conv_weight(T, p.in[I_WB], (u16*)(ws + WS_WB), 1024, 4096, 4096, 3, tb);
        conv_weight(T, p.in[I_WO], (u16*)(ws + WS_WO), 2048, 2048, 2048, 1, tb);
    }
    SYNC(1);
    if (IN(2)) REP(2) norm_rows<0, true>(p.in[I_X], p.in[I_NF1], mods + 0 * DM, mods + 1 * DM, H, nullptr);
    SYNC(2);
    if (IN(3)) REP(3) { pg8::Gemm g{H, (const u16*)(ws + WS_W1IN), M_TOK, 2 * FF, 2048}; pg8::StaticOrder S; S.init(M_TOK, 2 * FF, G, blockIdx.x); EpiSwiglu E{HID}; pg8::gemm_phase<EpiSwiglu, true, true>(lds, g, S, E); }
    SYNC(3);
    if (IN(4)) REP(4) { pg8::Gemm g{HID, (const u16*)(ws + WS_W1OUT), M_TOK, 2048, FF}; pg8::StaticOrder S; S.init(M_TOK, 2048, G, blockIdx.x, true); EpiResid E{p.in[I_X], p.out, mods + 2 * DM, 0.5f}; pg8::gemm_phase(lds, g, S, E); }
    SYNC(4);
    if (IN(5)) REP(5) {
        norm_dt_rows(p.out, p.in[I_NMIX], mods + 3 * DM, mods + 4 * DM, H, (const u16*)(ws + WS_WIN) + (size_t)NPROJ_G * 2048, p.in[I_DTB], (float*)(ws + WS_DT));
        int tb = 0; LAS float* T = (LAS float*)lds;
        conv_weight(T, p.in[I_W2IN], (u16*)(ws + WS_W1IN), 2048, 2 * FF, 2 * FF, 0, tb, true);
        conv_weight(T, p.in[I_W2OUT], (u16*)(ws + WS_W1OUT), FF, 2048, 2048, 1, tb);
    }
    SYNC(5);
    if (IN(6)) REP(6) { pg8::Gemm g{H, (const u16*)(ws + WS_WIN), M_TOK, NPROJ_G, 2048}; pg8::StaticOrder S; S.init(M_TOK, NPROJ_G, G, blockIdx.x);
        EpiProj E{(u16*)(ws + WS_Z), (u16*)(ws + WS_X), (u16*)(ws + WS_U), (u16*)(ws + WS_G), (float*)(ws + WS_DT), p.in[I_DTB]}; pg8::gemm_phase(lds, g, S, E); }
    SYNC(6);
    if (IN(7)) REP(7) {
        __syncthreads();
        REP(17) for (int it = blockIdx.x; it < 512; it += G) ssd_a_item(p, lds, it);
        REP(18) for (int it = blockIdx.x * 8 + (tid >> 6); it < 4096; it += G * 8) s5_item<false>(p, lds, it);
    }
    SYNC(7);
    if (IN(8)) REP(8) {
        u16* ST = (u16*)(ws + WS_ST); const float* CS = (const float*)(ws + WS_CS);
        for (int idx = gtid; idx < 131072; idx += nthr) { const int n4 = idx & 31, pp = (idx >> 5) & 63, h = (idx >> 11) & 31, b = idx >> 16;
            float run[4] = {0.f, 0.f, 0.f, 0.f};
#pragma unroll 1
            for (int cb = 0; cb < 64; cb += 16) {
                u32x2 sv[16]; float cse[16];
#pragma unroll
                for (int i = 0; i < 16; ++i) { const size_t hc = (size_t)((b * 64 + cb + i) * 32 + h); sv[i] = *(const u32x2*)(ST + (hc * 64 + pp) * 128 + n4 * 4); cse[i] = CS[hc * 128 + 127]; }
                asm volatile("" ::: "memory");
#pragma unroll
                for (int i = 0; i < 16; ++i) { const size_t hc = (size_t)((b * 64 + cb + i) * 32 + h); const float dec = __expf(cse[i]);
                    u32x2 o; o.x = cvt_pk_bf16(run[0], run[1]); o.y = cvt_pk_bf16(run[2], run[3]); *(u32x2*)(ST + (hc * 64 + pp) * 128 + n4 * 4) = o;
                    run[0] = dec * run[0] + bflo(sv[i].x); run[1] = dec * run[1] + bfhi(sv[i].x); run[2] = dec * run[2] + bflo(sv[i].y); run[3] = dec * run[3] + bfhi(sv[i].y); }
                asm volatile("" ::: "memory");
            } }
        const f32x2* AL = (const f32x2*)(ws + WS_AL); const f32x2* SEND = (const f32x2*)(ws + WS_SEND); f32x2* SINIT = (f32x2*)(ws + WS_SINIT);
        for (int idx = gtid; idx < 8192; idx += nthr) { const int gp = idx & 4095, b = idx >> 12; const f32x2 a = AL[gp]; float sr = 0.f, si = 0.f;
            f32x2 ev[32];
#pragma unroll
            for (int tc = 0; tc < 32; ++tc) ev[tc] = SEND[(size_t)(b * 32 + tc) * 4096 + gp];
            asm volatile("" ::: "memory");
#pragma unroll
            for (int tc = 0; tc < 32; ++tc) { SINIT[(size_t)(b * 32 + tc) * 4096 + gp] = (f32x2){sr, si};
                const float nr = a.x * sr - a.y * si + ev[tc].x, ni = a.x * si + a.y * sr + ev[tc].y; sr = nr; si = ni; } }
    }
    SYNC(8);
    if (IN(9)) REP(9) {
        __syncthreads();
        REP(19) for (int it = blockIdx.x; it < 512; it += G) ssd_c_item(p, lds, it);
        REP(20) for (int it = blockIdx.x * 8 + (tid >> 6); it < 4096; it += G * 8) s5_item<true>(p, lds, it);
    }
    SYNC(9);
    if (IN(10)) REP(10) { pg8::Gemm g{(const u16*)(ws + WS_YB), (const u16*)(ws + WS_WB), M_TOK, 4096, 1024}; pg8::StaticOrder S; S.init(M_TOK, 4096, G, blockIdx.x); EpiGlu E{(u16*)(ws + WS_MB), (const u16*)(ws + WS_G)}; pg8::gemm_phase(lds, g, S, E); }
    SYNC(10);
    if (IN(11)) REP(11) { pg8::Gemm g{(const u16*)(ws + WS_YA), (const u16*)(ws + WS_WA), M_TOK, 2048, 2048}; pg8::StaticOrder S; S.init(M_TOK, 2048, G, blockIdx.x); EpiMerge E{H, (const u16*)(ws + WS_G), (const u16*)(ws + WS_MB)}; pg8::gemm_phase(lds, g, S, E); }
    SYNC(11);
    if (IN(12)) REP(12) { pg8::Gemm g{H, (const u16*)(ws + WS_WO), M_TOK, 2048, 2048}; pg8::StaticOrder S; S.init(M_TOK, 2048, G, blockIdx.x); EpiResid E{p.out, p.out, mods + 5 * DM, 1.0f}; pg8::gemm_phase(lds, g, S, E); }
    SYNC(12);
    if (IN(13)) REP(13) norm_rows<0>(p.out, p.in[I_NF2], mods + 6 * DM, mods + 7 * DM, H, nullptr);
    SYNC(13);
    if (IN(14)) REP(14) { pg8::Gemm g{H, (const u16*)(ws + WS_W1IN), M_TOK, 2 * FF, 2048}; pg8::StaticOrder S; S.init(M_TOK, 2 * FF, G, blockIdx.x); EpiSwiglu E{HID}; pg8::gemm_phase<EpiSwiglu, false, true>(lds, g, S, E); }
    SYNC(14);
    if (IN(15)) REP(15) { pg8::Gemm g{HID, (const u16*)(ws + WS_W1OUT), M_TOK, 2048, FF}; pg8::StaticOrder S; S.init(M_TOK, 2048, G, blockIdx.x, true); EpiResid E{p.out, p.out, mods + 8 * DM, 0.5f}; pg8::gemm_phase(lds, g, S, E); }
    SYNC(15);
    if (IN(16)) REP(16) norm_rows<1>(p.out, p.in[I_NFIN], nullptr, nullptr, nullptr, p.out);
    if (hi > NPH) grid.sync();
#undef IN
#undef SYNC
}

#ifndef MK_SPLIT
#define MK_SPLIT 0
#endif
extern "C" void kernel_launch(void* const* d_in, const int* in_sizes, int n_in, void* d_out, int out_size, void* d_ws, size_t ws_size, hipStream_t stream) {
    static int grid = 0;
    if (grid == 0) {
        if (n_in != 30 || ws_size < WS_END) { fprintf(stderr, "kernel_launch: n_in %d ws %zu (need %zu)\n", n_in, ws_size, (size_t)WS_END); grid = -1; return; }
        int dev = 0, cus = 0, per_cu = 0;
        (void)hipGetDevice(&dev); (void)hipDeviceGetAttribute(&cus, hipDeviceAttributeMultiprocessorCount, dev);
        (void)hipFuncSetAttribute((const void*)mega, hipFuncAttributeMaxDynamicSharedMemorySize, LDS_BYTES);
        (void)hipOccupancyMaxActiveBlocksPerMultiprocessor(&per_cu, (const void*)mega, 512, LDS_BYTES);
        if (per_cu < 1) per_cu = 1;
        grid = cus * per_cu; if (grid > 256) grid = 256;
    }
    if (grid < 0) return;
    Params p{};
    for (int i = 0; i < 30; ++i) p.in[i] = (const float*)d_in[i];
    p.out = (float*)d_out; p.ws = (unsigned char*)d_ws;
    (void)hipMemsetAsync((unsigned char*)d_ws + WS_BAR, 0, 16384, stream);
#if MK_SPLIT
    for (int ph = 0; ph < NPH; ++ph) { p.ph_lo = ph; p.ph_hi = ph + 1; void* args[] = {&p};
        (void)hipLaunchCooperativeKernel((void*)mega, dim3(grid), dim3(512), args, LDS_BYTES, stream); }
#else
    p.ph_lo = 0; p.ph_hi = NPH; void* args[] = {&p};
    hipError_t e = hipLaunchCooperativeKernel((void*)mega, dim3(grid), dim3(512), args, LDS_BYTES, stream);
    if (e != hipSuccess) fprintf(stderr, "cooperative launch failed: %s (grid %d)\n", hipGetErrorString(e), grid);
#endif
}
```

```cpp
#include <hip/hip_runtime.h>
#include <hip/hip_cooperative_groups.h>
#include <cstdio>
#define REP_MASK 0
namespace cg = cooperative_groups;

#define LAS __attribute__((address_space(3)))
typedef unsigned short u16;
typedef short bf16x8 __attribute__((ext_vector_type(8)));
typedef float f32x4 __attribute__((ext_vector_type(4)));
typedef float f32x2 __attribute__((ext_vector_type(2)));
typedef unsigned u32x4 __attribute__((ext_vector_type(4)));
typedef unsigned u32x2 __attribute__((ext_vector_type(2)));

constexpr int M_TOK = 16384, DM = 2048, FF = 5504, SEQ = 8192;
constexpr int NPROJ = 10496;
constexpr int NPROJ_G = 10240, NPROJ_C = 10304;
constexpr int NMOD = 18432;
constexpr int LDS_PHASE_BYTES = 147456;
constexpr int LDS_BYTES = LDS_PHASE_BYTES + 16;
constexpr int NPH = 17;

constexpr size_t WS_W1IN = 0;
constexpr size_t WS_W1OUT = WS_W1IN + (size_t)11008 * 2048 * 2;
constexpr size_t WS_WIN = WS_W1OUT + (size_t)2048 * 5504 * 2;
constexpr size_t WS_WA = WS_WIN + (size_t)NPROJ * 2048 * 2;
constexpr size_t WS_WB = WS_WA + (size_t)2048 * 2048 * 2;
constexpr size_t WS_WO = WS_WB + (size_t)4096 * 1024 * 2;
constexpr size_t WS_H = WS_WO + (size_t)2048 * 2048 * 2;
constexpr size_t WS_HID = WS_H + (size_t)M_TOK * 2048 * 2;
constexpr size_t WS_X = WS_HID + (size_t)M_TOK * FF * 2;
constexpr size_t WS_G = WS_X + (size_t)M_TOK * 3072 * 2;
constexpr size_t WS_MISC = WS_G + (size_t)M_TOK * 4096 * 2;
constexpr size_t WS_Z = WS_HID;
constexpr size_t WS_U = WS_Z + (size_t)M_TOK * 2048 * 2;
constexpr size_t WS_DT = WS_U + (size_t)M_TOK * 1024 * 2;
constexpr size_t WS_CS = WS_DT + (size_t)M_TOK * 32 * 4;
constexpr size_t WS_ST = WS_CS + (size_t)M_TOK * 32 * 4;
constexpr size_t WS_MB = WS_ST;
static_assert(WS_ST + (size_t)M_TOK * 2048 * 2 <= WS_X, "mixer buffers overflow HID");
constexpr size_t WS_BC = WS_WIN;
constexpr size_t WS_CC = WS_BC + (size_t)M_TOK * 512 * 2;
constexpr size_t WS_YA = WS_X;
constexpr size_t WS_YB = WS_YA + (size_t)M_TOK * 2048 * 2;
constexpr size_t WS_PART = WS_MISC;
constexpr size_t WS_MODS = WS_PART + (size_t)32 * 2 * NMOD * 4;
constexpr size_t WS_BBAR = WS_MODS + (size_t)2 * NMOD * 4;
constexpr size_t WS_CM = WS_BBAR + (size_t)64 * 128 * 16 * 2;
constexpr size_t WS_AV = WS_CM + (size_t)64 * 16 * 128 * 2;
constexpr size_t WS_AL = WS_AV + (size_t)4096 * 8;
constexpr size_t WS_SEND = WS_AL + (size_t)4096 * 8;
constexpr size_t WS_SINIT = WS_SEND + (size_t)2 * 32 * 4096 * 8;
constexpr size_t WS_BAR = WS_SINIT + (size_t)2 * 32 * 4096 * 8;
constexpr size_t WS_BCT = WS_BAR + 16384;
constexpr size_t WS_END = WS_BCT + (size_t)512 * 16384 * 2;

struct Params {
    const float* in[30];
    float* out; unsigned char* ws; int ph_lo, ph_hi;
};
enum { I_X = 0, I_C, I_WADA, I_BADA, I_NF1, I_W1IN, I_W1OUT, I_NMIX, I_WIN, I_CONVW, I_CONVB, I_DTB, I_ALOG, I_DSSD, I_SNW, I_WA,
       I_LRE, I_LIM, I_BRE, I_BIM, I_CRE, I_CIM, I_S5D, I_LOGDT, I_WB, I_WO, I_NF2, I_W2IN, I_W2OUT, I_NFIN };

__device__ __forceinline__ unsigned cvt_pk_bf16(float lo, float hi) { unsigned r; asm volatile("v_cvt_pk_bf16_f32 %0, %1, %2" : "=v"(r) : "v"(lo), "v"(hi)); return r; }
__device__ __forceinline__ u16 f2bf(float f) { return (u16)(cvt_pk_bf16(f, 0.f) & 0xffffu); }
__device__ __forceinline__ float bf2f(u16 b) { return __uint_as_float(((unsigned)b) << 16); }
__device__ __forceinline__ float bflo(unsigned w) { return __uint_as_float(w << 16); }
__device__ __forceinline__ float bfhi(unsigned w) { return __uint_as_float(w & 0xffff0000u); }
__device__ __forceinline__ float sigmoidf_(float v) { return __builtin_amdgcn_rcpf(1.f + __expf(-v)); }
__device__ __forceinline__ float siluf_(float v) { return v * sigmoidf_(v); }
__device__ __forceinline__ float gelu_tanh(float v) { const float z = 0.7978845608028654f * (v + 0.044715f * v * v * v); const float t = 1.f - 2.f * __builtin_amdgcn_rcpf(__expf(2.f * z) + 1.f); return 0.5f * v * (1.f + t); }
__device__ __forceinline__ bf16x8 pack8(const float* f) { u32x4 w; w.x = cvt_pk_bf16(f[0], f[1]); w.y = cvt_pk_bf16(f[2], f[3]); w.z = cvt_pk_bf16(f[4], f[5]); w.w = cvt_pk_bf16(f[6], f[7]); return __builtin_bit_cast(bf16x8, w); }
#define MFMA16(a, b, c) __builtin_amdgcn_mfma_f32_16x16x32_bf16((a), (b), (c), 0, 0, 0)

namespace pg8 {
constexpr int BM = 256, BK = 64, HALF = 128, HTB = HALF * BK * 2, STAGE_BYTES = 8 * HTB, NXCD = 8, WGM = 8;
__device__ __forceinline__ int lds_byte(int r, int c) { const int st = (r >> 4) * 2 + (c >> 5), rr = r & 15, cc = c & 31, ob = rr * 64 + cc * 2; return st * 1024 + (ob ^ (((ob >> 9) & 1) << 5)); }
__device__ __forceinline__ void stage_rc(int b, int& R, int& C) { const int st = b / 1024, sb = b % 1024, swz = sb ^ (((sb >> 9) & 1) << 5); R = (st >> 1) * 16 + swz / 64; C = (st & 1) * 32 + (swz % 64) / 2; }
__device__ __forceinline__ int perm32(int rho) { const int n = rho >> 4, i = rho & 15; return 8 * (i >> 2) + 4 * n + (i & 3); }
struct Unit { int pm, pn; };
struct Gemm { const u16* A; const u16* Bt; int M, N, K; };
struct StaticOrder {
    int nM, nN, nwg, G, c; bool pnfast;
    __device__ void init(int M, int N, int G_, int c_, bool pf = false) { nM = M / BM; nN = N / BM; nwg = nM * nN; G = G_; c = c_; pnfast = pf; }
    __device__ bool next(int i, Unit& u) const {
        const long L = (long)i * G + c; if (L >= nwg) return false;
        int wgid = (int)L; { const int q = nwg / NXCD, r = nwg % NXCD, xcd = wgid % NXCD, off = wgid / NXCD; wgid = (xcd < r ? xcd * (q + 1) : r * (q + 1) + (xcd - r) * q) + off; }
        const int nig = WGM * nN, gid = wgid / nig, fm = gid * WGM, gsz = (nM - fm) < WGM ? (nM - fm) : WGM;
        if (pnfast) { u.pm = fm + (wgid % nig) / nN; u.pn = (wgid % nig) % nN; } else { u.pm = fm + ((wgid % nig) % gsz); u.pn = (wgid % nig) / gsz; }
        return true;
    }
};

template <class Epi, bool TA = false, bool TB = false>
__device__ __forceinline__ void gemm_phase(LAS unsigned char* lds, const Gemm g, const StaticOrder& S, const Epi& E) {
    const int tid = threadIdx.x, wid = __builtin_amdgcn_readfirstlane(tid >> 6), lane = tid & 63, wr = wid >> 2, wc = wid & 3, fr = lane & 15, fq = lane >> 4;
    const int K = g.K, nt = K / BK;
    unsigned voffA[2], voffB[2];
#pragma unroll
    for (int i = 0; i < 2; ++i) { int R, C; stage_rc(tid * 16 + i * 8192, R, C); const int Rb = Epi::PERM ? ((R & ~31) + perm32(R & 31)) : R;
        voffA[i] = (unsigned)(R * (TA ? BK : K) + C) * 2u; voffB[i] = (unsigned)(Rb * (TB ? BK : K) + C) * 2u; }
    const size_t kstepA = TA ? (size_t)HTB : (size_t)(BK * 2), kstepB = TB ? (size_t)HTB : (size_t)(BK * 2);
    const size_t hstepA = TA ? (size_t)nt * HTB : (size_t)HALF * K * 2, hstepB = TB ? (size_t)nt * HTB : (size_t)HALF * K * 2;
    const size_t tstep = (size_t)BM * K * 2;
    const unsigned ldsw = (unsigned)wid * 1024u;
    const int aoff = lds_byte(wr * 64 + fr, fq * 8), boff = lds_byte(wc * 32 + fr, fq * 8);
#define PG8_SA(b, h) (((b) * 2 + (h)) * HTB)
#define PG8_SB(b, h) ((4 + (b) * 2 + (h)) * HTB)
#define PG8_STAGE(bufoff, gbase, voff) do { _Pragma("unroll") for (int _i = 0; _i < 2; ++_i) \
        __builtin_amdgcn_global_load_lds((const unsigned*)((const char*)(gbase) + (voff)[_i]), (LAS unsigned*)(lds + (bufoff) + ldsw + _i * 8192), 16, 0, 0); } while (0)
#define PG8_LDA(dst, b, h) do { _Pragma("unroll") for (int m = 0; m < 4; ++m) _Pragma("unroll") for (int k = 0; k < 2; ++k) dst[m][k] = *(const LAS bf16x8*)(lds + PG8_SA(b, h) + aoff + m * 2048 + k * 1024); } while (0)
#define PG8_LDB(dst, b, h) do { _Pragma("unroll") for (int n = 0; n < 2; ++n) _Pragma("unroll") for (int k = 0; k < 2; ++k) dst[n][k] = *(const LAS bf16x8*)(lds + PG8_SB(b, h) + boff + n * 2048 + k * 1024); } while (0)
#define PG8_MMA(ai, bj, At, Bt) do { __builtin_amdgcn_s_setprio(1); _Pragma("unroll") for (int m = 0; m < 4; ++m) _Pragma("unroll") for (int n = 0; n < 2; ++n) _Pragma("unroll") for (int k = 0; k < 2; ++k) \
        acc[ai][bj][m][n] = __builtin_amdgcn_mfma_f32_16x16x32_bf16(Bt[n][k], At[m][k], acc[ai][bj][m][n], 0, 0, 0); __builtin_amdgcn_s_setprio(0); } while (0)
#define PG8_WAIT_V(n) asm volatile("s_waitcnt vmcnt(" #n ")" ::: "memory")
#define PG8_WAIT_L(n) asm volatile("s_waitcnt lgkmcnt(" #n ")" ::: "memory")
#define PG8_BAR __builtin_amdgcn_s_barrier()
#define PG8_SCHED __builtin_amdgcn_sched_barrier(0)
    Unit cur, nxt; int ui = 0;
    if (!S.next(0, cur)) return;
    f32x4 acc[2][2][4][2];
#pragma unroll
    for (int a = 0; a < 2; ++a)
#pragma unroll
        for (int b = 0; b < 2; ++b)
#pragma unroll
            for (int m = 0; m < 4; ++m)
#pragma unroll
                for (int n = 0; n < 2; ++n) acc[a][b][m][n] = (f32x4){0.f, 0.f, 0.f, 0.f};
    bf16x8 At[4][2], B0[2][2], B1[2][2];
    const char* cA = (const char*)g.A + (size_t)cur.pm * tstep; const char* cB = (const char*)g.Bt + (size_t)cur.pn * tstep;
    PG8_STAGE(PG8_SB(0, 0), cB, voffB); PG8_STAGE(PG8_SA(0, 0), cA, voffA); PG8_STAGE(PG8_SB(0, 1), cB + hstepB, voffB); PG8_STAGE(PG8_SA(0, 1), cA + hstepA, voffA);
    if (wr == 1) PG8_BAR;
    PG8_WAIT_V(4); PG8_BAR;
    PG8_STAGE(PG8_SB(1, 0), cB + kstepB, voffB); PG8_STAGE(PG8_SA(1, 0), cA + kstepA, voffA); PG8_STAGE(PG8_SB(1, 1), cB + hstepB + kstepB, voffB);
    PG8_WAIT_V(6); PG8_BAR;
    for (;;) {
        const bool has_next = S.next(ui + 1, nxt);
        const char* nA = has_next ? (const char*)g.A + (size_t)nxt.pm * tstep : cA; const char* nB = has_next ? (const char*)g.Bt + (size_t)nxt.pn * tstep : cB;
        for (int t = 0; t < nt; t += 2) {
            const bool last = (t == nt - 2);
            const char* a1 = cA + (size_t)(t + 1) * kstepA;
            const char* a2 = last ? nA : cA + (size_t)(t + 2) * kstepA; const char* b2 = last ? nB : cB + (size_t)(t + 2) * kstepB;
            const char* a3 = a2 + kstepA; const char* b3 = b2 + kstepB;
            PG8_LDB(B0, 0, 0); PG8_SCHED; PG8_LDA(At, 0, 0); PG8_STAGE(PG8_SA(1, 1), a1 + hstepA, voffA);
            PG8_WAIT_L(8); PG8_BAR; PG8_WAIT_L(0); PG8_MMA(0, 0, At, B0); PG8_BAR; PG8_SCHED;
            PG8_LDB(B1, 0, 1); PG8_STAGE(PG8_SB(0, 0), b2, voffB);
            PG8_BAR; PG8_WAIT_L(0); PG8_MMA(0, 1, At, B1); PG8_BAR;
            PG8_LDA(At, 0, 1); PG8_STAGE(PG8_SA(0, 0), a2, voffA);
            PG8_BAR; PG8_WAIT_L(0); PG8_MMA(1, 0, At, B0); PG8_BAR; PG8_SCHED;
            PG8_STAGE(PG8_SB(0, 1), b2 + hstepB, voffB);
            PG8_WAIT_V(6); PG8_BAR; PG8_MMA(1, 1, At, B1); PG8_BAR;
            PG8_LDB(B0, 1, 0); PG8_SCHED; PG8_LDA(At, 1, 0); PG8_STAGE(PG8_SA(0, 1), a2 + hstepA, voffA);
            PG8_WAIT_L(8); PG8_BAR; PG8_WAIT_L(0); PG8_MMA(0, 0, At, B0); PG8_BAR; PG8_SCHED;
            PG8_LDB(B1, 1, 1); PG8_STAGE(PG8_SB(1, 0), b3, voffB);
            PG8_BAR; PG8_WAIT_L(0); PG8_MMA(0, 1, At, B1); PG8_BAR;
            PG8_LDA(At, 1, 1); PG8_STAGE(PG8_SA(1, 0), a3, voffA);
            PG8_BAR; PG8_WAIT_L(0); PG8_MMA(1, 0, At, B0); PG8_BAR; PG8_SCHED;
            PG8_STAGE(PG8_SB(1, 1), b3 + hstepB, voffB);
            PG8_WAIT_V(6); PG8_BAR; PG8_MMA(1, 1, At, B1); PG8_BAR;
        }
        E(acc, cur, wr, wc, fr, fq);
        if (!has_next) break;
#pragma unroll
        for (int a = 0; a < 2; ++a)
#pragma unroll
            for (int b = 0; b < 2; ++b)
#pragma unroll
                for (int m = 0; m < 4; ++m)
#pragma unroll
                    for (int n = 0; n < 2; ++n) acc[a][b][m][n] = (f32x4){0.f, 0.f, 0.f, 0.f};
        cur = nxt; cA = nA; cB = nB; ++ui;
    }
    PG8_WAIT_V(0);
    if (wr == 0) PG8_BAR;
    PG8_BAR;
#undef PG8_SA
#undef PG8_SB
#undef PG8_STAGE
#undef PG8_LDA
#undef PG8_LDB
#undef PG8_MMA
#undef PG8_WAIT_V
#undef PG8_WAIT_L
#undef PG8_BAR
#undef PG8_SCHED
}
}

struct EpiSwiglu {
    static constexpr bool PERM = true;
    u16* O;
    __device__ __forceinline__ void operator()(const f32x4 (&acc)[2][2][4][2], const pg8::Unit& u, int wr, int wc, int fr, int fq) const {
        const int row0 = u.pm * 256 + wr * 64 + fr, col0 = u.pn * 128 + wc * 32 + 8 * fq;
#pragma unroll
        for (int ai = 0; ai < 2; ++ai)
#pragma unroll
            for (int m = 0; m < 4; ++m) {
                float v[8];
#pragma unroll
                for (int n = 0; n < 2; ++n)
#pragma unroll
                    for (int j = 0; j < 4; ++j) v[n * 4 + j] = siluf_(acc[ai][0][m][n][j]) * acc[ai][1][m][n][j];
                *(bf16x8*)(O + (size_t)(row0 + ai * 128 + m * 16) * FF + col0) = pack8(v);
            }
    }
};
struct EpiResid {
    static constexpr bool PERM = false;
    const float* xin; float* xout; const float* gate; float scale;
    __device__ __forceinline__ void operator()(const f32x4 (&acc)[2][2][4][2], const pg8::Unit& u, int wr, int wc, int fr, int fq) const {
        const int row0 = u.pm * 256 + wr * 64 + fr, col0 = u.pn * 256 + wc * 32 + 4 * fq;
        const float* gp = gate + (u.pm >= 32 ? NMOD : 0) + col0;
        f32x4 gv[2][2];
#pragma unroll
        for (int bj = 0; bj < 2; ++bj)
#pragma unroll
            for (int n = 0; n < 2; ++n) gv[bj][n] = *(const f32x4*)(gp + bj * 128 + n * 16) * scale;
#pragma unroll
        for (int ai = 0; ai < 2; ++ai) {
            f32x4 xi[4][2][2];
#pragma unroll
            for (int m = 0; m < 4; ++m)
#pragma unroll
                for (int bj = 0; bj < 2; ++bj)
#pragma unroll
                    for (int n = 0; n < 2; ++n) xi[m][bj][n] = *(const f32x4*)(xin + (size_t)(row0 + ai * 128 + m * 16) * DM + col0 + bj * 128 + n * 16);
#pragma unroll
            for (int m = 0; m < 4; ++m)
#pragma unroll
                for (int bj = 0; bj < 2; ++bj)
#pragma unroll
                    for (int n = 0; n < 2; ++n) *(f32x4*)(xout + (size_t)(row0 + ai * 128 + m * 16) * DM + col0 + bj * 128 + n * 16) = xi[m][bj][n] + gv[bj][n] * acc[ai][bj][m][n];
        }
    }
};
struct EpiProj {
    static constexpr bool PERM = true;
    u16* Z; u16* XBC; u16* U; u16* G; float* DT; const float* dt_bias;
    __device__ __forceinline__ void operator()(const f32x4 (&acc)[2][2][4][2], const pg8::Unit& u, int wr, int wc, int fr, int fq) const {
        const int row0 = u.pm * 256 + wr * 64 + fr, pn = u.pn;
        if (pn == 40) {
            if (wc == 0) {
#pragma unroll
                for (int ai = 0; ai < 2; ++ai)
#pragma unroll
                    for (int m = 0; m < 4; ++m) {
#pragma unroll
                        for (int n = 0; n < 2; ++n) { f32x4 o;
#pragma unroll
                            for (int j = 0; j < 4; ++j) { const float v = acc[ai][0][m][n][j] + dt_bias[8 * fq + 4 * n + j]; o[j] = v > 20.f ? v : log1pf(__expf(v)); }
                            *(f32x4*)(DT + (size_t)(row0 + ai * 128 + m * 16) * 32 + 8 * fq + 4 * n) = o; }
                    }
            }
            return;
        }
        u16* base; int ld, colt; bool sg = false;
        if (pn < 8) { base = Z; ld = 2048; colt = pn * 256; }
        else if (pn < 20) { base = XBC; ld = 3072; colt = (pn - 8) * 256; }
        else if (pn < 24) { base = U; ld = 1024; colt = (pn - 20) * 256; }
        else { base = G; ld = 4096; colt = (pn - 24) * 256; sg = true; }
        const int col0 = colt + wc * 32 + 8 * fq;
#pragma unroll
        for (int ai = 0; ai < 2; ++ai)
#pragma unroll
            for (int m = 0; m < 4; ++m)
#pragma unroll
                for (int bj = 0; bj < 2; ++bj) {
                    float v[8];
#pragma unroll
                    for (int n = 0; n < 2; ++n)
#pragma unroll
                        for (int j = 0; j < 4; ++j) { const float a = acc[ai][bj][m][n][j]; v[n * 4 + j] = sg ? sigmoidf_(a) : a; }
                    *(bf16x8*)(base + (size_t)(row0 + ai * 128 + m * 16) * ld + col0 + bj * 128) = pack8(v);
                }
    }
};
struct EpiGlu {
    static constexpr bool PERM = true;
    u16* O; const u16* G;
    __device__ __forceinline__ void operator()(const f32x4 (&acc)[2][2][4][2], const pg8::Unit& u, int wr, int wc, int fr, int fq) const {
        const int row0 = u.pm * 256 + wr * 64 + fr, col0 = u.pn * 128 + wc * 32 + 8 * fq;
        u32x4 gw[2][4];
#pragma unroll
        for (int ai = 0; ai < 2; ++ai)
#pragma unroll
            for (int m = 0; m < 4; ++m) gw[ai][m] = *(const u32x4*)(G + (size_t)(row0 + ai * 128 + m * 16) * 4096 + 2048 + col0);
#pragma unroll
        for (int ai = 0; ai < 2; ++ai)
#pragma unroll
            for (int m = 0; m < 4; ++m) {
                const size_t row = (size_t)(row0 + ai * 128 + m * 16);
                const u32x4 g4 = gw[ai][m];
                const float gb[8] = {bflo(g4.x), bfhi(g4.x), bflo(g4.y), bfhi(g4.y), bflo(g4.z), bfhi(g4.z), bflo(g4.w), bfhi(g4.w)};
                float v[8];
#pragma unroll
                for (int n = 0; n < 2; ++n)
#pragma unroll
                    for (int j = 0; j < 4; ++j) v[n * 4 + j] = gb[n * 4 + j] * acc[ai][0][m][n][j] * sigmoidf_(acc[ai][1][m][n][j]);
                *(bf16x8*)(O + row * DM + col0) = pack8(v);
            }
    }
};
struct EpiMerge {
    static constexpr bool PERM = true;
    u16* O; const u16* G; const u16* MB;
    __device__ __forceinline__ void operator()(const f32x4 (&acc)[2][2][4][2], const pg8::Unit& u, int wr, int wc, int fr, int fq) const {
        const int row0 = u.pm * 256 + wr * 64 + fr, col0 = u.pn * 256 + wc * 32 + 8 * fq;
#pragma unroll
        for (int ai = 0; ai < 2; ++ai) {
            u32x4 gw[4][2], mw[4][2];
#pragma unroll
            for (int m = 0; m < 4; ++m)
#pragma unroll
                for (int bj = 0; bj < 2; ++bj) { const size_t row = (size_t)(row0 + ai * 128 + m * 16); const int col = col0 + bj * 128;
                    gw[m][bj] = *(const u32x4*)(G + row * 4096 + col); mw[m][bj] = *(const u32x4*)(MB + row * DM + col); }
#pragma unroll
            for (int m = 0; m < 4; ++m)
#pragma unroll
                for (int bj = 0; bj < 2; ++bj) {
                    const size_t row = (size_t)(row0 + ai * 128 + m * 16); const int col = col0 + bj * 128;
                    const u32x4 g4 = gw[m][bj], m4 = mw[m][bj];
                    const float ga[8] = {bflo(g4.x), bfhi(g4.x), bflo(g4.y), bfhi(g4.y), bflo(g4.z), bfhi(g4.z), bflo(g4.w), bfhi(g4.w)};
                    const float mb[8] = {bflo(m4.x), bfhi(m4.x), bflo(m4.y), bfhi(m4.y), bflo(m4.z), bfhi(m4.z), bflo(m4.w), bfhi(m4.w)};
                    float v[8];
#pragma unroll
                    for (int n = 0; n < 2; ++n)
#pragma unroll
                        for (int j = 0; j < 4; ++j) v[n * 4 + j] = ga[n * 4 + j] * acc[ai][bj][m][n][j] + mb[n * 4 + j];
                    *(bf16x8*)(O + row * DM + col) = pack8(v);
                }
        }
    }
};

__device__ __forceinline__ size_t tiled_off(int row, int col, int K) { return ((size_t)(row >> 7) * (K >> 6) + (col >> 6)) * 8192 + (size_t)(row & 127) * 64 + (col & 63); }

__device__ __forceinline__ int map_col(int wsel, int n) {
    if (wsel == 0) return ((n >> 7) & 1) * FF + (n >> 8) * 128 + (n & 127);
    if (wsel == 3) return ((n >> 7) & 1) * 2048 + (n >> 8) * 128 + (n & 127);
    if (wsel == 2) { if (n < 5120) return n; if (n < 6144) return 5152 + (n - 5120); if (n < 10240) return 6176 + (n - 6144); if (n < 10272) return 5120 + (n - 10240); return -1; }
    return n;
}
__device__ __forceinline__ void conv_weight(LAS float* T, const float* __restrict__ src, u16* __restrict__ dst, int K, int ld, int ndst, int wsel, int& tbase, bool tiled = false) {
    const int nnt = ndst / 64, ntiles = (K / 128) * nnt, tid = threadIdx.x, G = gridDim.x;
    const int first = (((int)blockIdx.x - tbase) % G + G) % G;
    const int c4 = tid & 15, r = tid >> 4, kg = tid >> 5, nl = tid & 31;
    f32x4 v[4];
#define CW_LOAD(t_) do { const int n0_ = ((t_) % nnt) * 64, k0_ = ((t_) / nnt) * 128; const int sc_ = map_col(wsel, n0_ + c4 * 4); \
        _Pragma("unroll") for (int ps = 0; ps < 4; ++ps) { v[ps] = (f32x4){0.f, 0.f, 0.f, 0.f}; if (sc_ >= 0) v[ps] = *(const f32x4*)(src + (size_t)(k0_ + r + ps * 32) * ld + sc_); } } while (0)
#define CW_LBAR() do { asm volatile("s_waitcnt lgkmcnt(0)" ::: "memory"); __builtin_amdgcn_s_barrier(); asm volatile("" ::: "memory"); } while (0)
    if (first < ntiles) CW_LOAD(first);
    for (int t = first; t < ntiles; t += G) {
        const int n0 = (t % nnt) * 64, k0 = (t / nnt) * 128;
#pragma unroll
        for (int ps = 0; ps < 4; ++ps) { LAS float* tp = T + (r + ps * 32) * 65 + c4 * 4; tp[0] = v[ps].x; tp[1] = v[ps].y; tp[2] = v[ps].z; tp[3] = v[ps].w; }
        if (t + G < ntiles) CW_LOAD(t + G);
        CW_LBAR();
#pragma unroll
        for (int ps = 0; ps < 2; ++ps) { const int n = nl + ps * 32; float f[8];
#pragma unroll
            for (int j = 0; j < 8; ++j) f[j] = T[(kg * 8 + j) * 65 + n];
            *(bf16x8*)(dst + (tiled ? tiled_off(n0 + n, k0 + kg * 8, K) : (size_t)(n0 + n) * K + k0 + kg * 8)) = pack8(f); }
        CW_LBAR();
    }
#undef CW_LOAD
#undef CW_LBAR
    tbase += ntiles;
}

template <int MODE, bool TILED = false>
__device__ __forceinline__ void norm_rows(const float* src, const float* __restrict__ gw, const float* __restrict__ sh, const float* __restrict__ sc, u16* dst, float* fdst) {
    const int lane = threadIdx.x & 63, wg = blockIdx.x * 8 + (threadIdx.x >> 6), nw = gridDim.x * 8;
    for (int rp = wg; rp < M_TOK / 2; rp += nw) {
        f32x4 v[2][8]; float ss[2] = {0.f, 0.f};
#pragma unroll
        for (int q = 0; q < 2; ++q)
#pragma unroll
            for (int i = 0; i < 8; ++i) v[q][i] = *(const f32x4*)(src + (size_t)(rp * 2 + q) * DM + i * 256 + lane * 4);
#pragma unroll
        for (int q = 0; q < 2; ++q) {
#pragma unroll
            for (int i = 0; i < 8; ++i) ss[q] += v[q][i].x * v[q][i].x + v[q][i].y * v[q][i].y + v[q][i].z * v[q][i].z + v[q][i].w * v[q][i].w;
#pragma unroll
            for (int off = 32; off >= 1; off >>= 1) ss[q] += __shfl_xor(ss[q], off); }
#pragma unroll
        for (int q = 0; q < 2; ++q) { const int row = rp * 2 + q, bo = (row >> 13) * NMOD; const float rstd = rsqrtf(ss[q] * (1.f / 2048.f) + 1e-6f);
#pragma unroll
            for (int i = 0; i < 8; ++i) { const int col = i * 256 + lane * 4; const f32x4 g4 = *(const f32x4*)(gw + col);
                if (MODE == 0) { const f32x4 s4 = *(const f32x4*)(sc + bo + col), h4 = *(const f32x4*)(sh + bo + col);
                    const f32x4 o = v[q][i] * rstd * g4 * (s4 + 1.f) + h4;
                    u32x2 w; w.x = cvt_pk_bf16(o.x, o.y); w.y = cvt_pk_bf16(o.z, o.w); *(u32x2*)(dst + (TILED ? tiled_off(row, col, DM) : (size_t)row * DM + col)) = w; }
                else { *(f32x4*)(fdst + (size_t)row * DM + col) = v[q][i] * rstd * g4; } } }
    }
}

__device__ __forceinline__ void norm_dt_rows(const float* src, const float* __restrict__ gw, const float* __restrict__ sh, const float* __restrict__ sc, u16* dst,
                                             const u16* __restrict__ wdt  , const float* __restrict__ dt_bias, float* DT) {
    const int lane = threadIdx.x & 63, wg = blockIdx.x * 8 + (threadIdx.x >> 6), nw = gridDim.x * 8, fr = lane & 15, fq = lane >> 4;
    for (int rb = wg; rb < M_TOK / 8; rb += nw) {
        const int row0 = rb * 8, bo = (row0 >> 13) * NMOD;
#pragma unroll 1
        for (int i8 = 0; i8 < 8; i8 += 2) {
            f32x4 v[2][8]; float ss[2] = {0.f, 0.f};
#pragma unroll
            for (int q = 0; q < 2; ++q)
#pragma unroll
                for (int i = 0; i < 8; ++i) v[q][i] = *(const f32x4*)(src + (size_t)(row0 + i8 + q) * DM + i * 256 + lane * 4);
#pragma unroll
            for (int q = 0; q < 2; ++q) {
#pragma unroll
                for (int i = 0; i < 8; ++i) ss[q] += v[q][i].x * v[q][i].x + v[q][i].y * v[q][i].y + v[q][i].z * v[q][i].z + v[q][i].w * v[q][i].w;
#pragma unroll
                for (int off = 32; off >= 1; off >>= 1) ss[q] += __shfl_xor(ss[q], off); }
#pragma unroll
            for (int q = 0; q < 2; ++q) { const int row = row0 + i8 + q; const float rstd = rsqrtf(ss[q] * (1.f / 2048.f) + 1e-6f);
#pragma unroll
                for (int i = 0; i < 8; ++i) { const int col = i * 256 + lane * 4; const f32x4 g4 = *(const f32x4*)(gw + col), s4 = *(const f32x4*)(sc + bo + col), h4 = *(const f32x4*)(sh + bo + col);
                    const f32x4 o = v[q][i] * rstd * g4 * (s4 + 1.f) + h4;
                    u32x2 wv; wv.x = cvt_pk_bf16(o.x, o.y); wv.y = cvt_pk_bf16(o.z, o.w); *(u32x2*)(dst + (size_t)row * DM + col) = wv; } } }
        f32x4 a0 = (f32x4){0.f, 0.f, 0.f, 0.f}, a1 = a0;
        const u16* ap = dst + (size_t)(row0 + (fr & 7)) * DM + fq * 8; const u16* bp = wdt + (size_t)fr * 2048 + fq * 8;
        asm volatile("s_waitcnt vmcnt(0)" ::: "memory");
#pragma unroll 8
        for (int ks = 0; ks < 64; ++ks) { const bf16x8 a = *(const bf16x8*)(ap + ks * 32), b0 = *(const bf16x8*)(bp + ks * 32), b1 = *(const bf16x8*)(bp + 16 * 2048 + ks * 32);
            a0 = MFMA16(a, b0, a0); a1 = MFMA16(a, b1, a1); }
        if (fq < 2) {
#pragma unroll
            for (int j = 0; j < 4; ++j) { const float v0 = a0[j] + dt_bias[fr], v1 = a1[j] + dt_bias[16 + fr]; float* dp = DT + (size_t)(row0 + fq * 4 + j) * 32;
                dp[fr] = v0 > 20.f ? v0 : log1pf(__expf(v0)); dp[16 + fr] = v1 > 20.f ? v1 : log1pf(__expf(v1)); } }
    }
}

__device__ __forceinline__ void conv_tile4(const u32x4 (&raw)[11], const int jh, const float* __restrict__ cw, const float* __restrict__ cbp, float (&o)[8][4]) {
    const f32x4 w0 = *(const f32x4*)(cw + jh * 4), w1 = *(const f32x4*)(cw + 3072 + jh * 4), w2 = *(const f32x4*)(cw + 6144 + jh * 4), w3 = *(const f32x4*)(cw + 9216 + jh * 4), bb = *(const f32x4*)(cbp + jh * 4);
    f32x4 xr[11];
#pragma unroll
    for (int k = 0; k < 11; ++k) { const unsigned a = jh ? raw[k].z : raw[k].x, b2 = jh ? raw[k].w : raw[k].y; xr[k] = (f32x4){bflo(a), bfhi(a), bflo(b2), bfhi(b2)}; }
#pragma unroll
    for (int i = 0; i < 8; ++i) { const f32x4 v = bb + w0 * xr[i] + w1 * xr[i + 1] + w2 * xr[i + 2] + w3 * xr[i + 3];
#pragma unroll
        for (int jj = 0; jj < 4; ++jj) o[i][jj] = siluf_(v[jj]); }
}
constexpr int SA_XT = 17408, SA_CS_OFF = 8 * SA_XT, SA_DT_OFF = SA_CS_OFF + 4096, SA_BYTES = SA_DT_OFF + 4096;
__device__ __forceinline__ void ssd_a_item(const Params& p, LAS unsigned char* lds, int item) {
    unsigned char* ws = p.ws;
    const u16* XBC = (const u16*)(ws + WS_X); const float* DT = (const float*)(ws + WS_DT); float* CS = (float*)(ws + WS_CS);
    u16* Bc = (u16*)(ws + WS_BC); u16* Cc = (u16*)(ws + WS_CC); u16* XTG = (u16*)(ws + WS_H); u16* ST = (u16*)(ws + WS_ST);
    u16* BCT = (u16*)(ws + WS_BCT) + (size_t)item * 16384;
    const float* conv_w = p.in[I_CONVW]; const float* conv_b = p.in[I_CONVB];
    const int tid = threadIdx.x, lane = tid & 63, w = __builtin_amdgcn_readfirstlane(tid >> 6), fr = lane & 15, fq = lane >> 4;
    const int b = item >> 8, c = (item >> 2) & 63, g = item & 3, t0 = b * SEQ + c * 128, h = g * 8 + w;
    LAS u16* XT = (LAS u16*)(lds + w * SA_XT);
    LAS float* CSL = (LAS float*)(lds + SA_CS_OFF) + w * 128;
    LAS float* DTL = (LAS float*)(lds + SA_DT_OFF) + w * 128;
    { const float ah = -__expf(p.in[I_ALOG][h]); float carry = 0.f;
#pragma unroll
      for (int half = 0; half < 2; ++half) { const int l = lane + 64 * half; const float dtv = DT[(size_t)(t0 + l) * 32 + h]; float v = dtv * ah;
#pragma unroll
          for (int off = 1; off < 64; off <<= 1) { const float nb = __shfl_up(v, off); if (lane >= off) v += nb; }
          v += carry; carry = __shfl(v, 63);
          CSL[l] = v; DTL[l] = dtv; CS[((size_t)(b * 64 + c) * 32 + h) * 128 + l] = v; } }
    { const int cgx = tid & 31, l0 = (tid >> 5) * 8; const bool isC = cgx >= 16; const int n0 = (cgx & 15) * 8;
      const int col0 = 2048 + (isC ? 512 : 0) + g * 128 + n0;
      u32x4 raw[11];
#pragma unroll
      for (int k = 0; k < 11; ++k) { const int l = l0 - 3 + k; raw[k] = (u32x4){0u, 0u, 0u, 0u}; if (c * 128 + l >= 0) raw[k] = *(const u32x4*)(XBC + (size_t)((long)t0 + l) * 3072 + col0); }
      u16* op = (isC ? Cc : Bc) + (size_t)(t0 + l0) * 512 + g * 128 + n0;
#pragma unroll
      for (int jh = 0; jh < 2; ++jh) { float o[8][4]; conv_tile4(raw, jh, conv_w + col0, conv_b + col0, o);
#pragma unroll
          for (int i = 0; i < 8; ++i) { u32x2 wv; wv.x = cvt_pk_bf16(o[i][0], o[i][1]); wv.y = cvt_pk_bf16(o[i][2], o[i][3]); *(u32x2*)(op + (size_t)i * 512 + jh * 4) = wv; }
          if (!isC) {
#pragma unroll
              for (int j = 0; j < 4; ++j) { const float f[8] = {o[0][j], o[1][j], o[2][j], o[3][j], o[4][j], o[5][j], o[6][j], o[7][j]}; *(bf16x8*)(BCT + (size_t)(n0 + jh * 4 + j) * 128 + l0) = pack8(f); } } } }
    { const int p0 = (lane & 7) * 8, rg = lane >> 3, col0 = h * 64 + p0;
      u16* xtg = XTG + ((size_t)((b * 64 + c) * 32 + h) * 64) * 128;
      const float cs_end = CSL[127];
#pragma unroll 1
      for (int half = 0; half < 2; ++half) {
          const int l0 = half * 64 + rg * 8;
          u32x4 raw[11];
#pragma unroll
          for (int k = 0; k < 11; ++k) { const int l = l0 - 3 + k; raw[k] = (u32x4){0u, 0u, 0u, 0u}; if (c * 128 + l >= 0) raw[k] = *(const u32x4*)(XBC + (size_t)((long)t0 + l) * 3072 + col0); }
          float scl[8];
#pragma unroll
          for (int i = 0; i < 8; ++i) scl[i] = DTL[l0 + i] * __expf(cs_end - CSL[l0 + i]);
#pragma unroll
          for (int jh = 0; jh < 2; ++jh) { float o[8][4]; conv_tile4(raw, jh, conv_w + col0, conv_b + col0, o);
#pragma unroll
              for (int j = 0; j < 4; ++j) { const float f[8] = {o[0][j], o[1][j], o[2][j], o[3][j], o[4][j], o[5][j], o[6][j], o[7][j]};
                  *(bf16x8*)(xtg + (size_t)(p0 + jh * 4 + j) * 128 + l0) = pack8(f);
                  const float f2[8] = {f[0] * scl[0], f[1] * scl[1], f[2] * scl[2], f[3] * scl[3], f[4] * scl[4], f[5] * scl[5], f[6] * scl[6], f[7] * scl[7]};
                  *(LAS bf16x8*)(XT + (p0 + jh * 4 + j) * 136 + l0) = pack8(f2); } }
      } }
    __syncthreads();
    { f32x4 acc[4][8];
#pragma unroll
      for (int mt = 0; mt < 4; ++mt)
#pragma unroll
          for (int nt = 0; nt < 8; ++nt) acc[mt][nt] = (f32x4){0.f, 0.f, 0.f, 0.f};
#pragma unroll 1
      for (int kk = 0; kk < 4; ++kk) { bf16x8 xf[4];
#pragma unroll
          for (int mt = 0; mt < 4; ++mt) xf[mt] = *(const LAS bf16x8*)(XT + (mt * 16 + fr) * 136 + kk * 32 + fq * 8);
#pragma unroll
          for (int nt = 0; nt < 8; ++nt) { const bf16x8 bf = *(const bf16x8*)(BCT + (size_t)(nt * 16 + fr) * 128 + kk * 32 + fq * 8);
#pragma unroll
              for (int mt = 0; mt < 4; ++mt) acc[mt][nt] = MFMA16(bf, xf[mt], acc[mt][nt]); } }
      u16* sp = ST + ((size_t)((b * 64 + c) * 32 + h) * 64) * 128;
#pragma unroll
      for (int mt = 0; mt < 4; ++mt)
#pragma unroll
          for (int nt = 0; nt < 8; ++nt) { u32x2 wv; wv.x = cvt_pk_bf16(acc[mt][nt][0], acc[mt][nt][1]); wv.y = cvt_pk_bf16(acc[mt][nt][2], acc[mt][nt][3]);
              *(u32x2*)(sp + (mt * 16 + fr) * 128 + nt * 16 + fq * 4) = wv; }
    }
    __syncthreads();
}

#define SC_LBAR() do { asm volatile("s_waitcnt lgkmcnt(0)" ::: "memory"); __builtin_amdgcn_s_barrier(); asm volatile("" ::: "memory"); } while (0)
constexpr int SC_CBW = 8448, SC_ZY = 2304, SC_ZY_OFF = 8 * SC_CBW, SC_CS_OFF = SC_ZY_OFF + 8 * SC_ZY, SC_DT_OFF = SC_CS_OFF + 4096, SC_PV_OFF = SC_DT_OFF + 4096, SC_XT_OFF = SC_PV_OFF + 17408, SC_BYTES = SC_XT_OFF + 17408;
static_assert(SC_BYTES <= LDS_PHASE_BYTES, "ssd_c LDS");
__device__ __forceinline__ void ssd_c_item(const Params& p, LAS unsigned char* lds, int item) {
    unsigned char* ws = p.ws;
    const float* DT = (const float*)(ws + WS_DT); const float* CS = (const float*)(ws + WS_CS);
    const u16* Bc = (const u16*)(ws + WS_BC); const u16* Cc = (const u16*)(ws + WS_CC); const u16* XTG = (const u16*)(ws + WS_H); const u16* ST = (const u16*)(ws + WS_ST);
    const u16* Z = (const u16*)(ws + WS_Z); u16* YA = (u16*)(ws + WS_YA);
    const int tid = threadIdx.x, lane = tid & 63, w = __builtin_amdgcn_readfirstlane(tid >> 6), fr = lane & 15, fq = lane >> 4;
    const int b = item >> 8, c = (item >> 2) & 63, g = item & 3, t0 = b * SEQ + c * 128;
    const int mb = (w < 4) ? w : 11 - w;
    LAS float* CBW = (LAS float*)(lds + w * SC_CBW);
    LAS u16* ZY = (LAS u16*)(lds + SC_ZY_OFF + w * SC_ZY);
    LAS float* CSL = (LAS float*)(lds + SC_CS_OFF);
    LAS float* DTL = (LAS float*)(lds + SC_DT_OFF);
    LAS u16* PV = (LAS u16*)(lds + SC_PV_OFF);
    LAS u16* XS = (LAS u16*)(lds + SC_XT_OFF);
#pragma unroll
    for (int i = 0; i < 2; ++i) { const int idx = tid + 512 * i, hd = idx >> 7, l = idx & 127;
        CSL[idx] = CS[((size_t)(b * 64 + c) * 32 + g * 8 + hd) * 128 + l]; DTL[idx] = DT[(size_t)(t0 + l) * 32 + g * 8 + hd]; }
    const int la = 16 * mb + fr;
    bf16x8 afc[4];
#pragma unroll
    for (int kk = 0; kk < 4; ++kk) afc[kk] = *(const bf16x8*)(Cc + (size_t)(t0 + la) * 512 + g * 128 + kk * 32 + fq * 8);
    { LAS u16* BCL = (LAS u16*)(lds + SC_PV_OFF);
#pragma unroll
      for (int i = 0; i < 4; ++i) { const int q = tid + 512 * i, row = q >> 4, cc = q & 15;
          *(LAS u32x4*)(BCL + row * 136 + cc * 8) = *(const u32x4*)(Bc + (size_t)(t0 + row) * 512 + g * 128 + cc * 8); }
      __syncthreads();
#pragma unroll
      for (int st = 0; st < 8; ++st) { f32x4 acc = (f32x4){0.f, 0.f, 0.f, 0.f};
#pragma unroll
          for (int kk = 0; kk < 4; ++kk) { const bf16x8 bf = *(const LAS bf16x8*)(BCL + (st * 16 + fr) * 136 + kk * 32 + fq * 8); acc = MFMA16(afc[kk], bf, acc); }
#pragma unroll
          for (int j = 0; j < 4; ++j) CBW[(fq * 4 + j) * 132 + st * 16 + fr] = acc[j]; } }
    float ssq[4] = {0.f, 0.f, 0.f, 0.f};
    u32x4 rpv[2], rxs[2], rz[2];
    { const size_t hb = ((size_t)((b * 64 + c) * 32 + g * 8) * 64) * 128;
#pragma unroll
      for (int i = 0; i < 2; ++i) { const int q = tid + 512 * i, row = q >> 4, cc = q & 15; rpv[i] = *(const u32x4*)(ST + hb + row * 128 + cc * 8); rxs[i] = *(const u32x4*)(XTG + hb + row * 128 + cc * 8); }
#pragma unroll
      for (int i = 0; i < 2; ++i) { const int q = lane + 64 * i, row = q >> 3, cc = q & 7; rz[i] = *(const u32x4*)(Z + (size_t)(t0 + 16 * mb + row) * DM + g * 512 + cc * 8); } }
#pragma unroll 1
    for (int r = 0; r < 8; ++r) {
        const int h = g * 8 + r;
        const u16* xtg = XTG + ((size_t)((b * 64 + c) * 32 + h) * 64) * 128;
        const u16* pvg = ST + ((size_t)((b * 64 + c) * 32 + h) * 64) * 128;
        SC_LBAR();
#pragma unroll
        for (int i = 0; i < 2; ++i) { const int q = tid + 512 * i, row = q >> 4, cc = q & 15;
            *(LAS u32x4*)(PV + row * 136 + cc * 8) = rpv[i]; *(LAS u32x4*)(XS + row * 136 + cc * 8) = rxs[i]; }
#pragma unroll
        for (int i = 0; i < 2; ++i) { const int q = lane + 64 * i, row = q >> 3, cc = q & 7;
            *(LAS u32x4*)(ZY + row * 72 + cc * 8) = rz[i]; }
        SC_LBAR();
        if (r < 7) {
#pragma unroll
            for (int i = 0; i < 2; ++i) { const int q = tid + 512 * i, row = q >> 4, cc = q & 15;
                rpv[i] = *(const u32x4*)(pvg + 8192 + row * 128 + cc * 8); rxs[i] = *(const u32x4*)(xtg + 8192 + row * 128 + cc * 8); }
#pragma unroll
            for (int i = 0; i < 2; ++i) { const int q = lane + 64 * i, row = q >> 3, cc = q & 7;
                rz[i] = *(const u32x4*)(Z + (size_t)(t0 + 16 * mb + row) * DM + (h + 1) * 64 + cc * 8); }
        }
        const float csl = CSL[r * 128 + la], Dh = p.in[I_DSSD][h];
        f32x4 accd[4], acco[4];
#pragma unroll
        for (int pt = 0; pt < 4; ++pt) { accd[pt] = (f32x4){0.f, 0.f, 0.f, 0.f}; acco[pt] = (f32x4){0.f, 0.f, 0.f, 0.f}; }
#pragma unroll
        for (int kk = 0; kk < 4; ++kk) {
#pragma unroll
            for (int pt = 0; pt < 4; ++pt) { const bf16x8 pf = *(const LAS bf16x8*)(PV + (pt * 16 + fr) * 136 + kk * 32 + fq * 8); acco[pt] = MFMA16(afc[kk], pf, acco[pt]); }
            if (kk * 32 <= 16 * mb + 15) {
                const int s0 = kk * 32 + fq * 8; float mv[8];
#pragma unroll
                for (int i = 0; i < 8; ++i) { const int s = s0 + i; const float e = CBW[fr * 132 + s] * __expf(csl - CSL[r * 128 + s]) * DTL[r * 128 + s]; mv[i] = (s <= la) ? e : 0.f; }
                const bf16x8 afm = pack8(mv);
#pragma unroll
                for (int pt = 0; pt < 4; ++pt) { const bf16x8 xf = *(const LAS bf16x8*)(XS + (pt * 16 + fr) * 136 + kk * 32 + fq * 8); accd[pt] = MFMA16(afm, xf, accd[pt]); }
            }
        }
        float el[4];
#pragma unroll
        for (int j = 0; j < 4; ++j) el[j] = __expf(CSL[r * 128 + 16 * mb + fq * 4 + j]);
#pragma unroll
        for (int pt = 0; pt < 4; ++pt) {
            const u32x2 xr = *(const LAS u32x2*)(XS + (pt * 16 + fr) * 136 + 16 * mb + fq * 4);
            const float xv[4] = {bflo(xr.x), bfhi(xr.x), bflo(xr.y), bfhi(xr.y)};
#pragma unroll
            for (int j = 0; j < 4; ++j) { const float y = accd[pt][j] + el[j] * acco[pt][j] + Dh * xv[j];
                LAS u16* zp = ZY + (fq * 4 + j) * 72 + pt * 16 + fr;
                const float v = y * siluf_(bf2f(*zp)); ssq[j] += v * v; *zp = f2bf(v); }
        }
#pragma unroll
        for (int i = 0; i < 2; ++i) { const int q = lane + 64 * i, row = q >> 3, cc = q & 7;
            *(u32x4*)(YA + (size_t)(t0 + 16 * mb + row) * DM + h * 64 + cc * 8) = *(const LAS u32x4*)(ZY + row * 72 + cc * 8); }
    }
#pragma unroll
    for (int j = 0; j < 4; ++j) { float s = ssq[j]; s += __shfl_xor(s, 1); s += __shfl_xor(s, 2); s += __shfl_xor(s, 4); s += __shfl_xor(s, 8);
        if (fr == 0) CBW[fq * 4 + j] = rsqrtf(s * (1.f / 512.f) + 1e-6f); }
    const float* nw = p.in[I_SNW];
    asm volatile("s_waitcnt vmcnt(0)" ::: "memory");
    { u16* ybase = YA + (size_t)(t0 + 16 * mb) * DM + g * 512 + lane * 8;
      const f32x4 n0 = *(const f32x4*)(nw + g * 512 + lane * 8), n1 = *(const f32x4*)(nw + g * 512 + lane * 8 + 4);
#pragma unroll
      for (int hb = 0; hb < 2; ++hb) { u32x4 v[8];
#pragma unroll
          for (int i = 0; i < 8; ++i) v[i] = *(const u32x4*)(ybase + (size_t)(hb * 8 + i) * DM);
#pragma unroll
          for (int i = 0; i < 8; ++i) { const float rsv = CBW[hb * 8 + i];
              const float f[8] = {bflo(v[i].x) * rsv * n0.x, bfhi(v[i].x) * rsv * n0.y, bflo(v[i].y) * rsv * n0.z, bfhi(v[i].y) * rsv * n0.w, bflo(v[i].z) * rsv * n1.x, bfhi(v[i].z) * rsv * n1.y, bflo(v[i].w) * rsv * n1.z, bfhi(v[i].w) * rsv * n1.w};
              *(bf16x8*)(ybase + (size_t)(hb * 8 + i) * DM) = pack8(f); } } }
    __syncthreads();
}

template <bool OUT>
__device__ __forceinline__ void s5_item(const Params& p, LAS unsigned char* lds, int item) {
    unsigned char* ws = p.ws;
    const u16* U = (const u16*)(ws + WS_U); const u16* BBAR = (const u16*)(ws + WS_BBAR); const u16* CM = (const u16*)(ws + WS_CM);
    const f32x2* AV = (const f32x2*)(ws + WS_AV); f32x2* SEND = (f32x2*)(ws + WS_SEND); const f32x2* SINIT = (const f32x2*)(ws + WS_SINIT); u16* YB = (u16*)(ws + WS_YB);
    const int tid = threadIdx.x, lane = tid & 63, w = __builtin_amdgcn_readfirstlane(tid >> 6), fr = lane & 15, fq = lane >> 4;
    const int b = item >> 11, tc = (item >> 6) & 31, g = item & 63;
    LAS float* L = (LAS float*)(lds + w * 16896);
    LAS u16* OT = (LAS u16*)(lds + 8 * 16896 + w * 1024);
    const f32x2 a = AV[g * 64 + lane]; const float ar = a.x, ai = a.y;
    float sre = 0.f, sim = 0.f;
    if (OUT) { const f32x2 s0 = SINIT[((size_t)(b * 32 + tc) * 64 + g) * 64 + lane]; sre = s0.x; sim = s0.y; }
    const bf16x8 zero8 = (bf16x8){0, 0, 0, 0, 0, 0, 0, 0};
    bf16x8 bfr[8];
#pragma unroll
    for (int nt = 0; nt < 8; ++nt) { bfr[nt] = zero8; if (fq < 2) bfr[nt] = *(const bf16x8*)(BBAR + ((size_t)(g * 128 + nt * 16 + fr)) * 16 + fq * 8); }
    bf16x8 cfr[4], dfr = zero8;
    if (OUT) {
#pragma unroll
        for (int kk = 0; kk < 4; ++kk) cfr[kk] = *(const bf16x8*)(CM + ((size_t)(g * 16 + fr)) * 128 + kk * 32 + fq * 8);
        const unsigned dv = (unsigned)f2bf(p.in[I_S5D][g * 16 + fr]); const int kpos = fr - fq * 8; u32x4 dw = (u32x4){0u, 0u, 0u, 0u};
        if (kpos >= 0 && kpos < 8) { const unsigned word = (kpos & 1) ? (dv << 16) : dv; if ((kpos >> 1) == 0) dw.x = word; else if ((kpos >> 1) == 1) dw.y = word; else if ((kpos >> 1) == 2) dw.z = word; else dw.w = word; }
        dfr = __builtin_bit_cast(bf16x8, dw);
    }
    const size_t ubase = (size_t)(b * SEQ + tc * 256) * 1024 + g * 16 + (fq & 1) * 8;
    bf16x8 afn[2];
#pragma unroll
    for (int mt = 0; mt < 2; ++mt) { afn[mt] = zero8; if (fq < 2) afn[mt] = *(const bf16x8*)(U + ubase + (size_t)(mt * 16 + fr) * 1024); }
#pragma unroll 1
    for (int sb = 0; sb < 8; ++sb) {
        const int tok0 = b * SEQ + tc * 256 + sb * 32;
        bf16x8 af[2] = {afn[0], afn[1]};
        if (sb < 7) {
#pragma unroll
            for (int mt = 0; mt < 2; ++mt) if (fq < 2) afn[mt] = *(const bf16x8*)(U + ubase + (size_t)((sb + 1) * 32 + mt * 16 + fr) * 1024);
        }
#pragma unroll
        for (int mt = 0; mt < 2; ++mt) {
#pragma unroll
            for (int nt = 0; nt < 8; ++nt) { const f32x4 r = MFMA16(af[mt], bfr[nt], ((f32x4){0.f, 0.f, 0.f, 0.f}));
#pragma unroll
                for (int j = 0; j < 4; ++j) L[(mt * 16 + fq * 4 + j) * 132 + nt * 16 + fr] = r[j]; } }
#pragma unroll 8
        for (int t = 0; t < 32; ++t) { const float bre = L[t * 132 + lane], bim = L[t * 132 + 64 + lane];
            const float nre = ar * sre - ai * sim + bre, nim = ar * sim + ai * sre + bim; sre = nre; sim = nim;
            if (OUT) { L[t * 132 + lane] = sre; L[t * 132 + 64 + lane] = sim; } }
        if (OUT) {
#pragma unroll
            for (int mt = 0; mt < 2; ++mt) { f32x4 acc = MFMA16(af[mt], dfr, ((f32x4){0.f, 0.f, 0.f, 0.f}));
#pragma unroll
                for (int kk = 0; kk < 4; ++kk) { float f[8];
#pragma unroll
                    for (int i = 0; i < 8; ++i) f[i] = L[(mt * 16 + fr) * 132 + kk * 32 + fq * 8 + i];
                    acc = MFMA16(pack8(f), cfr[kk], acc); }
#pragma unroll
                for (int j = 0; j < 4; ++j) OT[(mt * 16 + fq * 4 + j) * 16 + fr] = f2bf(gelu_tanh(acc[j])); }
            *(u32x4*)(YB + (size_t)(tok0 + (lane >> 1)) * 1024 + g * 16 + (lane & 1) * 8) = *(const LAS u32x4*)(OT + lane * 8);
        }
    }
    if (!OUT) SEND[((size_t)(b * 32 + tc) * 64 + g) * 64 + lane] = (f32x2){sre, sim};
}

#define XB_TMO      128
#define XB_XCNT(j)  (256  + 64 * (j))
#define XB_XSUB(j)  (1280 + 64 * (j))
#define XB_XGEN(j)  (2304 + 64 * (j))
#define XB_TOP      3328
#define XB_TOPGEN   3392
#define XCD_BAR_WORDS 3456
#define XB_SPIN_CAP (1u << 23)
__device__ __forceinline__ unsigned xb_ld(unsigned* p)              { return __hip_atomic_load(p, __ATOMIC_RELAXED, __HIP_MEMORY_SCOPE_AGENT); }
__device__ __forceinline__ unsigned xb_add(unsigned* p, unsigned v) { return __hip_atomic_fetch_add(p, v, __ATOMIC_RELAXED, __HIP_MEMORY_SCOPE_AGENT); }
__device__ __forceinline__ unsigned xb_xcc_id() { return (unsigned)__builtin_amdgcn_s_getreg((3 << 11) | 20) & 0xFu; }
#define XB_SPIN(cond, bar) do { unsigned _sp = 0; while (cond) { __builtin_amdgcn_s_sleep(1); \
    if ((++_sp & 255u) == 0u) { if (xb_ld(&(bar)[XB_TMO])) break; if (_sp > XB_SPIN_CAP) { atomicAdd(&(bar)[XB_TMO], 1u); break; } } } } while (0)
struct XcdBarrier { unsigned* bar; unsigned x; volatile LAS unsigned* st; };
__device__ __forceinline__ XcdBarrier xcd_barrier_post(unsigned* bar, volatile LAS unsigned* st) {
    XcdBarrier b; b.bar = bar; b.x = xb_xcc_id(); b.st = st;
    if (threadIdx.x == 0) (void)xb_add(&bar[XB_XCNT(b.x)], 1u);
    return b;
}
__device__ __forceinline__ void xcd_barrier_complete(unsigned* bar, unsigned x, unsigned& nloc, unsigned& nx) {
    const unsigned G = gridDim.x * gridDim.y * gridDim.z;
    unsigned sum, cnt, mine, sp = 0u;
    for (;;) {
        sum = 0u; cnt = 0u; mine = 0u;
#pragma unroll
        for (unsigned j = 0; j < 16; ++j) { const unsigned c = xb_ld(&bar[XB_XCNT(j)]); sum += c; cnt += (c > 0u) ? 1u : 0u; mine = (j == x) ? c : mine; }
        if (sum == G) break;
        __builtin_amdgcn_s_sleep(1);
        if ((++sp & 255u) == 0u) { if (xb_ld(&bar[XB_TMO])) break; if (sp > XB_SPIN_CAP) { atomicAdd(&bar[XB_TMO], 1u); break; } }
    }
    nloc = mine > 0u ? mine : 1u; nx = cnt > 0u ? cnt : 1u;
}
__device__ __forceinline__ void xcd_barrier(const XcdBarrier& b) {
    asm volatile("s_waitcnt vmcnt(0)" ::: "memory");
    __syncthreads();
    if (threadIdx.x == 0) {
        unsigned* bar = b.bar;
        __builtin_amdgcn_s_waitcnt(0);
        unsigned nloc = b.st[0], nx = b.st[1];
        if (nloc == 0u) { xcd_barrier_complete(bar, b.x, nloc, nx); b.st[0] = nloc; b.st[1] = nx; }
        const unsigned old = xb_add(&bar[XB_XSUB(b.x)], 1u);
        const unsigned gen = old / nloc;
        if (old + 1u == (gen + 1u) * nloc) {
            __builtin_amdgcn_fence(__ATOMIC_RELEASE, "agent");
            asm volatile("s_waitcnt vmcnt(0)" ::: "memory");
            const unsigned og = xb_add(&bar[XB_TOP], 1u);
            const unsigned tg = og / nx;
            if (og + 1u == (tg + 1u) * nx) xb_add(&bar[XB_TOPGEN], 1u);
            else XB_SPIN(xb_ld(&bar[XB_TOPGEN]) == tg, bar);
            __builtin_amdgcn_fence(__ATOMIC_ACQUIRE, "agent");
            xb_add(&bar[XB_XGEN(b.x)], 1u);
            asm volatile("s_waitcnt vmcnt(0)" ::: "memory");
        } else {
            XB_SPIN(xb_ld(&bar[XB_XGEN(b.x)]) == gen, bar);
            __builtin_amdgcn_fence(__ATOMIC_ACQUIRE, "agent");
            asm volatile("s_waitcnt vmcnt(0)" ::: "memory");
        }
    }
    __syncthreads();
}

__global__ void __launch_bounds__(512, 2) mega(Params p) {
    extern __shared__ __attribute__((aligned(16))) unsigned char shm[];
    LAS unsigned char* lds = (LAS unsigned char*)shm;
    cg::grid_group grid = cg::this_grid();
    unsigned char* ws = p.ws;
    const int tid = threadIdx.x, G = gridDim.x, gtid = blockIdx.x * 512 + tid, nthr = G * 512;
    const int lo = p.ph_lo, hi = p.ph_hi;
    float* mods = (float*)(ws + WS_MODS);
    u16* H = (u16*)(ws + WS_H); u16* HID = (u16*)(ws + WS_HID);
#define IN(k) (lo <= (k) && (k) < hi)
    volatile LAS unsigned* xbst = (volatile LAS unsigned*)(lds + LDS_PHASE_BYTES);
    if (tid < 4) xbst[tid] = 0u;
    __syncthreads();
    XcdBarrier xbar = xcd_barrier_post((unsigned*)(ws + WS_BAR), xbst);
#define SYNC(k) do { if (IN(k) && IN((k) + 1)) xcd_barrier(xbar); } while (0)
#ifndef REP_MASK
#define REP_MASK 0
#endif
#define REP(k) for (int _rep = 0; _rep < (((REP_MASK >> (k)) & 1) ? 2 : 1); ++_rep)

    if (IN(0)) REP(0) {
        LAS float* scl = (LAS float*)lds;
        for (int i = tid; i < 4096; i += 512) scl[i] = siluf_(p.in[I_C][i]);
        __syncthreads();
        float* part = (float*)(ws + WS_PART); const float* wada = p.in[I_WADA];
        for (int it = gtid; it < 32 * 4608; it += nthr) { const int kc = it / 4608, cgp = it % 4608;
            f32x4 a0 = (f32x4){0.f, 0.f, 0.f, 0.f}, a1 = a0; const float* wp = wada + (size_t)(kc * 64) * NMOD + cgp * 4;
#pragma unroll 8
            for (int k = 0; k < 64; ++k) { const f32x4 wv = *(const f32x4*)(wp + (size_t)k * NMOD); a0 += wv * scl[kc * 64 + k]; a1 += wv * scl[2048 + kc * 64 + k]; }
            *(f32x4*)(part + (size_t)(kc * 2 + 0) * NMOD + cgp * 4) = a0; *(f32x4*)(part + (size_t)(kc * 2 + 1) * NMOD + cgp * 4) = a1; }
        u16* BBAR = (u16*)(ws + WS_BBAR); f32x2* AV = (f32x2*)(ws + WS_AV); f32x2* AL = (f32x2*)(ws + WS_AL);
        for (int i = gtid; i < 4096; i += nthr) { const int g = i >> 6;
            const float dt = expf(p.in[I_LOGDT][g]); const float lr = fminf(p.in[I_LRE][i], -1e-4f), li = p.in[I_LIM][i];
            const float mag = expf(lr * dt); const float ar = mag * cosf(li * dt), ai = mag * sinf(li * dt);
            const float den = lr * lr + li * li, nr = ar - 1.f; const float kr = (nr * lr + ai * li) / den, ki = (ai * lr - nr * li) / den;
            const int pp = i & 63;
#pragma unroll
            for (int ii = 0; ii < 16; ++ii) { const float br = p.in[I_BRE][(size_t)i * 16 + ii], bi = p.in[I_BIM][(size_t)i * 16 + ii];
                BBAR[((size_t)(g * 128 + pp)) * 16 + ii] = f2bf(kr * br - ki * bi); BBAR[((size_t)(g * 128 + 64 + pp)) * 16 + ii] = f2bf(kr * bi + ki * br); }
            AV[i] = (f32x2){ar, ai}; float xr = ar, xi = ai;
#pragma unroll
            for (int s = 0; s < 8; ++s) { const float t = xr * xr - xi * xi; xi = 2.f * xr * xi; xr = t; }
            AL[i] = (f32x2){xr, xi}; }
        u16* CM = (u16*)(ws + WS_CM);
        for (int i = gtid; i < 131072; i += nthr) { const int gi = i >> 7, q = i & 127; CM[i] = f2bf(q < 64 ? p.in[I_CRE][(size_t)gi * 64 + q] : -p.in[I_CIM][(size_t)gi * 64 + q - 64]); }
    }
    SYNC(0);
    if (IN(1)) REP(1) {
        const float* part = (const float*)(ws + WS_PART);
        for (int i = gtid; i < 2 * NMOD; i += nthr) { const int b = i / NMOD, j = i % NMOD; float s = p.in[I_BADA][j];
#pragma unroll 8
            for (int kc = 0; kc < 32; ++kc) s += part[(size_t)(kc * 2 + b) * NMOD + j];
            mods[i] = s; }
        int tb = 0; LAS float* T = (LAS float*)lds;
        conv_weight(T, p.in[I_W1IN], (u16*)(ws + WS_W1IN), 2048, 2 * FF, 2 * FF, 0, tb, true);
        conv_weight(T, p.in[I_W1OUT], (u16*)(ws + WS_W1OUT), FF, 2048, 2048, 1, tb);
        conv_weight(T, p.in[I_WIN], (u16*)(ws + WS_WIN), 2048, 10272, NPROJ_C, 2, tb);
        conv_weight(T, p.in[I_WA], (u16*)(ws + WS_WA), 2048, 2048, 2048, 1, tb);
        conv_weight(T, p.in[I_WB], (u16*)(ws + WS_WB), 1024, 4096, 4096, 3, tb);
        conv_weight(T, p.in[I_WO], (u16*)(ws + WS_WO), 2048, 2048, 2048, 1, tb);
    }
    SYNC(1);
    if (IN(2)) REP(2) norm_rows<0, true>(p.in[I_X], p.in[I_NF1], mods + 0 * DM, mods + 1 * DM, H, nullptr);
    SYNC(2);
    if (IN(3)) REP(3) { pg8::Gemm g{H, (const u16*)(ws + WS_W1IN), M_TOK, 2 * FF, 2048}; pg8::StaticOrder S; S.init(M_TOK, 2 * FF, G, blockIdx.x); EpiSwiglu E{HID}; pg8::gemm_phase<EpiSwiglu, true, true>(lds, g, S, E); }
    SYNC(3);
    if (IN(4)) REP(4) { pg8::Gemm g{HID, (const u16*)(ws + WS_W1OUT), M_TOK, 2048, FF}; pg8::StaticOrder S; S.init(M_TOK, 2048, G, blockIdx.x, true); EpiResid E{p.in[I_X], p.out, mods + 2 * DM, 0.5f}; pg8::gemm_phase(lds, g, S, E); }
    SYNC(4);
    if (IN(5)) REP(5) {
        norm_dt_rows(p.out, p.in[I_NMIX], mods + 3 * DM, mods + 4 * DM, H, (const u16*)(ws + WS_WIN) + (size_t)NPROJ_G * 2048, p.in[I_DTB], (float*)(ws + WS_DT));
        int tb = 0; LAS float* T = (LAS float*)lds;
        conv_weight(T, p.in[I_W2IN], (u16*)(ws + WS_W1IN), 2048, 2 * FF, 2 * FF, 0, tb, true);
        conv_weight(T, p.in[I_W2OUT], (u16*)(ws + WS_W1OUT), FF, 2048, 2048, 1, tb);
    }
    SYNC(5);
    if (IN(6)) REP(6) { pg8::Gemm g{H, (const u16*)(ws + WS_WIN), M_TOK, NPROJ_G, 2048}; pg8::StaticOrder S; S.init(M_TOK, NPROJ_G, G, blockIdx.x);
        EpiProj E{(u16*)(ws + WS_Z), (u16*)(ws + WS_X), (u16*)(ws + WS_U), (u16*)(ws + WS_G), (float*)(ws + WS_DT), p.in[I_DTB]}; pg8::gemm_phase(lds, g, S, E); }
    SYNC(6);
    if (IN(7)) REP(7) {
        __syncthreads();
        REP(17) for (int it = blockIdx.x; it < 512; it += G) ssd_a_item(p, lds, it);
        REP(18) for (int it = blockIdx.x * 8 + (tid >> 6); it < 4096; it += G * 8) s5_item<false>(p, lds, it);
    }
    SYNC(7);
    if (IN(8)) REP(8) {
        u16* ST = (u16*)(ws + WS_ST); const float* CS = (const float*)(ws + WS_CS);
        for (int idx = gtid; idx < 131072; idx += nthr) { const int n4 = idx & 31, pp = (idx >> 5) & 63, h = (idx >> 11) & 31, b = idx >> 16;
            float run[4] = {0.f, 0.f, 0.f, 0.f};
#pragma unroll 1
            for (int cb = 0; cb < 64; cb += 16) {
                u32x2 sv[16]; float cse[16];
#pragma unroll
                for (int i = 0; i < 16; ++i) { const size_t hc = (size_t)((b * 64 + cb + i) * 32 + h); sv[i] = *(const u32x2*)(ST + (hc * 64 + pp) * 128 + n4 * 4); cse[i] = CS[hc * 128 + 127]; }
                asm volatile("" ::: "memory");
#pragma unroll
                for (int i = 0; i < 16; ++i) { const size_t hc = (size_t)((b * 64 + cb + i) * 32 + h); const float dec = __expf(cse[i]);
                    u32x2 o; o.x = cvt_pk_bf16(run[0], run[1]); o.y = cvt_pk_bf16(run[2], run[3]); *(u32x2*)(ST + (hc * 64 + pp) * 128 + n4 * 4) = o;
                    run[0] = dec * run[0] + bflo(sv[i].x); run[1] = dec * run[1] + bfhi(sv[i].x); run[2] = dec * run[2] + bflo(sv[i].y); run[3] = dec * run[3] + bfhi(sv[i].y); }
                asm volatile("" ::: "memory");
            } }
        const f32x2* AL = (const f32x2*)(ws + WS_AL); const f32x2* SEND = (const f32x2*)(ws + WS_SEND); f32x2* SINIT = (f32x2*)(ws + WS_SINIT);
        for (int idx = gtid; idx < 8192; idx += nthr) { const int gp = idx & 4095, b = idx >> 12; const f32x2 a = AL[gp]; float sr = 0.f, si = 0.f;
            f32x2 ev[32];
#pragma unroll
            for (int tc = 0; tc < 32; ++tc) ev[tc] = SEND[(size_t)(b * 32 + tc) * 4096 + gp];
            asm volatile("" ::: "memory");
#pragma unroll
            for (int tc = 0; tc < 32; ++tc) { SINIT[(size_t)(b * 32 + tc) * 4096 + gp] = (f32x2){sr, si};
                const float nr = a.x * sr - a.y * si + ev[tc].x, ni = a.x * si + a.y * sr + ev[tc].y; sr = nr; si = ni; } }
    }
    SYNC(8);
    if (IN(9)) REP(9) {
        __syncthreads();
        REP(19) for (int it = blockIdx.x; it < 512; it += G) ssd_c_item(p, lds, it);
        REP(20) for (int it = blockIdx.x * 8 + (tid >> 6); it < 4096; it += G * 8) s5_item<true>(p, lds, it);
    }
    SYNC(9);
    if (IN(10)) REP(10) { pg8::Gemm g{(const u16*)(ws + WS_YB), (const u16*)(ws + WS_WB), M_TOK, 4096, 1024}; pg8::StaticOrder S; S.init(M_TOK, 4096, G, blockIdx.x); EpiGlu E{(u16*)(ws + WS_MB), (const u16*)(ws + WS_G)}; pg8::gemm_phase(lds, g, S, E); }
    SYNC(10);
    if (IN(11)) REP(11) { pg8::Gemm g{(const u16*)(ws + WS_YA), (const u16*)(ws + WS_WA), M_TOK, 2048, 2048}; pg8::StaticOrder S; S.init(M_TOK, 2048, G, blockIdx.x); EpiMerge E{H, (const u16*)(ws + WS_G), (const u16*)(ws + WS_MB)}; pg8::gemm_phase(lds, g, S, E); }
    SYNC(11);
    if (IN(12)) REP(12) { pg8::Gemm g{H, (const u16*)(ws + WS_WO), M_TOK, 2048, 2048}; pg8::StaticOrder S; S.init(M_TOK, 2048, G, blockIdx.x); EpiResid E{p.out, p.out, mods + 5 * DM, 1.0f}; pg8::gemm_phase(lds, g, S, E); }
    SYNC(12);
    if (IN(13)) REP(13) norm_rows<0>(p.out, p.in[I_NF2], mods + 6 * DM, mods + 7 * DM, H, nullptr);
    SYNC(13);
    if (IN(14)) REP(14) { pg8::Gemm g{H, (const u16*)(ws + WS_W1IN), M_TOK, 2 * FF, 2048}; pg8::StaticOrder S; S.init(M_TOK, 2 * FF, G, blockIdx.x); EpiSwiglu E{HID}; pg8::gemm_phase<EpiSwiglu, false, true>(lds, g, S, E); }
    SYNC(14);
    if (IN(15)) REP(15) { pg8::Gemm g{HID, (const u16*)(ws + WS_W1OUT), M_TOK, 2048, FF}; pg8::StaticOrder S; S.init(M_TOK, 2048, G, blockIdx.x, true); EpiResid E{p.out, p.out, mods + 8 * DM, 0.5f}; pg8::gemm_phase(lds, g, S, E); }
    SYNC(15);
    if (IN(16)) REP(16) norm_rows<1>(p.out, p.in[I_NFIN], nullptr, nullptr, nullptr, p.out);
    if (hi > NPH) grid.sync();
#undef IN
#undef SYNC
}

#ifndef MK_SPLIT
#define MK_SPLIT 0
#endif
extern "C" void kernel_launch(void* const* d_in, const int* in_sizes, int n_in, void* d_out, int out_size, void* d_ws, size_t ws_size, hipStream_t stream) {
    static int grid = 0;
    if (grid == 0) {
        if (n_in != 30 || ws_size < WS_END) { fprintf(stderr, "kernel_launch: n_in %d ws %zu (need %zu)\n", n_in, ws_size, (size_t)WS_END); grid = -1; return; }
        int dev = 0, cus = 0, per_cu = 0;
        (void)hipGetDevice(&dev); (void)hipDeviceGetAttribute(&cus, hipDeviceAttributeMultiprocessorCount, dev);
        (void)hipFuncSetAttribute((const void*)mega, hipFuncAttributeMaxDynamicSharedMemorySize, LDS_BYTES);
        (void)hipOccupancyMaxActiveBlocksPerMultiprocessor(&per_cu, (const void*)mega, 512, LDS_BYTES);
        if (per_cu < 1) per_cu = 1;
        grid = cus * per_cu; if (grid > 256) grid = 256;
    }
    if (grid < 0) return;
    Params p{};
    for (int i = 0; i < 30; ++i) p.in[i] = (const float*)d_in[i];
    p.out = (float*)d_out; p.ws = (unsigned char*)d_ws;
    (void)hipMemsetAsync((unsigned char*)d_ws + WS_BAR, 0, 16384, stream);
#if MK_SPLIT
    for (int ph = 0; ph < NPH; ++ph) { p.ph_lo = ph; p.ph_hi = ph + 1; void* args[] = {&p};
        (void)hipLaunchCooperativeKernel((void*)mega, dim3(grid), dim3(512), args, LDS_BYTES, stream); }
#else
    p.ph_lo = 0; p.ph_hi = NPH; void* args[] = {&p};
    hipError_t e = hipLaunchCooperativeKernel((void*)mega, dim3(grid), dim3(512), args, LDS_BYTES, stream);
    if (e != hipSuccess) fprintf(stderr, "cooperative launch failed: %s (grid %d)\n", hipGetErrorString(e), grid);
#endif
}
```

```cpp
#include <hip/hip_runtime.h>
#include <hip/hip_cooperative_groups.h>
#include <cstdio>
#define REP_MASK 0
namespace cg = cooperative_groups;

#define LAS __attribute__((address_space(3)))
typedef unsigned short u16;
typedef short bf16x8 __attribute__((ext_vector_type(8)));
typedef float f32x4 __attribute__((ext_vector_type(4)));
typedef float f32x2 __attribute__((ext_vector_type(2)));
typedef unsigned u32x4 __attribute__((ext_vector_type(4)));
typedef unsigned u32x2 __attribute__((ext_vector_type(2)));

constexpr int M_TOK = 16384, DM = 2048, FF = 5504, SEQ = 8192;
constexpr int NPROJ = 10496;
constexpr int NPROJ_G = 10240, NPROJ_C = 10304;
constexpr int NMOD = 18432;
constexpr int LDS_PHASE_BYTES = 147456;
constexpr int LDS_BYTES = LDS_PHASE_BYTES + 16;
constexpr int NPH = 17;

constexpr size_t WS_W1IN = 0;
constexpr size_t WS_W1OUT = WS_W1IN + (size_t)11008 * 2048 * 2;
constexpr size_t WS_WIN = WS_W1OUT + (size_t)2048 * 5504 * 2;
constexpr size_t WS_WA = WS_WIN + (size_t)NPROJ * 2048 * 2;
constexpr size_t WS_WB = WS_WA + (size_t)2048 * 2048 * 2;
constexpr size_t WS_WO = WS_WB + (size_t)4096 * 1024 * 2;
constexpr size_t WS_H = WS_WO + (size_t)2048 * 2048 * 2;
constexpr size_t WS_HID = WS_H + (size_t)M_TOK * 2048 * 2;
constexpr size_t WS_X = WS_HID + (size_t)M_TOK * FF * 2;
constexpr size_t WS_G = WS_X + (size_t)M_TOK * 3072 * 2;
constexpr size_t WS_MISC = WS_G + (size_t)M_TOK * 4096 * 2;
constexpr size_t WS_Z = WS_HID;
constexpr size_t WS_U = WS_Z + (size_t)M_TOK * 2048 * 2;
constexpr size_t WS_DT = WS_U + (size_t)M_TOK * 1024 * 2;
constexpr size_t WS_CS = WS_DT + (size_t)M_TOK * 32 * 4;
constexpr size_t WS_ST = WS_CS + (size_t)M_TOK * 32 * 4;
constexpr size_t WS_MB = WS_ST;
static_assert(WS_ST + (size_t)M_TOK * 2048 * 2 <= WS_X, "mixer buffers overflow HID");
constexpr size_t WS_BC = WS_WIN;
constexpr size_t WS_CC = WS_BC + (size_t)M_TOK * 512 * 2;
constexpr size_t WS_YA = WS_X;
constexpr size_t WS_YB = WS_YA + (size_t)M_TOK * 2048 * 2;
constexpr size_t WS_PART = WS_MISC;
constexpr size_t WS_MODS = WS_PART + (size_t)32 * 2 * NMOD * 4;
constexpr size_t WS_BBAR = WS_MODS + (size_t)2 * NMOD * 4;
constexpr size_t WS_CM = WS_BBAR + (size_t)64 * 128 * 16 * 2;
constexpr size_t WS_AV = WS_CM + (size_t)64 * 16 * 128 * 2;
constexpr size_t WS_AL = WS_AV + (size_t)4096 * 8;
constexpr size_t WS_SEND = WS_AL + (size_t)4096 * 8;
constexpr size_t WS_SINIT = WS_SEND + (size_t)2 * 32 * 4096 * 8;
constexpr size_t WS_BAR = WS_SINIT + (size_t)2 * 32 * 4096 * 8;
constexpr size_t WS_BCT = WS_BAR + 16384;
constexpr size_t WS_END = WS_BCT + (size_t)512 * 16384 * 2;

struct Params {
    const float* in[30];
    float* out; unsigned char* ws; int ph_lo, ph_hi;
};
enum { I_X = 0, I_C, I_WADA, I_BADA, I_NF1, I_W1IN, I_W1OUT, I_NMIX, I_WIN, I_CONVW, I_CONVB, I_DTB, I_ALOG, I_DSSD, I_SNW, I_WA,
       I_LRE, I_LIM, I_BRE, I_BIM, I_CRE, I_CIM, I_S5D, I_LOGDT, I_WB, I_WO, I_NF2, I_W2IN, I_W2OUT, I_NFIN };

__device__ __forceinline__ unsigned cvt_pk_bf16(float lo, float hi) { unsigned r; asm volatile("v_cvt_pk_bf16_f32 %0, %1, %2" : "=v"(r) : "v"(lo), "v"(hi)); return r; }
__device__ __forceinline__ u16 f2bf(float f) { return (u16)(cvt_pk_bf16(f, 0.f) & 0xffffu); }
__device__ __forceinline__ float bf2f(u16 b) { return __uint_as_float(((unsigned)b) << 16); }
__device__ __forceinline__ float bflo(unsigned w) { return __uint_as_float(w << 16); }
__device__ __forceinline__ float bfhi(unsigned w) { return __uint_as_float(w & 0xffff0000u); }
__device__ __forceinline__ float sigmoidf_(float v) { return __builtin_amdgcn_rcpf(1.f + __expf(-v)); }
__device__ __forceinline__ float siluf_(float v) { return v * sigmoidf_(v); }
__device__ __forceinline__ float gelu_tanh(float v) { const float z = 0.7978845608028654f * (v + 0.044715f * v * v * v); const float t = 1.f - 2.f * __builtin_amdgcn_rcpf(__expf(2.f * z) + 1.f); return 0.5f * v * (1.f + t); }
__device__ __forceinline__ bf16x8 pack8(const float* f) { u32x4 w; w.x = cvt_pk_bf16(f[0], f[1]); w.y = cvt_pk_bf16(f[2], f[3]); w.z = cvt_pk_bf16(f[4], f[5]); w.w = cvt_pk_bf16(f[6], f[7]); return __builtin_bit_cast(bf16x8, w); }
#define MFMA16(a, b, c) __builtin_amdgcn_mfma_f32_16x16x32_bf16((a), (b), (c), 0, 0, 0)

namespace pg8 {
constexpr int BM = 256, BK = 64, HALF = 128, HTB = HALF * BK * 2, STAGE_BYTES = 8 * HTB, NXCD = 8, WGM = 8;
__device__ __forceinline__ int lds_byte(int r, int c) { const int st = (r >> 4) * 2 + (c >> 5), rr = r & 15, cc = c & 31, ob = rr * 64 + cc * 2; return st * 1024 + (ob ^ (((ob >> 9) & 1) << 5)); }
__device__ __forceinline__ void stage_rc(int b, int& R, int& C) { const int st = b / 1024, sb = b % 1024, swz = sb ^ (((sb >> 9) & 1) << 5); R = (st >> 1) * 16 + swz / 64; C = (st & 1) * 32 + (swz % 64) / 2; }
__device__ __forceinline__ int perm32(int rho) { const int n = rho >> 4, i = rho & 15; return 8 * (i >> 2) + 4 * n + (i & 3); }
struct Unit { int pm, pn; };
struct Gemm { const u16* A; const u16* Bt; int M, N, K; };
struct StaticOrder {
    int nM, nN, nwg, G, c; bool pnfast;
    __device__ void init(int M, int N, int G_, int c_, bool pf = false) { nM = M / BM; nN = N / BM; nwg = nM * nN; G = G_; c = c_; pnfast = pf; }
    __device__ bool next(int i, Unit& u) const {
        const long L = (long)i * G + c; if (L >= nwg) return false;
        int wgid = (int)L; { const int q = nwg / NXCD, r = nwg % NXCD, xcd = wgid % NXCD, off = wgid / NXCD; wgid = (xcd < r ? xcd * (q + 1) : r * (q + 1) + (xcd - r) * q) + off; }
        const int nig = WGM * nN, gid = wgid / nig, fm = gid * WGM, gsz = (nM - fm) < WGM ? (nM - fm) : WGM;
        if (pnfast) { u.pm = fm + (wgid % nig) / nN; u.pn = (wgid % nig) % nN; } else { u.pm = fm + ((wgid % nig) % gsz); u.pn = (wgid % nig) / gsz; }
        return true;
    }
};

template <class Epi, bool TA = false, bool TB = false>
__device__ __forceinline__ void gemm_phase(LAS unsigned char* lds, const Gemm g, const StaticOrder& S, const Epi& E) {
    const int tid = threadIdx.x, wid = __builtin_amdgcn_readfirstlane(tid >> 6), lane = tid & 63, wr = wid >> 2, wc = wid & 3, fr = lane & 15, fq = lane >> 4;
    const int K = g.K, nt = K / BK;
    unsigned voffA[2], voffB[2];
#pragma unroll
    for (int i = 0; i < 2; ++i) { int R, C; stage_rc(tid * 16 + i * 8192, R, C); const int Rb = Epi::PERM ? ((R & ~31) + perm32(R & 31)) : R;
        voffA[i] = (unsigned)(R * (TA ? BK : K) + C) * 2u; voffB[i] = (unsigned)(Rb * (TB ? BK : K) + C) * 2u; }
    const size_t kstepA = TA ? (size_t)HTB : (size_t)(BK * 2), kstepB = TB ? (size_t)HTB : (size_t)(BK * 2);
    const size_t hstepA = TA ? (size_t)nt * HTB : (size_t)HALF * K * 2, hstepB = TB ? (size_t)nt * HTB : (size_t)HALF * K * 2;
    const size_t tstep = (size_t)BM * K * 2;
    const unsigned ldsw = (unsigned)wid * 1024u;
    const int aoff = lds_byte(wr * 64 + fr, fq * 8), boff = lds_byte(wc * 32 + fr, fq * 8);
#define PG8_SA(b, h) (((b) * 2 + (h)) * HTB)
#define PG8_SB(b, h) ((4 + (b) * 2 + (h)) * HTB)
#define PG8_STAGE(bufoff, gbase, voff) do { _Pragma("unroll") for (int _i = 0; _i < 2; ++_i) \
        __builtin_amdgcn_global_load_lds((const unsigned*)((const char*)(gbase) + (voff)[_i]), (LAS unsigned*)(lds + (bufoff) + ldsw + _i * 8192), 16, 0, 0); } while (0)
#define PG8_LDA(dst, b, h) do { _Pragma("unroll") for (int m = 0; m < 4; ++m) _Pragma("unroll") for (int k = 0; k < 2; ++k) dst[m][k] = *(const LAS bf16x8*)(lds + PG8_SA(b, h) + aoff + m * 2048 + k * 1024); } while (0)
#define PG8_LDB(dst, b, h) do { _Pragma("unroll") for (int n = 0; n < 2; ++n) _Pragma("unroll") for (int k = 0; k < 2; ++k) dst[n][k] = *(const LAS bf16x8*)(lds + PG8_SB(b, h) + boff + n * 2048 + k * 1024); } while (0)
#define PG8_MMA(ai, bj, At, Bt) do { __builtin_amdgcn_s_setprio(1); _Pragma("unroll") for (int m = 0; m < 4; ++m) _Pragma("unroll") for (int n = 0; n < 2; ++n) _Pragma("unroll") for (int k = 0; k < 2; ++k) \
        acc[ai][bj][m][n] = __builtin_amdgcn_mfma_f32_16x16x32_bf16(Bt[n][k], At[m][k], acc[ai][bj][m][n], 0, 0, 0); __builtin_amdgcn_s_setprio(0); } while (0)
#define PG8_WAIT_V(n) asm volatile("s_waitcnt vmcnt(" #n ")" ::: "memory")
#define PG8_WAIT_L(n) asm volatile("s_waitcnt lgkmcnt(" #n ")" ::: "memory")
#define PG8_BAR __builtin_amdgcn_s_barrier()
#define PG8_SCHED __builtin_amdgcn_sched_barrier(0)
    Unit cur, nxt; int ui = 0;
    if (!S.next(0, cur)) return;
    f32x4 acc[2][2][4][2];
#pragma unroll
    for (int a = 0; a < 2; ++a)
#pragma unroll
        for (int b = 0; b < 2; ++b)
#pragma unroll
            for (int m = 0; m < 4; ++m)
#pragma unroll
                for (int n = 0; n < 2; ++n) acc[a][b][m][n] = (f32x4){0.f, 0.f, 0.f, 0.f};
    bf16x8 At[4][2], B0[2][2], B1[2][2];
    const char* cA = (const char*)g.A + (size_t)cur.pm * tstep; const char* cB = (const char*)g.Bt + (size_t)cur.pn * tstep;
    PG8_STAGE(PG8_SB(0, 0), cB, voffB); PG8_STAGE(PG8_SA(0, 0), cA, voffA); PG8_STAGE(PG8_SB(0, 1), cB + hstepB, voffB); PG8_STAGE(PG8_SA(0, 1), cA + hstepA, voffA);
    if (wr == 1) PG8_BAR;
    PG8_WAIT_V(4); PG8_BAR;
    PG8_STAGE(PG8_SB(1, 0), cB + kstepB, voffB); PG8_STAGE(PG8_SA(1, 0), cA + kstepA, voffA); PG8_STAGE(PG8_SB(1, 1), cB + hstepB + kstepB, voffB);
    PG8_WAIT_V(6); PG8_BAR;
    for (;;) {
        const bool has_next = S.next(ui + 1, nxt);
        const char* nA = has_next ? (const char*)g.A + (size_t)nxt.pm * tstep : cA; const char* nB = has_next ? (const char*)g.Bt + (size_t)nxt.pn * tstep : cB;
        for (int t = 0; t < nt; t += 2) {
            const bool last = (t == nt - 2);
            const char* a1 = cA + (size_t)(t + 1) * kstepA;
            const char* a2 = last ? nA : cA + (size_t)(t + 2) * kstepA; const char* b2 = last ? nB : cB + (size_t)(t + 2) * kstepB;
            const char* a3 = a2 + kstepA; const char* b3 = b2 + kstepB;
            PG8_LDB(B0, 0, 0); PG8_SCHED; PG8_LDA(At, 0, 0); PG8_STAGE(PG8_SA(1, 1), a1 + hstepA, voffA);
            PG8_WAIT_L(8); PG8_BAR; PG8_WAIT_L(0); PG8_MMA(0, 0, At, B0); PG8_BAR; PG8_SCHED;
            PG8_LDB(B1, 0, 1); PG8_STAGE(PG8_SB(0, 0), b2, voffB);
            PG8_BAR; PG8_WAIT_L(0); PG8_MMA(0, 1, At, B1); PG8_BAR;
            PG8_LDA(At, 0, 1); PG8_STAGE(PG8_SA(0, 0), a2, voffA);
            PG8_BAR; PG8_WAIT_L(0); PG8_MMA(1, 0, At, B0); PG8_BAR; PG8_SCHED;
            PG8_STAGE(PG8_SB(0, 1), b2 + hstepB, voffB);
            PG8_WAIT_V(6); PG8_BAR; PG8_MMA(1, 1, At, B1); PG8_BAR;
            PG8_LDB(B0, 1, 0); PG8_SCHED; PG8_LDA(At, 1, 0); PG8_STAGE(PG8_SA(0, 1), a2 + hstepA, voffA);
            PG8_WAIT_L(8); PG8_BAR; PG8_WAIT_L(0); PG8_MMA(0, 0, At, B0); PG8_BAR; PG8_SCHED;
            PG8_LDB(B1, 1, 1); PG8_STAGE(PG8_SB(1, 0), b3, voffB);
            PG8_BAR; PG8_WAIT_L(0); PG8_MMA(0, 1, At, B1); PG8_BAR;
            PG8_LDA(At, 1, 1); PG8_STAGE(PG8_SA(1, 0), a3, voffA);
            PG8_BAR; PG8_WAIT_L(0); PG8_MMA(1, 0, At, B0); PG8_BAR; PG8_SCHED;
            PG8_STAGE(PG8_SB(1, 1), b3 + hstepB, voffB);
            PG8_WAIT_V(6); PG8_BAR; PG8_MMA(1, 1, At, B1); PG8_BAR;
        }
        E(acc, cur, wr, wc, fr, fq);
        if (!has_next) break;
#pragma unroll
        for (int a = 0; a < 2; ++a)
#pragma unroll
            for (int b = 0; b < 2; ++b)
#pragma unroll
                for (int m = 0; m < 4; ++m)
#pragma unroll
                    for (int n = 0; n < 2; ++n) acc[a][b][m][n] = (f32x4){0.f, 0.f, 0.f, 0.f};
        cur = nxt; cA = nA; cB = nB; ++ui;
    }
    PG8_WAIT_V(0);
    if (wr == 0) PG8_BAR;
    PG8_BAR;
#undef PG8_SA
#undef PG8_SB
#undef PG8_STAGE
#undef PG8_LDA
#undef PG8_LDB
#undef PG8_MMA
#undef PG8_WAIT_V
#undef PG8_WAIT_L
#undef PG8_BAR
#undef PG8_SCHED
}
}

struct EpiSwiglu {
    static constexpr bool PERM = true;
    u16* O;
    __device__ __forceinline__ void operator()(const f32x4 (&acc)[2][2][4][2], const pg8::Unit& u, int wr, int wc, int fr, int fq) const {
        const int row0 = u.pm * 256 + wr * 64 + fr, col0 = u.pn * 128 + wc * 32 + 8 * fq;
#pragma unroll
        for (int ai = 0; ai < 2; ++ai)
#pragma unroll
            for (int m = 0; m < 4; ++m) {
                float v[8];
#pragma unroll
                for (int n = 0; n < 2; ++n)
#pragma unroll
                    for (int j = 0; j < 4; ++j) v[n * 4 + j] = siluf_(acc[ai][0][m][n][j]) * acc[ai][1][m][n][j];
                *(bf16x8*)(O + (size_t)(row0 + ai * 128 + m * 16) * FF + col0) = pack8(v);
            }
    }
};
struct EpiResid {
    static constexpr bool PERM = false;
    const float* xin; float* xout; const float* gate; float scale;
    __device__ __forceinline__ void operator()(const f32x4 (&acc)[2][2][4][2], const pg8::Unit& u, int wr, int wc, int fr, int fq) const {
        const int row0 = u.pm * 256 + wr * 64 + fr, col0 = u.pn * 256 + wc * 32 + 4 * fq;
        const float* gp = gate + (u.pm >= 32 ? NMOD : 0) + col0;
        f32x4 gv[2][2];
#pragma unroll
        for (int bj = 0; bj < 2; ++bj)
#pragma unroll
            for (int n = 0; n < 2; ++n) gv[bj][n] = *(const f32x4*)(gp + bj * 128 + n * 16) * scale;
#pragma unroll
        for (int ai = 0; ai < 2; ++ai) {
            f32x4 xi[4][2][2];
#pragma unroll
            for (int m = 0; m < 4; ++m)
#pragma unroll
                for (int bj = 0; bj < 2; ++bj)
#pragma unroll
                    for (int n = 0; n < 2; ++n) xi[m][bj][n] = *(const f32x4*)(xin + (size_t)(row0 + ai * 128 + m * 16) * DM + col0 + bj * 128 + n * 16);
#pragma unroll
            for (int m = 0; m < 4; ++m)
#pragma unroll
                for (int bj = 0; bj < 2; ++bj)
#pragma unroll
                    for (int n = 0; n < 2; ++n) *(f32x4*)(xout + (size_t)(row0 + ai * 128 + m * 16) * DM + col0 + bj * 128 + n * 16) = xi[m][bj][n] + gv[bj][n] * acc[ai][bj][m][n];
        }
    }
};
struct EpiProj {
    static constexpr bool PERM = true;
    u16* Z; u16* XBC; u16* U; u16* G; float* DT; const float* dt_bias;
    __device__ __forceinline__ void operator()(const f32x4 (&acc)[2][2][4][2], const pg8::Unit& u, int wr, int wc, int fr, int fq) const {
        const int row0 = u.pm * 256 + wr * 64 + fr, pn = u.pn;
        if (pn == 40) {
            if (wc == 0) {
#pragma unroll
                for (int ai = 0; ai < 2; ++ai)
#pragma unroll
                    for (int m = 0; m < 4; ++m) {
#pragma unroll
                        for (int n = 0; n < 2; ++n) { f32x4 o;
#pragma unroll
                            for (int j = 0; j < 4; ++j) { const float v = acc[ai][0][m][n][j] + dt_bias[8 * fq + 4 * n + j]; o[j] = v > 20.f ? v : log1pf(__expf(v)); }
                            *(f32x4*)(DT + (size_t)(row0 + ai * 128 + m * 16) * 32 + 8 * fq + 4 * n) = o; }
                    }
            }
            return;
        }
        u16* base; int ld, colt; bool sg = false;
        if (pn < 8) { base = Z; ld = 2048; colt = pn * 256; }
        else if (pn < 20) { base = XBC; ld = 3072; colt = (pn - 8) * 256; }
        else if (pn < 24) { base = U; ld = 1024; colt = (pn - 20) * 256; }
        else { base = G; ld = 4096; colt = (pn - 24) * 256; sg = true; }
        const int col0 = colt + wc * 32 + 8 * fq;
#pragma unroll
        for (int ai = 0; ai < 2; ++ai)
#pragma unroll
            for (int m = 0; m < 4; ++m)
#pragma unroll
                for (int bj = 0; bj < 2; ++bj) {
                    float v[8];
#pragma unroll
                    for (int n = 0; n < 2; ++n)
#pragma unroll
                        for (int j = 0; j < 4; ++j) { const float a = acc[ai][bj][m][n][j]; v[n * 4 + j] = sg ? sigmoidf_(a) : a; }
                    *(bf16x8*)(base + (size_t)(row0 + ai * 128 + m * 16) * ld + col0 + bj * 128) = pack8(v);
                }
    }
};
struct EpiGlu {
    static constexpr bool PERM = true;
    u16* O; const u16* G;
    __device__ __forceinline__ void operator()(const f32x4 (&acc)[2][2][4][2], const pg8::Unit& u, int wr, int wc, int fr, int fq) const {
        const int row0 = u.pm * 256 + wr * 64 + fr, col0 = u.pn * 128 + wc * 32 + 8 * fq;
        u32x4 gw[2][4];
#pragma unroll
        for (int ai = 0; ai < 2; ++ai)
#pragma unroll
            for (int m = 0; m < 4; ++m) gw[ai][m] = *(const u32x4*)(G + (size_t)(row0 + ai * 128 + m * 16) * 4096 + 2048 + col0);
#pragma unroll
        for (int ai = 0; ai < 2; ++ai)
#pragma unroll
            for (int m = 0; m < 4; ++m) {
                const size_t row = (size_t)(row0 + ai * 128 + m * 16);
                const u32x4 g4 = gw[ai][m];
                const float gb[8] = {bflo(g4.x), bfhi(g4.x), bflo(g4.y), bfhi(g4.y), bflo(g4.z), bfhi(g4.z), bflo(g4.w), bfhi(g4.w)};
                float v[8];
#pragma unroll
                for (int n = 0; n < 2; ++n)
#pragma unroll
                    for (int j = 0; j < 4; ++j) v[n * 4 + j] = gb[n * 4 + j] * acc[ai][0][m][n][j] * sigmoidf_(acc[ai][1][m][n][j]);
                *(bf16x8*)(O + row * DM + col0) = pack8(v);
            }
    }
};
struct EpiMerge {
    static constexpr bool PERM = true;
    u16* O; const u16* G; const u16* MB;
    __device__ __forceinline__ void operator()(const f32x4 (&acc)[2][2][4][2], const pg8::Unit& u, int wr, int wc, int fr, int fq) const {
        const int row0 = u.pm * 256 + wr * 64 + fr, col0 = u.pn * 256 + wc * 32 + 8 * fq;
#pragma unroll
        for (int ai = 0; ai < 2; ++ai) {
            u32x4 gw[4][2], mw[4][2];
#pragma unroll
            for (int m = 0; m < 4; ++m)
#pragma unroll
                for (int bj = 0; bj < 2; ++bj) { const size_t row = (size_t)(row0 + ai * 128 + m * 16); const int col = col0 + bj * 128;
                    gw[m][bj] = *(const u32x4*)(G + row * 4096 + col); mw[m][bj] = *(const u32x4*)(MB + row * DM + col); }
#pragma unroll
            for (int m = 0; m < 4; ++m)
#pragma unroll
                for (int bj = 0; bj < 2; ++bj) {
                    const size_t row = (size_t)(row0 + ai * 128 + m * 16); const int col = col0 + bj * 128;
                    const u32x4 g4 = gw[m][bj], m4 = mw[m][bj];
                    const float ga[8] = {bflo(g4.x), bfhi(g4.x), bflo(g4.y), bfhi(g4.y), bflo(g4.z), bfhi(g4.z), bflo(g4.w), bfhi(g4.w)};
                    const float mb[8] = {bflo(m4.x), bfhi(m4.x), bflo(m4.y), bfhi(m4.y), bflo(m4.z), bfhi(m4.z), bflo(m4.w), bfhi(m4.w)};
                    float v[8];
#pragma unroll
                    for (int n = 0; n < 2; ++n)
#pragma unroll
                        for (int j = 0; j < 4; ++j) v[n * 4 + j] = ga[n * 4 + j] * acc[ai][bj][m][n][j] + mb[n * 4 + j];
                    *(bf16x8*)(O + row * DM + col) = pack8(v);
                }
        }
    }
};

__device__ __forceinline__ size_t tiled_off(int row, int col, int K) { return ((size_t)(row >> 7) * (K >> 6) + (col >> 6)) * 8192 + (size_t)(row & 127) * 64 + (col & 63); }

__device__ __forceinline__ int map_col(int wsel, int n) {
    if (wsel == 0) return ((n >> 7) & 1) * FF + (n >> 8) * 128 + (n & 127);
    if (wsel == 3) return ((n >> 7) & 1) * 2048 + (n >> 8) * 128 + (n & 127);
    if (wsel == 2) { if (n < 5120) return n; if (n < 6144) return 5152 + (n - 5120); if (n < 10240) return 6176 + (n - 6144); if (n < 10272) return 5120 + (n - 10240); return -1; }
    return n;
}
__device__ __forceinline__ void conv_weight(LAS float* T, const float* __restrict__ src, u16* __restrict__ dst, int K, int ld, int ndst, int wsel, int& tbase, bool tiled = false) {
    const int nnt = ndst / 64, ntiles = (K / 128) * nnt, tid = threadIdx.x, G = gridDim.x;
    const int first = (((int)blockIdx.x - tbase) % G + G) % G;
    const int c4 = tid & 15, r = tid >> 4, kg = tid >> 5, nl = tid & 31;
    f32x4 v[4];
#define CW_LOAD(t_) do { const int n0_ = ((t_) % nnt) * 64, k0_ = ((t_) / nnt) * 128; const int sc_ = map_col(wsel, n0_ + c4 * 4); \
        _Pragma("unroll") for (int ps = 0; ps < 4; ++ps) { v[ps] = (f32x4){0.f, 0.f, 0.f, 0.f}; if (sc_ >= 0) v[ps] = __builtin_nontemporal_load((const f32x4*)(src + (size_t)(k0_ + r + ps * 32) * ld + sc_)); } } while (0)
#define CW_LBAR() do { asm volatile("s_waitcnt lgkmcnt(0)" ::: "memory"); __builtin_amdgcn_s_barrier(); asm volatile("" ::: "memory"); } while (0)
    if (first < ntiles) CW_LOAD(first);
    for (int t = first; t < ntiles; t += G) {
        const int n0 = (t % nnt) * 64, k0 = (t / nnt) * 128;
#pragma unroll
        for (int ps = 0; ps < 4; ++ps) { LAS float* tp = T + (r + ps * 32) * 65 + c4 * 4; tp[0] = v[ps].x; tp[1] = v[ps].y; tp[2] = v[ps].z; tp[3] = v[ps].w; }
        if (t + G < ntiles) CW_LOAD(t + G);
        CW_LBAR();
#pragma unroll
        for (int ps = 0; ps < 2; ++ps) { const int n = nl + ps * 32; float f[8];
#pragma unroll
            for (int j = 0; j < 8; ++j) f[j] = T[(kg * 8 + j) * 65 + n];
            *(bf16x8*)(dst + (tiled ? tiled_off(n0 + n, k0 + kg * 8, K) : (size_t)(n0 + n) * K + k0 + kg * 8)) = pack8(f); }
        CW_LBAR();
    }
#undef CW_LOAD
#undef CW_LBAR
    tbase += ntiles;
}

template <int MODE, bool TILED = false>
__device__ __forceinline__ void norm_rows(const float* src, const float* __restrict__ gw, const float* __restrict__ sh, const float* __restrict__ sc, u16* dst, float* fdst) {
    const int lane = threadIdx.x & 63, wg = blockIdx.x * 8 + (threadIdx.x >> 6), nw = gridDim.x * 8;
    for (int rp = wg; rp < M_TOK / 2; rp += nw) {
        f32x4 v[2][8]; float ss[2] = {0.f, 0.f};
#pragma unroll
        for (int q = 0; q < 2; ++q)
#pragma unroll
            for (int i = 0; i < 8; ++i) v[q][i] = *(const f32x4*)(src + (size_t)(rp * 2 + q) * DM + i * 256 + lane * 4);
#pragma unroll
        for (int q = 0; q < 2; ++q) {
#pragma unroll
            for (int i = 0; i < 8; ++i) ss[q] += v[q][i].x * v[q][i].x + v[q][i].y * v[q][i].y + v[q][i].z * v[q][i].z + v[q][i].w * v[q][i].w;
#pragma unroll
            for (int off = 32; off >= 1; off >>= 1) ss[q] += __shfl_xor(ss[q], off); }
#pragma unroll
        for (int q = 0; q < 2; ++q) { const int row = rp * 2 + q, bo = (row >> 13) * NMOD; const float rstd = rsqrtf(ss[q] * (1.f / 2048.f) + 1e-6f);
#pragma unroll
            for (int i = 0; i < 8; ++i) { const int col = i * 256 + lane * 4; const f32x4 g4 = *(const f32x4*)(gw + col);
                if (MODE == 0) { const f32x4 s4 = *(const f32x4*)(sc + bo + col), h4 = *(const f32x4*)(sh + bo + col);
                    const f32x4 o = v[q][i] * rstd * g4 * (s4 + 1.f) + h4;
                    u32x2 w; w.x = cvt_pk_bf16(o.x, o.y); w.y = cvt_pk_bf16(o.z, o.w); *(u32x2*)(dst + (TILED ? tiled_off(row, col, DM) : (size_t)row * DM + col)) = w; }
                else { *(f32x4*)(fdst + (size_t)row * DM + col) = v[q][i] * rstd * g4; } } }
    }
}

__device__ __forceinline__ void norm_dt_rows(const float* src, const float* __restrict__ gw, const float* __restrict__ sh, const float* __restrict__ sc, u16* dst,
                                             const u16* __restrict__ wdt  , const float* __restrict__ dt_bias, float* DT) {
    const int lane = threadIdx.x & 63, wg = blockIdx.x * 8 + (threadIdx.x >> 6), nw = gridDim.x * 8, fr = lane & 15, fq = lane >> 4;
    for (int rb = wg; rb < M_TOK / 8; rb += nw) {
        const int row0 = rb * 8, bo = (row0 >> 13) * NMOD;
#pragma unroll 1
        for (int i8 = 0; i8 < 8; i8 += 2) {
            f32x4 v[2][8]; float ss[2] = {0.f, 0.f};
#pragma unroll
            for (int q = 0; q < 2; ++q)
#pragma unroll
                for (int i = 0; i < 8; ++i) v[q][i] = *(const f32x4*)(src + (size_t)(row0 + i8 + q) * DM + i * 256 + lane * 4);
#pragma unroll
            for (int q = 0; q < 2; ++q) {
#pragma unroll
                for (int i = 0; i < 8; ++i) ss[q] += v[q][i].x * v[q][i].x + v[q][i].y * v[q][i].y + v[q][i].z * v[q][i].z + v[q][i].w * v[q][i].w;
#pragma unroll
                for (int off = 32; off >= 1; off >>= 1) ss[q] += __shfl_xor(ss[q], off); }
#pragma unroll
            for (int q = 0; q < 2; ++q) { const int row = row0 + i8 + q; const float rstd = rsqrtf(ss[q] * (1.f / 2048.f) + 1e-6f);
#pragma unroll
                for (int i = 0; i < 8; ++i) { const int col = i * 256 + lane * 4; const f32x4 g4 = *(const f32x4*)(gw + col), s4 = *(const f32x4*)(sc + bo + col), h4 = *(const f32x4*)(sh + bo + col);
                    const f32x4 o = v[q][i] * rstd * g4 * (s4 + 1.f) + h4;
                    u32x2 wv; wv.x = cvt_pk_bf16(o.x, o.y); wv.y = cvt_pk_bf16(o.z, o.w); *(u32x2*)(dst + (size_t)row * DM + col) = wv; } } }
        f32x4 a0 = (f32x4){0.f, 0.f, 0.f, 0.f}, a1 = a0;
        const u16* ap = dst + (size_t)(row0 + (fr & 7)) * DM + fq * 8; const u16* bp = wdt + (size_t)fr * 2048 + fq * 8;
        asm volatile("s_waitcnt vmcnt(0)" ::: "memory");
#pragma unroll 8
        for (int ks = 0; ks < 64; ++ks) { const bf16x8 a = *(const bf16x8*)(ap + ks * 32), b0 = *(const bf16x8*)(bp + ks * 32), b1 = *(const bf16x8*)(bp + 16 * 2048 + ks * 32);
            a0 = MFMA16(a, b0, a0); a1 = MFMA16(a, b1, a1); }
        if (fq < 2) {
#pragma unroll
            for (int j = 0; j < 4; ++j) { const float v0 = a0[j] + dt_bias[fr], v1 = a1[j] + dt_bias[16 + fr]; float* dp = DT + (size_t)(row0 + fq * 4 + j) * 32;
                dp[fr] = v0 > 20.f ? v0 : log1pf(__expf(v0)); dp[16 + fr] = v1 > 20.f ? v1 : log1pf(__expf(v1)); } }
    }
}

__device__ __forceinline__ void conv_tile4(const u32x4 (&raw)[11], const int jh, const float* __restrict__ cw, const float* __restrict__ cbp, float (&o)[8][4]) {
    const f32x4 w0 = *(const f32x4*)(cw + jh * 4), w1 = *(const f32x4*)(cw + 3072 + jh * 4), w2 = *(const f32x4*)(cw + 6144 + jh * 4), w3 = *(const f32x4*)(cw + 9216 + jh * 4), bb = *(const f32x4*)(cbp + jh * 4);
    f32x4 xr[11];
#pragma unroll
    for (int k = 0; k < 11; ++k) { const unsigned a = jh ? raw[k].z : raw[k].x, b2 = jh ? raw[k].w : raw[k].y; xr[k] = (f32x4){bflo(a), bfhi(a), bflo(b2), bfhi(b2)}; }
#pragma unroll
    for (int i = 0; i < 8; ++i) { const f32x4 v = bb + w0 * xr[i] + w1 * xr[i + 1] + w2 * xr[i + 2] + w3 * xr[i + 3];
#pragma unroll
        for (int jj = 0; jj < 4; ++jj) o[i][jj] = siluf_(v[jj]); }
}
constexpr int SA_XT = 17408, SA_CS_OFF = 8 * SA_XT, SA_DT_OFF = SA_CS_OFF + 4096, SA_BYTES = SA_DT_OFF + 4096;
__device__ __forceinline__ void ssd_a_item(const Params& p, LAS unsigned char* lds, int item) {
    unsigned char* ws = p.ws;
    const u16* XBC = (const u16*)(ws + WS_X); const float* DT = (const float*)(ws + WS_DT); float* CS = (float*)(ws + WS_CS);
    u16* Bc = (u16*)(ws + WS_BC); u16* Cc = (u16*)(ws + WS_CC); u16* XTG = (u16*)(ws + WS_H); u16* ST = (u16*)(ws + WS_ST);
    u16* BCT = (u16*)(ws + WS_BCT) + (size_t)item * 16384;
    const float* conv_w = p.in[I_CONVW]; const float* conv_b = p.in[I_CONVB];
    const int tid = threadIdx.x, lane = tid & 63, w = __builtin_amdgcn_readfirstlane(tid >> 6), fr = lane & 15, fq = lane >> 4;
    const int b = item >> 8, c = (item >> 2) & 63, g = item & 3, t0 = b * SEQ + c * 128, h = g * 8 + w;
    LAS u16* XT = (LAS u16*)(lds + w * SA_XT);
    LAS float* CSL = (LAS float*)(lds + SA_CS_OFF) + w * 128;
    LAS float* DTL = (LAS float*)(lds + SA_DT_OFF) + w * 128;
    { const float ah = -__expf(p.in[I_ALOG][h]); float carry = 0.f;
#pragma unroll
      for (int half = 0; half < 2; ++half) { const int l = lane + 64 * half; const float dtv = DT[(size_t)(t0 + l) * 32 + h]; float v = dtv * ah;
#pragma unroll
          for (int off = 1; off < 64; off <<= 1) { const float nb = __shfl_up(v, off); if (lane >= off) v += nb; }
          v += carry; carry = __shfl(v, 63);
          CSL[l] = v; DTL[l] = dtv; CS[((size_t)(b * 64 + c) * 32 + h) * 128 + l] = v; } }
    { const int cgx = tid & 31, l0 = (tid >> 5) * 8; const bool isC = cgx >= 16; const int n0 = (cgx & 15) * 8;
      const int col0 = 2048 + (isC ? 512 : 0) + g * 128 + n0;
      u32x4 raw[11];
#pragma unroll
      for (int k = 0; k < 11; ++k) { const int l = l0 - 3 + k; raw[k] = (u32x4){0u, 0u, 0u, 0u}; if (c * 128 + l >= 0) raw[k] = *(const u32x4*)(XBC + (size_t)((long)t0 + l) * 3072 + col0); }
      u16* op = (isC ? Cc : Bc) + (size_t)(t0 + l0) * 512 + g * 128 + n0;
#pragma unroll
      for (int jh = 0; jh < 2; ++jh) { float o[8][4]; conv_tile4(raw, jh, conv_w + col0, conv_b + col0, o);
#pragma unroll
          for (int i = 0; i < 8; ++i) { u32x2 wv; wv.x = cvt_pk_bf16(o[i][0], o[i][1]); wv.y = cvt_pk_bf16(o[i][2], o[i][3]); *(u32x2*)(op + (size_t)i * 512 + jh * 4) = wv; }
          if (!isC) {
#pragma unroll
              for (int j = 0; j < 4; ++j) { const float f[8] = {o[0][j], o[1][j], o[2][j], o[3][j], o[4][j], o[5][j], o[6][j], o[7][j]}; *(bf16x8*)(BCT + (size_t)(n0 + jh * 4 + j) * 128 + l0) = pack8(f); } } } }
    { const int p0 = (lane & 7) * 8, rg = lane >> 3, col0 = h * 64 + p0;
      u16* xtg = XTG + ((size_t)((b * 64 + c) * 32 + h) * 64) * 128;
      const float cs_end = CSL[127];
#pragma unroll 1
      for (int half = 0; half < 2; ++half) {
          const int l0 = half * 64 + rg * 8;
          u32x4 raw[11];
#pragma unroll
          for (int k = 0; k < 11; ++k) { const int l = l0 - 3 + k; raw[k] = (u32x4){0u, 0u, 0u, 0u}; if (c * 128 + l >= 0) raw[k] = *(const u32x4*)(XBC + (size_t)((long)t0 + l) * 3072 + col0); }
          float scl[8];
#pragma unroll
          for (int i = 0; i < 8; ++i) scl[i] = DTL[l0 + i] * __expf(cs_end - CSL[l0 + i]);
#pragma unroll
          for (int jh = 0; jh < 2; ++jh) { float o[8][4]; conv_tile4(raw, jh, conv_w + col0, conv_b + col0, o);
#pragma unroll
              for (int j = 0; j < 4; ++j) { const float f[8] = {o[0][j], o[1][j], o[2][j], o[3][j], o[4][j], o[5][j], o[6][j], o[7][j]};
                  *(bf16x8*)(xtg + (size_t)(p0 + jh * 4 + j) * 128 + l0) = pack8(f);
                  const float f2[8] = {f[0] * scl[0], f[1] * scl[1], f[2] * scl[2], f[3] * scl[3], f[4] * scl[4], f[5] * scl[5], f[6] * scl[6], f[7] * scl[7]};
                  *(LAS bf16x8*)(XT + (p0 + jh * 4 + j) * 136 + l0) = pack8(f2); } }
      } }
    __syncthreads();
    { f32x4 acc[4][8];
#pragma unroll
      for (int mt = 0; mt < 4; ++mt)
#pragma unroll
          for (int nt = 0; nt < 8; ++nt) acc[mt][nt] = (f32x4){0.f, 0.f, 0.f, 0.f};
#pragma unroll 1
      for (int kk = 0; kk < 4; ++kk) { bf16x8 xf[4];
#pragma unroll
          for (int mt = 0; mt < 4; ++mt) xf[mt] = *(const LAS bf16x8*)(XT + (mt * 16 + fr) * 136 + kk * 32 + fq * 8);
#pragma unroll
          for (int nt = 0; nt < 8; ++nt) { const bf16x8 bf = *(const bf16x8*)(BCT + (size_t)(nt * 16 + fr) * 128 + kk * 32 + fq * 8);
#pragma unroll
              for (int mt = 0; mt < 4; ++mt) acc[mt][nt] = MFMA16(bf, xf[mt], acc[mt][nt]); } }
      u16* sp = ST + ((size_t)((b * 64 + c) * 32 + h) * 64) * 128;
#pragma unroll
      for (int mt = 0; mt < 4; ++mt)
#pragma unroll
          for (int nt = 0; nt < 8; ++nt) { u32x2 wv; wv.x = cvt_pk_bf16(acc[mt][nt][0], acc[mt][nt][1]); wv.y = cvt_pk_bf16(acc[mt][nt][2], acc[mt][nt][3]);
              *(u32x2*)(sp + (mt * 16 + fr) * 128 + nt * 16 + fq * 4) = wv; }
    }
    __syncthreads();
}

#define SC_LBAR() do { asm volatile("s_waitcnt lgkmcnt(0)" ::: "memory"); __builtin_amdgcn_s_barrier(); asm volatile("" ::: "memory"); } while (0)
constexpr int SC_CBW = 8448, SC_ZY = 2304, SC_ZY_OFF = 8 * SC_CBW, SC_CS_OFF = SC_ZY_OFF + 8 * SC_ZY, SC_DT_OFF = SC_CS_OFF + 4096, SC_PV_OFF = SC_DT_OFF + 4096, SC_XT_OFF = SC_PV_OFF + 17408, SC_BYTES = SC_XT_OFF + 17408;
static_assert(SC_BYTES <= LDS_PHASE_BYTES, "ssd_c LDS");
__device__ __forceinline__ void ssd_c_item(const Params& p, LAS unsigned char* lds, int item) {
    unsigned char* ws = p.ws;
    const float* DT = (const float*)(ws + WS_DT); const float* CS = (const float*)(ws + WS_CS);
    const u16* Bc = (const u16*)(ws + WS_BC); const u16* Cc = (const u16*)(ws + WS_CC); const u16* XTG = (const u16*)(ws + WS_H); const u16* ST = (const u16*)(ws + WS_ST);
    const u16* Z = (const u16*)(ws + WS_Z); u16* YA = (u16*)(ws + WS_YA);
    const int tid = threadIdx.x, lane = tid & 63, w = __builtin_amdgcn_readfirstlane(tid >> 6), fr = lane & 15, fq = lane >> 4;
    const int b = item >> 8, c = (item >> 2) & 63, g = item & 3, t0 = b * SEQ + c * 128;
    const int mb = (w < 4) ? w : 11 - w;
    LAS float* CBW = (LAS float*)(lds + w * SC_CBW);
    LAS u16* ZY = (LAS u16*)(lds + SC_ZY_OFF + w * SC_ZY);
    LAS float* CSL = (LAS float*)(lds + SC_CS_OFF);
    LAS float* DTL = (LAS float*)(lds + SC_DT_OFF);
    LAS u16* PV = (LAS u16*)(lds + SC_PV_OFF);
    LAS u16* XS = (LAS u16*)(lds + SC_XT_OFF);
#pragma unroll
    for (int i = 0; i < 2; ++i) { const int idx = tid + 512 * i, hd = idx >> 7, l = idx & 127;
        CSL[idx] = CS[((size_t)(b * 64 + c) * 32 + g * 8 + hd) * 128 + l]; DTL[idx] = DT[(size_t)(t0 + l) * 32 + g * 8 + hd]; }
    const int la = 16 * mb + fr;
    bf16x8 afc[4];
#pragma unroll
    for (int kk = 0; kk < 4; ++kk) afc[kk] = *(const bf16x8*)(Cc + (size_t)(t0 + la) * 512 + g * 128 + kk * 32 + fq * 8);
    { LAS u16* BCL = (LAS u16*)(lds + SC_PV_OFF);
#pragma unroll
      for (int i = 0; i < 4; ++i) { const int q = tid + 512 * i, row = q >> 4, cc = q & 15;
          *(LAS u32x4*)(BCL + row * 136 + cc * 8) = *(const u32x4*)(Bc + (size_t)(t0 + row) * 512 + g * 128 + cc * 8); }
      __syncthreads();
#pragma unroll
      for (int st = 0; st < 8; ++st) { f32x4 acc = (f32x4){0.f, 0.f, 0.f, 0.f};
#pragma unroll
          for (int kk = 0; kk < 4; ++kk) { const bf16x8 bf = *(const LAS bf16x8*)(BCL + (st * 16 + fr) * 136 + kk * 32 + fq * 8); acc = MFMA16(afc[kk], bf, acc); }
#pragma unroll
          for (int j = 0; j < 4; ++j) CBW[(fq * 4 + j) * 132 + st * 16 + fr] = acc[j]; } }
    float ssq[4] = {0.f, 0.f, 0.f, 0.f};
    u32x4 rpv[2], rxs[2], rz[2];
    { const size_t hb = ((size_t)((b * 64 + c) * 32 + g * 8) * 64) * 128;
#pragma unroll
      for (int i = 0; i < 2; ++i) { const int q = tid + 512 * i, row = q >> 4, cc = q & 15; rpv[i] = *(const u32x4*)(ST + hb + row * 128 + cc * 8); rxs[i] = *(const u32x4*)(XTG + hb + row * 128 + cc * 8); }
#pragma unroll
      for (int i = 0; i < 2; ++i) { const int q = lane + 64 * i, row = q >> 3, cc = q & 7; rz[i] = *(const u32x4*)(Z + (size_t)(t0 + 16 * mb + row) * DM + g * 512 + cc * 8); } }
#pragma unroll 1
    for (int r = 0; r < 8; ++r) {
        const int h = g * 8 + r;
        const u16* xtg = XTG + ((size_t)((b * 64 + c) * 32 + h) * 64) * 128;
        const u16* pvg = ST + ((size_t)((b * 64 + c) * 32 + h) * 64) * 128;
        SC_LBAR();
#pragma unroll
        for (int i = 0; i < 2; ++i) { const int q = tid + 512 * i, row = q >> 4, cc = q & 15;
            *(LAS u32x4*)(PV + row * 136 + cc * 8) = rpv[i]; *(LAS u32x4*)(XS + row * 136 + cc * 8) = rxs[i]; }
#pragma unroll
        for (int i = 0; i < 2; ++i) { const int q = lane + 64 * i, row = q >> 3, cc = q & 7;
            *(LAS u32x4*)(ZY + row * 72 + cc * 8) = rz[i]; }
        SC_LBAR();
        if (r < 7) {
#pragma unroll
            for (int i = 0; i < 2; ++i) { const int q = tid + 512 * i, row = q >> 4, cc = q & 15;
                rpv[i] = *(const u32x4*)(pvg + 8192 + row * 128 + cc * 8); rxs[i] = *(const u32x4*)(xtg + 8192 + row * 128 + cc * 8); }
#pragma unroll
            for (int i = 0; i < 2; ++i) { const int q = lane + 64 * i, row = q >> 3, cc = q & 7;
                rz[i] = *(const u32x4*)(Z + (size_t)(t0 + 16 * mb + row) * DM + (h + 1) * 64 + cc * 8); }
        }
        const float csl = CSL[r * 128 + la], Dh = p.in[I_DSSD][h];
        f32x4 accd[4], acco[4];
#pragma unroll
        for (int pt = 0; pt < 4; ++pt) { accd[pt] = (f32x4){0.f, 0.f, 0.f, 0.f}; acco[pt] = (f32x4){0.f, 0.f, 0.f, 0.f}; }
#pragma unroll
        for (int kk = 0; kk < 4; ++kk) {
#pragma unroll
            for (int pt = 0; pt < 4; ++pt) { const bf16x8 pf = *(const LAS bf16x8*)(PV + (pt * 16 + fr) * 136 + kk * 32 + fq * 8); acco[pt] = MFMA16(afc[kk], pf, acco[pt]); }
            if (kk * 32 <= 16 * mb + 15) {
                const int s0 = kk * 32 + fq * 8; float mv[8];
#pragma unroll
                for (int i = 0; i < 8; ++i) { const int s = s0 + i; const float e = CBW[fr * 132 + s] * __expf(csl - CSL[r * 128 + s]) * DTL[r * 128 + s]; mv[i] = (s <= la) ? e : 0.f; }
                const bf16x8 afm = pack8(mv);
#pragma unroll
                for (int pt = 0; pt < 4; ++pt) { const bf16x8 xf = *(const LAS bf16x8*)(XS + (pt * 16 + fr) * 136 + kk * 32 + fq * 8); accd[pt] = MFMA16(afm, xf, accd[pt]); }
            }
        }
        float el[4];
#pragma unroll
        for (int j = 0; j < 4; ++j) el[j] = __expf(CSL[r * 128 + 16 * mb + fq * 4 + j]);
#pragma unroll
        for (int pt = 0; pt < 4; ++pt) {
            const u32x2 xr = *(const LAS u32x2*)(XS + (pt * 16 + fr) * 136 + 16 * mb + fq * 4);
            const float xv[4] = {bflo(xr.x), bfhi(xr.x), bflo(xr.y), bfhi(xr.y)};
#pragma unroll
            for (int j = 0; j < 4; ++j) { const float y = accd[pt][j] + el[j] * acco[pt][j] + Dh * xv[j];
                LAS u16* zp = ZY + (fq * 4 + j) * 72 + pt * 16 + fr;
                const float v = y * siluf_(bf2f(*zp)); ssq[j] += v * v; *zp = f2bf(v); }
        }
#pragma unroll
        for (int i = 0; i < 2; ++i) { const int q = lane + 64 * i, row = q >> 3, cc = q & 7;
            *(u32x4*)(YA + (size_t)(t0 + 16 * mb + row) * DM + h * 64 + cc * 8) = *(const LAS u32x4*)(ZY + row * 72 + cc * 8); }
    }
#pragma unroll
    for (int j = 0; j < 4; ++j) { float s = ssq[j]; s += __shfl_xor(s, 1); s += __shfl_xor(s, 2); s += __shfl_xor(s, 4); s += __shfl_xor(s, 8);
        if (fr == 0) CBW[fq * 4 + j] = rsqrtf(s * (1.f / 512.f) + 1e-6f); }
    const float* nw = p.in[I_SNW];
    asm volatile("s_waitcnt vmcnt(0)" ::: "memory");
    { u16* ybase = YA + (size_t)(t0 + 16 * mb) * DM + g * 512 + lane * 8;
      const f32x4 n0 = *(const f32x4*)(nw + g * 512 + lane * 8), n1 = *(const f32x4*)(nw + g * 512 + lane * 8 + 4);
#pragma unroll
      for (int hb = 0; hb < 2; ++hb) { u32x4 v[8];
#pragma unroll
          for (int i = 0; i < 8; ++i) v[i] = *(const u32x4*)(ybase + (size_t)(hb * 8 + i) * DM);
#pragma unroll
          for (int i = 0; i < 8; ++i) { const float rsv = CBW[hb * 8 + i];
              const float f[8] = {bflo(v[i].x) * rsv * n0.x, bfhi(v[i].x) * rsv * n0.y, bflo(v[i].y) * rsv * n0.z, bfhi(v[i].y) * rsv * n0.w, bflo(v[i].z) * rsv * n1.x, bfhi(v[i].z) * rsv * n1.y, bflo(v[i].w) * rsv * n1.z, bfhi(v[i].w) * rsv * n1.w};
              *(bf16x8*)(ybase + (size_t)(hb * 8 + i) * DM) = pack8(f); } } }
    __syncthreads();
}

template <bool OUT>
__device__ __forceinline__ void s5_item(const Params& p, LAS unsigned char* lds, int item) {
    unsigned char* ws = p.ws;
    const u16* U = (const u16*)(ws + WS_U); const u16* BBAR = (const u16*)(ws + WS_BBAR); const u16* CM = (const u16*)(ws + WS_CM);
    const f32x2* AV = (const f32x2*)(ws + WS_AV); f32x2* SEND = (f32x2*)(ws + WS_SEND); const f32x2* SINIT = (const f32x2*)(ws + WS_SINIT); u16* YB = (u16*)(ws + WS_YB);
    const int tid = threadIdx.x, lane = tid & 63, w = __builtin_amdgcn_readfirstlane(tid >> 6), fr = lane & 15, fq = lane >> 4;
    const int b = item >> 11, tc = (item >> 6) & 31, g = item & 63;
    LAS float* L = (LAS float*)(lds + w * 16896);
    LAS u16* OT = (LAS u16*)(lds + 8 * 16896 + w * 1024);
    const f32x2 a = AV[g * 64 + lane]; const float ar = a.x, ai = a.y;
    float sre = 0.f, sim = 0.f;
    if (OUT) { const f32x2 s0 = SINIT[((size_t)(b * 32 + tc) * 64 + g) * 64 + lane]; sre = s0.x; sim = s0.y; }
    const bf16x8 zero8 = (bf16x8){0, 0, 0, 0, 0, 0, 0, 0};
    bf16x8 bfr[8];
#pragma unroll
    for (int nt = 0; nt < 8; ++nt) { bfr[nt] = zero8; if (fq < 2) bfr[nt] = *(const bf16x8*)(BBAR + ((size_t)(g * 128 + nt * 16 + fr)) * 16 + fq * 8); }
    bf16x8 cfr[4], dfr = zero8;
    if (OUT) {
#pragma unroll
        for (int kk = 0; kk < 4; ++kk) cfr[kk] = *(const bf16x8*)(CM + ((size_t)(g * 16 + fr)) * 128 + kk * 32 + fq * 8);
        const unsigned dv = (unsigned)f2bf(p.in[I_S5D][g * 16 + fr]); const int kpos = fr - fq * 8; u32x4 dw = (u32x4){0u, 0u, 0u, 0u};
        if (kpos >= 0 && kpos < 8) { const unsigned word = (kpos & 1) ? (dv << 16) : dv; if ((kpos >> 1) == 0) dw.x = word; else if ((kpos >> 1) == 1) dw.y = word; else if ((kpos >> 1) == 2) dw.z = word; else dw.w = word; }
        dfr = __builtin_bit_cast(bf16x8, dw);
    }
    const size_t ubase = (size_t)(b * SEQ + tc * 256) * 1024 + g * 16 + (fq & 1) * 8;
    bf16x8 afn[2];
#pragma unroll
    for (int mt = 0; mt < 2; ++mt) { afn[mt] = zero8; if (fq < 2) afn[mt] = *(const bf16x8*)(U + ubase + (size_t)(mt * 16 + fr) * 1024); }
#pragma unroll 1
    for (int sb = 0; sb < 8; ++sb) {
        const int tok0 = b * SEQ + tc * 256 + sb * 32;
        bf16x8 af[2] = {afn[0], afn[1]};
        if (sb < 7) {
#pragma unroll
            for (int mt = 0; mt < 2; ++mt) if (fq < 2) afn[mt] = *(const bf16x8*)(U + ubase + (size_t)((sb + 1) * 32 + mt * 16 + fr) * 1024);
        }
#pragma unroll
        for (int mt = 0; mt < 2; ++mt) {
#pragma unroll
            for (int nt = 0; nt < 8; ++nt) { const f32x4 r = MFMA16(af[mt], bfr[nt], ((f32x4){0.f, 0.f, 0.f, 0.f}));
#pragma unroll
                for (int j = 0; j < 4; ++j) L[(mt * 16 + fq * 4 + j) * 132 + nt * 16 + fr] = r[j]; } }
#pragma unroll 8
        for (int t = 0; t < 32; ++t) { const float bre = L[t * 132 + lane], bim = L[t * 132 + 64 + lane];
            const float nre = ar * sre - ai * sim + bre, nim = ar * sim + ai * sre + bim; sre = nre; sim = nim;
            if (OUT) { L[t * 132 + lane] = sre; L[t * 132 + 64 + lane] = sim; } }
        if (OUT) {
#pragma unroll
            for (int mt = 0; mt < 2; ++mt) { f32x4 acc = MFMA16(af[mt], dfr, ((f32x4){0.f, 0.f, 0.f, 0.f}));
#pragma unroll
                for (int kk = 0; kk < 4; ++kk) { float f[8];
#pragma unroll
                    for (int i = 0; i < 8; ++i) f[i] = L[(mt * 16 + fr) * 132 + kk * 32 + fq * 8 + i];
                    acc = MFMA16(pack8(f), cfr[kk], acc); }
#pragma unroll
                for (int j = 0; j < 4; ++j) OT[(mt * 16 + fq * 4 + j) * 16 + fr] = f2bf(gelu_tanh(acc[j])); }
            *(u32x4*)(YB + (size_t)(tok0 + (lane >> 1)) * 1024 + g * 16 + (lane & 1) * 8) = *(const LAS u32x4*)(OT + lane * 8);
        }
    }
    if (!OUT) SEND[((size_t)(b * 32 + tc) * 64 + g) * 64 + lane] = (f32x2){sre, sim};
}

#define XB_TMO      128
#define XB_XCNT(j)  (256  + 64 * (j))
#define XB_XSUB(j)  (1280 + 64 * (j))
#define XB_XGEN(j)  (2304 + 64 * (j))
#define XB_TOP      3328
#define XB_TOPGEN   3392
#define XCD_BAR_WORDS 3456
#define XB_SPIN_CAP (1u << 23)
__device__ __forceinline__ unsigned xb_ld(unsigned* p)              { return __hip_atomic_load(p, __ATOMIC_RELAXED, __HIP_MEMORY_SCOPE_AGENT); }
__device__ __forceinline__ unsigned xb_add(unsigned* p, unsigned v) { return __hip_atomic_fetch_add(p, v, __ATOMIC_RELAXED, __HIP_MEMORY_SCOPE_AGENT); }
__device__ __forceinline__ unsigned xb_xcc_id() { return (unsigned)__builtin_amdgcn_s_getreg((3 << 11) | 20) & 0xFu; }
#define XB_SPIN(cond, bar) do { unsigned _sp = 0; while (cond) { __builtin_amdgcn_s_sleep(1); \
    if ((++_sp & 255u) == 0u) { if (xb_ld(&(bar)[XB_TMO])) break; if (_sp > XB_SPIN_CAP) { atomicAdd(&(bar)[XB_TMO], 1u); break; } } } } while (0)
struct XcdBarrier { unsigned* bar; unsigned x; volatile LAS unsigned* st; };
__device__ __forceinline__ XcdBarrier xcd_barrier_post(unsigned* bar, volatile LAS unsigned* st) {
    XcdBarrier b; b.bar = bar; b.x = xb_xcc_id(); b.st = st;
    if (threadIdx.x == 0) (void)xb_add(&bar[XB_XCNT(b.x)], 1u);
    return b;
}
__device__ __forceinline__ void xcd_barrier_complete(unsigned* bar, unsigned x, unsigned& nloc, unsigned& nx) {
    const unsigned G = gridDim.x * gridDim.y * gridDim.z;
    unsigned sum, cnt, mine, sp = 0u;
    for (;;) {
        sum = 0u; cnt = 0u; mine = 0u;
#pragma unroll
        for (unsigned j = 0; j < 16; ++j) { const unsigned c = xb_ld(&bar[XB_XCNT(j)]); sum += c; cnt += (c > 0u) ? 1u : 0u; mine = (j == x) ? c : mine; }
        if (sum == G) break;
        __builtin_amdgcn_s_sleep(1);
        if ((++sp & 255u) == 0u) { if (xb_ld(&bar[XB_TMO])) break; if (sp > XB_SPIN_CAP) { atomicAdd(&bar[XB_TMO], 1u); break; } }
    }
    nloc = mine > 0u ? mine : 1u; nx = cnt > 0u ? cnt : 1u;
}
__device__ __forceinline__ void xcd_barrier(const XcdBarrier& b) {
    asm volatile("s_waitcnt vmcnt(0)" ::: "memory");
    __syncthreads();
    if (threadIdx.x == 0) {
        unsigned* bar = b.bar;
        __builtin_amdgcn_s_waitcnt(0);
        unsigned nloc = b.st[0], nx = b.st[1];
        if (nloc == 0u) { xcd_barrier_complete(bar, b.x, nloc, nx); b.st[0] = nloc; b.st[1] = nx; }
        const unsigned old = xb_add(&bar[XB_XSUB(b.x)], 1u);
        const unsigned gen = old / nloc;
        if (old + 1u == (gen + 1u) * nloc) {
            __builtin_amdgcn_fence(__ATOMIC_RELEASE, "agent");
            asm volatile("s_waitcnt vmcnt(0)" ::: "memory");
            const unsigned og = xb_add(&bar[XB_TOP], 1u);
            const unsigned tg = og / nx;
            if (og + 1u == (tg + 1u) * nx) xb_add(&bar[XB_TOPGEN], 1u);
            else XB_SPIN(xb_ld(&bar[XB_TOPGEN]) == tg, bar);
            __builtin_amdgcn_fence(__ATOMIC_ACQUIRE, "agent");
            xb_add(&bar[XB_XGEN(b.x)], 1u);
            asm volatile("s_waitcnt vmcnt(0)" ::: "memory");
        } else {
            XB_SPIN(xb_ld(&bar[XB_XGEN(b.x)]) == gen, bar);
            __builtin_amdgcn_fence(__ATOMIC_ACQUIRE, "agent");
            asm volatile("s_waitcnt vmcnt(0)" ::: "memory");
        }
    }
    __syncthreads();
}

__global__ void __launch_bounds__(512, 2) mega(Params p) {
    extern __shared__ __attribute__((aligned(16))) unsigned char shm[];
    LAS unsigned char* lds = (LAS unsigned char*)shm;
    cg::grid_group grid = cg::this_grid();
    unsigned char* ws = p.ws;
    const int tid = threadIdx.x, G = gridDim.x, gtid = blockIdx.x * 512 + tid, nthr = G * 512;
    const int lo = p.ph_lo, hi = p.ph_hi;
    float* mods = (float*)(ws + WS_MODS);
    u16* H = (u16*)(ws + WS_H); u16* HID = (u16*)(ws + WS_HID);
#define IN(k) (lo <= (k) && (k) < hi)
    volatile LAS unsigned* xbst = (volatile LAS unsigned*)(lds + LDS_PHASE_BYTES);
    if (tid < 4) xbst[tid] = 0u;
    __syncthreads();
    XcdBarrier xbar = xcd_barrier_post((unsigned*)(ws + WS_BAR), xbst);
#define SYNC(k) do { if (IN(k) && IN((k) + 1)) xcd_barrier(xbar); } while (0)
#ifndef REP_MASK
#define REP_MASK 0
#endif
#define REP(k) for (int _rep = 0; _rep < (((REP_MASK >> (k)) & 1) ? 2 : 1); ++_rep)

    if (IN(0)) REP(0) {
        LAS float* scl = (LAS float*)lds;
        for (int i = tid; i < 4096; i += 512) scl[i] = siluf_(p.in[I_C][i]);
        __syncthreads();
        float* part = (float*)(ws + WS_PART); const float* wada = p.in[I_WADA];
        for (int it = gtid; it < 32 * 4608; it += nthr) { const int kc = it / 4608, cgp = it % 4608;
            f32x4 a0 = (f32x4){0.f, 0.f, 0.f, 0.f}, a1 = a0; const float* wp = wada + (size_t)(kc * 64) * NMOD + cgp * 4;
#pragma unroll 8
            for (int k = 0; k < 64; ++k) { const f32x4 wv = __builtin_nontemporal_load((const f32x4*)(wp + (size_t)k * NMOD)); a0 += wv * scl[kc * 64 + k]; a1 += wv * scl[2048 + kc * 64 + k]; }
            *(f32x4*)(part + (size_t)(kc * 2 + 0) * NMOD + cgp * 4) = a0; *(f32x4*)(part + (size_t)(kc * 2 + 1) * NMOD + cgp * 4) = a1; }
        u16* BBAR = (u16*)(ws + WS_BBAR); f32x2* AV = (f32x2*)(ws + WS_AV); f32x2* AL = (f32x2*)(ws + WS_AL);
        for (int i = gtid; i < 4096; i += nthr) { const int g = i >> 6;
            const float dt = expf(p.in[I_LOGDT][g]); const float lr = fminf(p.in[I_LRE][i], -1e-4f), li = p.in[I_LIM][i];
            const float mag = expf(lr * dt); const float ar = mag * cosf(li * dt), ai = mag * sinf(li * dt);
            const float den = lr * lr + li * li, nr = ar - 1.f; const float kr = (nr * lr + ai * li) / den, ki = (ai * lr - nr * li) / den;
            const int pp = i & 63;
#pragma unroll
            for (int ii = 0; ii < 16; ++ii) { const float br = p.in[I_BRE][(size_t)i * 16 + ii], bi = p.in[I_BIM][(size_t)i * 16 + ii];
                BBAR[((size_t)(g * 128 + pp)) * 16 + ii] = f2bf(kr * br - ki * bi); BBAR[((size_t)(g * 128 + 64 + pp)) * 16 + ii] = f2bf(kr * bi + ki * br); }
            AV[i] = (f32x2){ar, ai}; float xr = ar, xi = ai;
#pragma unroll
            for (int s = 0; s < 8; ++s) { const float t = xr * xr - xi * xi; xi = 2.f * xr * xi; xr = t; }
            AL[i] = (f32x2){xr, xi}; }
        u16* CM = (u16*)(ws + WS_CM);
        for (int i = gtid; i < 131072; i += nthr) { const int gi = i >> 7, q = i & 127; CM[i] = f2bf(q < 64 ? p.in[I_CRE][(size_t)gi * 64 + q] : -p.in[I_CIM][(size_t)gi * 64 + q - 64]); }
    }
    SYNC(0);
    if (IN(1)) REP(1) {
        const float* part = (const float*)(ws + WS_PART);
        for (int i = gtid; i < 2 * NMOD; i += nthr) { const int b = i / NMOD, j = i % NMOD; float s = p.in[I_BADA][j];
#pragma unroll 8
            for (int kc = 0; kc < 32; ++kc) s += part[(size_t)(kc * 2 + b) * NMOD + j];
            mods[i] = s; }
        int tb = 0; LAS float* T = (LAS float*)lds;
        conv_weight(T, p.in[I_W1IN], (u16*)(ws + WS_W1IN), 2048, 2 * FF, 2 * FF, 0, tb, true);
        conv_weight(T, p.in[I_W1OUT], (u16*)(ws + WS_W1OUT), FF, 2048, 2048, 1, tb);
        conv_weight(T, p.in[I_WIN], (u16*)(ws + WS_WIN), 2048, 10272, NPROJ_C, 2, tb);
        conv_weight(T, p.in[I_WA], (u16*)(ws + WS_WA), 2048, 2048, 2048, 1, tb);
        conv_weight(T, p.in[I_WB], (u16*)(ws + WS_WB), 1024, 4096, 4096, 3, tb);
        conv_weight(T, p.in[I_WO], (u16*)(ws + WS_WO), 2048, 2048, 2048, 1, tb);
    }
    SYNC(1);
    if (IN(2)) REP(2) norm_rows<0, true>(p.in[I_X], p.in[I_NF1], mods + 0 * DM, mods + 1 * DM, H, nullptr);
    SYNC(2);
    if (IN(3)) REP(3) { pg8::Gemm g{H, (const u16*)(ws + WS_W1IN), M_TOK, 2 * FF, 2048}; pg8::StaticOrder S; S.init(M_TOK, 2 * FF, G, blockIdx.x); EpiSwiglu E{HID}; pg8::gemm_phase<EpiSwiglu, true, true>(lds, g, S, E); }
    SYNC(3);
    if (IN(4)) REP(4) { pg8::Gemm g{HID, (const u16*)(ws + WS_W1OUT), M_TOK, 2048, FF}; pg8::StaticOrder S; S.init(M_TOK, 2048, G, blockIdx.x, true); EpiResid E{p.in[I_X], p.out, mods + 2 * DM, 0.5f}; pg8::gemm_phase(lds, g, S, E); }
    SYNC(4);
    if (IN(5)) REP(5) {
        norm_dt_rows(p.out, p.in[I_NMIX], mods + 3 * DM, mods + 4 * DM, H, (const u16*)(ws + WS_WIN) + (size_t)NPROJ_G * 2048, p.in[I_DTB], (float*)(ws + WS_DT));
        int tb = 0; LAS float* T = (LAS float*)lds;
        conv_weight(T, p.in[I_W2IN], (u16*)(ws + WS_W1IN), 2048, 2 * FF, 2 * FF, 0, tb, true);
        conv_weight(T, p.in[I_W2OUT], (u16*)(ws + WS_W1OUT), FF, 2048, 2048, 1, tb);
    }
    SYNC(5);
    if (IN(6)) REP(6) { pg8::Gemm g{H, (const u16*)(ws + WS_WIN), M_TOK, NPROJ_G, 2048}; pg8::StaticOrder S; S.init(M_TOK, NPROJ_G, G, blockIdx.x);
        EpiProj E{(u16*)(ws + WS_Z), (u16*)(ws + WS_X), (u16*)(ws + WS_U), (u16*)(ws + WS_G), (float*)(ws + WS_DT), p.in[I_DTB]}; pg8::gemm_phase(lds, g, S, E); }
    SYNC(6);
    if (IN(7)) REP(7) {
        __syncthreads();
        REP(17) for (int it = blockIdx.x; it < 512; it += G) ssd_a_item(p, lds, it);
        REP(18) for (int it = blockIdx.x * 8 + (tid >> 6); it < 4096; it += G * 8) s5_item<false>(p, lds, it);
    }
    SYNC(7);
    if (IN(8)) REP(8) {
        u16* ST = (u16*)(ws + WS_ST); const float* CS = (const float*)(ws + WS_CS);
        for (int idx = gtid; idx < 131072; idx += nthr) { const int n4 = idx & 31, pp = (idx >> 5) & 63, h = (idx >> 11) & 31, b = idx >> 16;
            float run[4] = {0.f, 0.f, 0.f, 0.f};
#pragma unroll 1
            for (int cb = 0; cb < 64; cb += 16) {
                u32x2 sv[16]; float cse[16];
#pragma unroll
                for (int i = 0; i < 16; ++i) { const size_t hc = (size_t)((b * 64 + cb + i) * 32 + h); sv[i] = *(const u32x2*)(ST + (hc * 64 + pp) * 128 + n4 * 4); cse[i] = CS[hc * 128 + 127]; }
                asm volatile("" ::: "memory");
#pragma unroll
                for (int i = 0; i < 16; ++i) { const size_t hc = (size_t)((b * 64 + cb + i) * 32 + h); const float dec = __expf(cse[i]);
                    u32x2 o; o.x = cvt_pk_bf16(run[0], run[1]); o.y = cvt_pk_bf16(run[2], run[3]); *(u32x2*)(ST + (hc * 64 + pp) * 128 + n4 * 4) = o;
                    run[0] = dec * run[0] + bflo(sv[i].x); run[1] = dec * run[1] + bfhi(sv[i].x); run[2] = dec * run[2] + bflo(sv[i].y); run[3] = dec * run[3] + bfhi(sv[i].y); }
                asm volatile("" ::: "memory");
            } }
        const f32x2* AL = (const f32x2*)(ws + WS_AL); const f32x2* SEND = (const f32x2*)(ws + WS_SEND); f32x2* SINIT = (f32x2*)(ws + WS_SINIT);
        for (int idx = gtid; idx < 8192; idx += nthr) { const int gp = idx & 4095, b = idx >> 12; const f32x2 a = AL[gp]; float sr = 0.f, si = 0.f;
            f32x2 ev[32];
#pragma unroll
            for (int tc = 0; tc < 32; ++tc) ev[tc] = SEND[(size_t)(b * 32 + tc) * 4096 + gp];
            asm volatile("" ::: "memory");
#pragma unroll
            for (int tc = 0; tc < 32; ++tc) { SINIT[(size_t)(b * 32 + tc) * 4096 + gp] = (f32x2){sr, si};
                const float nr = a.x * sr - a.y * si + ev[tc].x, ni = a.x * si + a.y * sr + ev[tc].y; sr = nr; si = ni; } }
    }
    SYNC(8);
    if (IN(9)) REP(9) {
        __syncthreads();
        REP(19) for (int it = blockIdx.x; it < 512; it += G) ssd_c_item(p, lds, it);
        REP(20) for (int it = blockIdx.x * 8 + (tid >> 6); it < 4096; it += G * 8) s5_item<true>(p, lds, it);
    }
    SYNC(9);
    if (IN(10)) REP(10) { pg8::Gemm g{(const u16*)(ws + WS_YB), (const u16*)(ws + WS_WB), M_TOK, 4096, 1024}; pg8::StaticOrder S; S.init(M_TOK, 4096, G, blockIdx.x); EpiGlu E{(u16*)(ws + WS_MB), (const u16*)(ws + WS_G)}; pg8::gemm_phase(lds, g, S, E); }
    SYNC(10);
    if (IN(11)) REP(11) { pg8::Gemm g{(const u16*)(ws + WS_YA), (const u16*)(ws + WS_WA), M_TOK, 2048, 2048}; pg8::StaticOrder S; S.init(M_TOK, 2048, G, blockIdx.x); EpiMerge E{H, (const u16*)(ws + WS_G), (const u16*)(ws + WS_MB)}; pg8::gemm_phase(lds, g, S, E); }
    SYNC(11);
    if (IN(12)) REP(12) { pg8::Gemm g{H, (const u16*)(ws + WS_WO), M_TOK, 2048, 2048}; pg8::StaticOrder S; S.init(M_TOK, 2048, G, blockIdx.x); EpiResid E{p.out, p.out, mods + 5 * DM, 1.0f}; pg8::gemm_phase(lds, g, S, E); }
    SYNC(12);
    if (IN(13)) REP(13) norm_rows<0>(p.out, p.in[I_NF2], mods + 6 * DM, mods + 7 * DM, H, nullptr);
    SYNC(13);
    if (IN(14)) REP(14) { pg8::Gemm g{H, (const u16*)(ws + WS_W1IN), M_TOK, 2 * FF, 2048}; pg8::StaticOrder S; S.init(M_TOK, 2 * FF, G, blockIdx.x); EpiSwiglu E{HID}; pg8::gemm_phase<EpiSwiglu, false, true>(lds, g, S, E); }
    SYNC(14);
    if (IN(15)) REP(15) { pg8::Gemm g{HID, (const u16*)(ws + WS_W1OUT), M_TOK, 2048, FF}; pg8::StaticOrder S; S.init(M_TOK, 2048, G, blockIdx.x, true); EpiResid E{p.out, p.out, mods + 8 * DM, 0.5f}; pg8::gemm_phase(lds, g, S, E); }
    SYNC(15);
    if (IN(16)) REP(16) norm_rows<1>(p.out, p.in[I_NFIN], nullptr, nullptr, nullptr, p.out);
    if (hi > NPH) grid.sync();
#undef IN
#undef SYNC
}

#ifndef MK_SPLIT
#define MK_SPLIT 0
#endif
extern "C" void kernel_launch(void* const* d_in, const int* in_sizes, int n_in, void* d_out, int out_size, void* d_ws, size_t ws_size, hipStream_t stream) {
    static int grid = 0;
    if (grid == 0) {
        if (n_in != 30 || ws_size < WS_END) { fprintf(stderr, "kernel_launch: n_in %d ws %zu (need %zu)\n", n_in, ws_size, (size_t)WS_END); grid = -1; return; }
        int dev = 0, cus = 0, per_cu = 0;
        (void)hipGetDevice(&dev); (void)hipDeviceGetAttribute(&cus, hipDeviceAttributeMultiprocessorCount, dev);
        (void)hipFuncSetAttribute((const void*)mega, hipFuncAttributeMaxDynamicSharedMemorySize, LDS_BYTES);
        (void)hipOccupancyMaxActiveBlocksPerMultiprocessor(&per_cu, (const void*)mega, 512, LDS_BYTES);
        if (per_cu < 1) per_cu = 1;
        grid = cus * per_cu; if (grid > 256) grid = 256;
    }
    if (grid < 0) return;
    Params p{};
    for (int i = 0; i < 30; ++i) p.in[i] = (const float*)d_in[i];
    p.out = (float*)d_out; p.ws = (unsigned char*)d_ws;
    (void)hipMemsetAsync((unsigned char*)d_ws + WS_BAR, 0, 16384, stream);
#if MK_SPLIT
    for (int ph = 0; ph < NPH; ++ph) { p.ph_lo = ph; p.ph_hi = ph + 1; void* args[] = {&p};
        (void)hipLaunchCooperativeKernel((void*)mega, dim3(grid), dim3(512), args, LDS_BYTES, stream); }
#else
    p.ph_lo = 0; p.ph_hi = NPH; void* args[] = {&p};
    hipError_t e = hipLaunchCooperativeKernel((void*)mega, dim3(grid), dim3(512), args, LDS_BYTES, stream);
    if (e != hipSuccess) fprintf(stderr, "cooperative launch failed: %s (grid %d)\n", hipGetErrorString(e), grid);
#endif
}
```
